# Optimizing an MI355X kernel written in HIP

```python
import jax, jax.numpy as jnp
from jax import lax
import numpy as np

D_MODEL = 1024
BATCH = 16
SEQ = 4096
DEPTH = 1

MLA_HEADS = 8
QK_NOPE_DIM = 128
QK_ROPE_DIM = 64
V_HEAD_DIM = 128
Q_LORA_RANK = 256
KV_LORA_RANK = 256
ROPE_THETA = 10000.0
Q_BLOCK = 128
SSM_D_INNER = 2 * D_MODEL
SSM_HEAD_DIM = 64
SSM_HEADS = SSM_D_INNER // SSM_HEAD_DIM
SSM_GROUPS = 8
SSM_HEADS_PER_GROUP = SSM_HEADS // SSM_GROUPS
SSM_STATE = 128
CONV_WIDTH = 4
SSD_CHUNK = 128
CONV_CH = SSM_D_INNER + 2 * SSM_GROUPS * SSM_STATE
D_FF = 4 * D_MODEL
EPS = 1e-6
IN_SIZES = (Q_LORA_RANK, KV_LORA_RANK, QK_ROPE_DIM, SSM_D_INNER, CONV_CH, SSM_HEADS, D_MODEL, D_MODEL)
IN_COLS = Q_LORA_RANK + KV_LORA_RANK + QK_ROPE_DIM + SSM_D_INNER + CONV_CH + SSM_HEADS + 2 * D_MODEL

kernel_name = "hybrid_mla_ssd_gated_block"


def rms_norm(x, g):
    xf = x.astype(jnp.float32)
    y = xf * lax.rsqrt(jnp.mean(xf * xf, axis=-1, keepdims=True) + EPS)
    return (y * g.astype(jnp.float32)).astype(x.dtype)


def split_cols(t, sizes):
    idx = [int(v) for v in np.cumsum(sizes)[:-1]]
    return jnp.split(t, idx, axis=-1)


def rope_tables(positions):
    half = QK_ROPE_DIM // 2
    inv = ROPE_THETA ** (-jnp.arange(half, dtype=jnp.float32) / half)
    ang = positions.astype(jnp.float32)[..., None] * inv
    return jnp.cos(ang), jnp.sin(ang)


def apply_rope(t, cos, sin):
    half = QK_ROPE_DIM // 2
    t1, t2 = t[..., :half], t[..., half:]
    return jnp.concatenate([t1 * cos - t2 * sin, t1 * sin + t2 * cos], axis=-1).astype(t.dtype)


def mla_attention(q_lat, kv_lat, k_rope, positions, g_q, g_kv, w_uq, w_ukv):
    B, S, _ = q_lat.shape
    q = (rms_norm(q_lat, g_q) @ w_uq).reshape(B, S, MLA_HEADS, QK_NOPE_DIM + QK_ROPE_DIM)
    q_nope, q_rope = q[..., :QK_NOPE_DIM], q[..., QK_NOPE_DIM:]
    kv = (rms_norm(kv_lat, g_kv) @ w_ukv).reshape(B, S, MLA_HEADS, QK_NOPE_DIM + V_HEAD_DIM)
    k_nope, v = kv[..., :QK_NOPE_DIM], kv[..., QK_NOPE_DIM:]
    cos, sin = rope_tables(positions)
    q_rope = apply_rope(q_rope, cos[:, :, None, :], sin[:, :, None, :])
    k_rope = apply_rope(k_rope, cos, sin)
    scale = (QK_NOPE_DIM + QK_ROPE_DIM) ** -0.5
    outs = []
    for i in range(S // Q_BLOCK):
        q0, q1 = i * Q_BLOCK, (i + 1) * Q_BLOCK
        s = (jnp.einsum('bqhd,bkhd->bhqk', q_nope[:, q0:q1], k_nope[:, :q1]).astype(jnp.float32)
             + jnp.einsum('bqhr,bkr->bhqk', q_rope[:, q0:q1], k_rope[:, :q1]).astype(jnp.float32)) * scale
        causal = jnp.arange(q1)[None, :] <= jnp.arange(q0, q1)[:, None]
        p = jax.nn.softmax(jnp.where(causal, s, -jnp.inf), axis=-1).astype(v.dtype)
        outs.append(jnp.einsum('bhqk,bkhd->bqhd', p, v[:, :q1]))
    return jnp.concatenate(outs, axis=1).reshape(B, S, MLA_HEADS * V_HEAD_DIM)


def causal_depthwise_conv(u, w, b):
    S = u.shape[1]
    up = jnp.pad(u, ((0, 0), (CONV_WIDTH - 1, 0), (0, 0)))
    out = b
    for k in range(CONV_WIDTH):
        out = out + up[:, k:k + S] * w[k]
    return out


def ssd_chunked(xh, dt, A, Bm, Cm):
    Bsz, S, G, Hg, P = xh.shape
    N = Bm.shape[-1]
    L = SSD_CHUNK
    nc = S // L
    xdt = (xh * dt[..., None]).reshape(Bsz, nc, L, G, Hg, P)
    a_cum = jnp.cumsum((dt * A).reshape(Bsz, nc, L, G, Hg), axis=2)
    Bc = Bm.reshape(Bsz, nc, L, G, N).astype(jnp.float32)
    Cc = Cm.reshape(Bsz, nc, L, G, N).astype(jnp.float32)
    seg = a_cum[:, :, :, None] - a_cum[:, :, None, :]
    tri = jnp.tril(jnp.ones((L, L), dtype=bool))[:, :, None, None]
    decay = jnp.exp(jnp.where(tri, seg, -jnp.inf))
    cb = jnp.einsum('bclgn,bcsgn->bclsg', Cc, Bc)
    y_diag = jnp.einsum('bclsg,bclsgh,bcsghp->bclghp', cb, decay, xdt)
    decay_to_end = jnp.exp(a_cum[:, :, -1:] - a_cum)
    states = jnp.einsum('bclgn,bclgh,bclghp->bcghpn', Bc, decay_to_end, xdt)
    chunk_decay = jnp.exp(a_cum[:, :, -1])

    def step(h, inp):
        s_c, d_c = inp
        return h * d_c[..., None, None] + s_c, h

    h0 = jnp.zeros((Bsz, G, Hg, P, N), dtype=states.dtype)
    _, h_prev = lax.scan(step, h0, (jnp.moveaxis(states, 1, 0), jnp.moveaxis(chunk_decay, 1, 0)))
    h_prev = jnp.moveaxis(h_prev, 0, 1)
    y_off = jnp.einsum('bclgn,bcghpn,bclgh->bclghp', Cc, h_prev, jnp.exp(a_cum))
    return (y_diag + y_off).reshape(Bsz, S, G, Hg, P)


def mamba2_mixer(z, xbc, dt_raw, conv_w, conv_b, dt_bias, a_log, d_skip, g_ssm_out):
    B, S, _ = z.shape
    xbc = jax.nn.silu(causal_depthwise_conv(xbc, conv_w, conv_b))
    xs, Bm, Cm = split_cols(xbc, (SSM_D_INNER, SSM_GROUPS * SSM_STATE, SSM_GROUPS * SSM_STATE))
    xh = xs.reshape(B, S, SSM_GROUPS, SSM_HEADS_PER_GROUP, SSM_HEAD_DIM)
    Bm = Bm.reshape(B, S, SSM_GROUPS, SSM_STATE)
    Cm = Cm.reshape(B, S, SSM_GROUPS, SSM_STATE)
    dt = jax.nn.softplus(dt_raw.astype(jnp.float32).reshape(B, S, SSM_GROUPS, SSM_HEADS_PER_GROUP)
                         + dt_bias.astype(jnp.float32).reshape(SSM_GROUPS, SSM_HEADS_PER_GROUP))
    A = -jnp.exp(a_log.astype(jnp.float32)).reshape(SSM_GROUPS, SSM_HEADS_PER_GROUP)
    y = ssd_chunked(xh, dt, A, Bm, Cm)
    y = y + d_skip.reshape(SSM_GROUPS, SSM_HEADS_PER_GROUP)[:, :, None] * xh
    y = y.reshape(B, S, SSM_D_INNER).astype(z.dtype)
    yg = (y * jax.nn.silu(z)).reshape(B, S, SSM_GROUPS, SSM_D_INNER // SSM_GROUPS)
    yg = rms_norm(yg, g_ssm_out.reshape(SSM_GROUPS, SSM_D_INNER // SSM_GROUPS))
    return yg.reshape(B, S, SSM_D_INNER)


def setup_inputs(seed: int = 0) -> dict:
    key = jax.random.key(seed)
    ks = jax.random.split(key, 32)
    f32 = jnp.float32

    def nrm(k, shape, scale):
        return jax.random.normal(k, shape, f32) * scale

    def gain(k, shape):
        return 1.0 + 0.05 * jax.random.normal(k, shape, f32)

    Ld = DEPTH
    x = jax.random.normal(ks[0], (BATCH, SEQ, D_MODEL), f32)
    c = jax.random.normal(ks[1], (BATCH, D_MODEL), f32)
    offs = jax.random.randint(ks[2], (BATCH, 1), 0, 2048, dtype=jnp.int32)
    positions = (offs + jnp.arange(SEQ, dtype=jnp.int32)[None, :]).astype(jnp.int32)
    dt0 = jnp.exp(jax.random.uniform(ks[16], (Ld, SSM_HEADS), f32, np.log(1e-3), np.log(1e-1)))
    return {
        "x": x,
        "c": c,
        "positions": positions,
        "w_ada": nrm(ks[3], (Ld, D_MODEL, 6 * D_MODEL), 0.5 * D_MODEL ** -0.5),
        "b_ada": nrm(ks[4], (Ld, 6 * D_MODEL), 0.01),
        "g_pre_mix": gain(ks[5], (Ld, D_MODEL)),
        "g_post_mix": gain(ks[6], (Ld, D_MODEL)),
        "w_in": nrm(ks[7], (Ld, D_MODEL, IN_COLS), D_MODEL ** -0.5),
        "g_q_lat": gain(ks[8], (Ld, Q_LORA_RANK)),
        "g_kv_lat": gain(ks[9], (Ld, KV_LORA_RANK)),
        "w_uq": nrm(ks[10], (Ld, Q_LORA_RANK, MLA_HEADS * (QK_NOPE_DIM + QK_ROPE_DIM)), Q_LORA_RANK ** -0.5),
        "w_ukv": nrm(ks[11], (Ld, KV_LORA_RANK, MLA_HEADS * (QK_NOPE_DIM + V_HEAD_DIM)), KV_LORA_RANK ** -0.5),
        "w_o_attn": nrm(ks[12], (Ld, MLA_HEADS * V_HEAD_DIM, D_MODEL), (MLA_HEADS * V_HEAD_DIM) ** -0.5),
        "conv_w": nrm(ks[13], (Ld, CONV_WIDTH, CONV_CH), CONV_WIDTH ** -0.5),
        "conv_b": nrm(ks[14], (Ld, CONV_CH), 0.01),
        "dt_bias": dt0 + jnp.log(-jnp.expm1(-dt0)),
        "a_log": jnp.log(jax.random.uniform(ks[17], (Ld, SSM_HEADS), f32, 1.0, 16.0)),
        "d_skip": gain(ks[18], (Ld, SSM_HEADS)),
        "g_ssm_out": gain(ks[19], (Ld, SSM_D_INNER)),
        "w_o_ssm": nrm(ks[20], (Ld, SSM_D_INNER, D_MODEL), SSM_D_INNER ** -0.5),
        "w_out": nrm(ks[21], (Ld, D_MODEL, D_MODEL), D_MODEL ** -0.5),
        "g_pre_mlp": gain(ks[22], (Ld, D_MODEL)),
        "g_post_mlp": gain(ks[23], (Ld, D_MODEL)),
        "w_ff1": nrm(ks[24], (Ld, D_MODEL, D_FF), D_MODEL ** -0.5),
        "w_ff2": nrm(ks[25], (Ld, D_FF, D_MODEL), D_FF ** -0.5),
    }


def reference(x, c, positions, w_ada, b_ada, g_pre_mix, g_post_mix, w_in, g_q_lat, g_kv_lat,
              w_uq, w_ukv, w_o_attn, conv_w, conv_b, dt_bias, a_log, d_skip, g_ssm_out,
              w_o_ssm, w_out, g_pre_mlp, g_post_mlp, w_ff1, w_ff2):
    sc = jax.nn.silu(c)
    for l in range(DEPTH):
        mod = sc @ w_ada[l] + b_ada[l]
        shift1, scale1, gate1, shift2, scale2, gate2 = [m[:, None, :] for m in jnp.split(mod, 6, axis=-1)]
        h = rms_norm(x, g_pre_mix[l]) * (1.0 + scale1) + shift1
        q_lat, kv_lat, k_rope, z, xbc, dt_raw, gate_a, gate_b = split_cols(h @ w_in[l], IN_SIZES)
        attn = mla_attention(q_lat, kv_lat, k_rope, positions, g_q_lat[l], g_kv_lat[l], w_uq[l], w_ukv[l]) @ w_o_attn[l]
        ssm = mamba2_mixer(z, xbc, dt_raw, conv_w[l], conv_b[l], dt_bias[l], a_log[l], d_skip[l], g_ssm_out[l]) @ w_o_ssm[l]
        merged = jax.nn.sigmoid(gate_a) * attn + jax.nn.sigmoid(gate_b) * ssm
        x = x + gate1 * rms_norm(merged @ w_out[l], g_post_mix[l])
        h2 = rms_norm(x, g_pre_mlp[l]) * (1.0 + scale2) + shift2
        ff = jnp.square(jax.nn.relu(h2 @ w_ff1[l])) @ w_ff2[l]
        x = x + gate2 * rms_norm(ff, g_post_mlp[l])
    return x
```

```cpp
#include <hip/hip_runtime.h>
#include <hip/hip_cooperative_groups.h>
#include <cstdio>
#include <cstdint>
namespace cg = cooperative_groups;

#define LAS __attribute__((address_space(3)))
typedef unsigned short bf16_t;
typedef short bf16x8 __attribute__((ext_vector_type(8)));
typedef float f32x4 __attribute__((ext_vector_type(4)));
typedef float f32x2 __attribute__((ext_vector_type(2)));
typedef float f32x16 __attribute__((ext_vector_type(16)));
typedef unsigned u32x4 __attribute__((ext_vector_type(4)));
typedef unsigned u32x2 __attribute__((ext_vector_type(2)));

__device__ __forceinline__ int ltid() { int t = threadIdx.x; asm volatile("" : "+v"(t)); return t; }
__device__ __forceinline__ int lbid() { int b = blockIdx.x; asm volatile("" : "+s"(b)); return b; }
__device__ __forceinline__ int lgrid() { int g = gridDim.x; asm volatile("" : "+s"(g)); return g; }

namespace pg8 {
#define PG8_LAS __attribute__((address_space(3)))
constexpr int BM = 256, BK = 64, HALF = 128, HTB = HALF * BK * 2, STAGE_BYTES = 8 * HTB, NXCD = 8, WGM = 8;
__host__ __device__ __forceinline__ int lds_byte(int r, int c) { const int st = (r >> 4) * 2 + (c >> 5), rr = r & 15, cc = c & 31, ob = rr * 64 + cc * 2; return st * 1024 + (ob ^ (((ob >> 9) & 1) << 5)); }
__host__ __device__ __forceinline__ void stage_rc(int b, int& R, int& C) { const int st = b / 1024, sb = b % 1024, swz = sb ^ (((sb >> 9) & 1) << 5); R = (st >> 1) * 16 + swz / 64; C = (st & 1) * 32 + (swz % 64) / 2; }
__host__ __device__ __forceinline__ int perm32(int rho) { const int n = rho >> 4, i = rho & 15; return 8 * (i >> 2) + 4 * n + (i & 3); }
struct Unit { int pm, pn; };
struct Gemm { const bf16_t* A; const bf16_t* Bt; int M, N, K; };
struct StaticOrder {
    int nM, nN, nwg, G, c;
    __host__ __device__ void init(int M, int N, int G_, int c_) { nM = M / BM; nN = N / BM; nwg = nM * nN; G = G_; c = c_; }
    __host__ __device__ bool next(int i, Unit& u) const {
        const long L = (long)i * G + c; if (L >= nwg) return false;
        int wgid = (int)L; { const int q = nwg / NXCD, r = nwg % NXCD, xcd = wgid % NXCD, off = wgid / NXCD; wgid = (xcd < r ? xcd * (q + 1) : r * (q + 1) + (xcd - r) * q) + off; }
        const int nig = WGM * nN, gid = wgid / nig, fm = gid * WGM, gsz = (nM - fm) < WGM ? (nM - fm) : WGM;
        u.pm = fm + ((wgid % nig) % gsz); u.pn = (wgid % nig) / gsz; return true;
    }
    __device__ __forceinline__ void a_ready(const Unit&) const {}
    __device__ __forceinline__ void done(const Unit&) const {}
};
__device__ __forceinline__ unsigned cvt_pk_bf16(float lo, float hi) { unsigned r; asm volatile("v_cvt_pk_bf16_f32 %0, %1, %2" : "=v"(r) : "v"(lo), "v"(hi)); return r; }

template <class Epi, class Sched, bool ALIGN_EPI = false, bool SP2 = false>
__device__ __forceinline__ void gemm_phase(PG8_LAS unsigned char* lds, const Gemm g, const Sched& S, const Epi& E) {
    const int tid = ltid(), wid = __builtin_amdgcn_readfirstlane(tid >> 6), lane = tid & 63, wr = wid >> 2, wc = wid & 3, fr = lane & 15, fq = lane >> 4;
    const int K = g.K, nt = K / BK;
    unsigned voffA[2], voffB[2];
#pragma unroll
    for (int i = 0; i < 2; ++i) { int R, C; stage_rc(tid * 16 + i * 8192, R, C); const int Rb = Epi::PERM ? ((R & ~31) + perm32(R & 31)) : R;
        voffA[i] = (unsigned)(R * K + C) * 2u; voffB[i] = (unsigned)(Rb * K + C) * 2u; }
    const size_t kstep = (size_t)(BK * 2);
    const size_t hstep = (size_t)HALF * K * 2;
    const size_t tstep = 2 * hstep;
    const unsigned ldsw = (unsigned)wid * 1024u;
    const int aoff = lds_byte(wr * 64 + fr, fq * 8), boff = lds_byte(wc * 32 + fr, fq * 8);
#define PG8_SA(b, h) (((b) * 2 + (h)) * HTB)
#define PG8_SB(b, h) ((4 + (b) * 2 + (h)) * HTB)
#define PG8_STAGE(bufoff, gbase, voff) do { _Pragma("unroll") for (int _i = 0; _i < 2; ++_i) \
        __builtin_amdgcn_global_load_lds((const unsigned*)((const char*)(gbase) + (voff)[_i]), (PG8_LAS unsigned*)(lds + (bufoff) + ldsw + _i * 8192), 16, 0, 0); } while (0)
#define PG8_LDA(dst, b, h) do { _Pragma("unroll") for (int m = 0; m < 4; ++m) _Pragma("unroll") for (int k = 0; k < 2; ++k) dst[m][k] = *(const PG8_LAS bf16x8*)(lds + PG8_SA(b, h) + aoff + m * 2048 + k * 1024); } while (0)
#define PG8_LDB(dst, b, h) do { _Pragma("unroll") for (int n = 0; n < 2; ++n) _Pragma("unroll") for (int k = 0; k < 2; ++k) dst[n][k] = *(const PG8_LAS bf16x8*)(lds + PG8_SB(b, h) + boff + n * 2048 + k * 1024); } while (0)
#define PG8_MMA(ai, bj, At, Bt) do { __builtin_amdgcn_s_setprio(1); _Pragma("unroll") for (int m = 0; m < 4; ++m) _Pragma("unroll") for (int n = 0; n < 2; ++n) _Pragma("unroll") for (int k = 0; k < 2; ++k) \
        acc[ai][bj][m][n] = __builtin_amdgcn_mfma_f32_16x16x32_bf16(Bt[n][k], At[m][k], acc[ai][bj][m][n], 0, 0, 0); __builtin_amdgcn_s_setprio(0); } while (0)
#define PG8_WAIT_V(n) asm volatile("s_waitcnt vmcnt(" #n ")" ::: "memory")
#define PG8_WAIT_L(n) asm volatile("s_waitcnt lgkmcnt(" #n ")" ::: "memory")
#define PG8_BAR __builtin_amdgcn_s_barrier()
#define PG8_SCHED __builtin_amdgcn_sched_barrier(0)
    Unit cur, nxt; int ui = 0;
    if (!S.next(0, cur)) return;
    f32x4 acc[2][2][4][2];
#pragma unroll
    for (int a = 0; a < 2; ++a)
#pragma unroll
        for (int b = 0; b < 2; ++b)
#pragma unroll
            for (int m = 0; m < 4; ++m)
#pragma unroll
                for (int n = 0; n < 2; ++n) acc[a][b][m][n] = (f32x4){0.f, 0.f, 0.f, 0.f};
    bf16x8 At[4][2], B0[2][2], B1[2][2];
    const char* cA = (const char*)g.A + (size_t)cur.pm * tstep; const char* cB = (const char*)g.Bt + (size_t)cur.pn * tstep;
    S.a_ready(cur);
    if constexpr (SP2) {
        PG8_STAGE(PG8_SB(0, 0), cB, voffB); PG8_STAGE(PG8_SB(0, 1), cB + hstep, voffB); PG8_STAGE(PG8_SA(0, 0), cA, voffA); PG8_STAGE(PG8_SA(0, 1), cA + hstep, voffA);
        if (wr == 1) PG8_BAR;
        PG8_WAIT_V(2); PG8_BAR;
        PG8_STAGE(PG8_SB(1, 0), cB + kstep, voffB); PG8_STAGE(PG8_SA(1, 0), cA + kstep, voffA); PG8_STAGE(PG8_SB(1, 1), cB + hstep + kstep, voffB);
        PG8_WAIT_V(6); PG8_BAR;
    } else {
        PG8_STAGE(PG8_SB(0, 0), cB, voffB); PG8_STAGE(PG8_SA(0, 0), cA, voffA); PG8_STAGE(PG8_SB(0, 1), cB + hstep, voffB); PG8_STAGE(PG8_SA(0, 1), cA + hstep, voffA);
        if (wr == 1) PG8_BAR;
        PG8_WAIT_V(4); PG8_BAR;
        PG8_STAGE(PG8_SB(1, 0), cB + kstep, voffB); PG8_STAGE(PG8_SA(1, 0), cA + kstep, voffA); PG8_STAGE(PG8_SB(1, 1), cB + hstep + kstep, voffB);
        PG8_WAIT_V(6); PG8_BAR;
    }
    for (;;) {
        const bool has_next = S.next(ui + 1, nxt);
        const char* nA = has_next ? (const char*)g.A + (size_t)nxt.pm * tstep : cA; const char* nB = has_next ? (const char*)g.Bt + (size_t)nxt.pn * tstep : cB;
#pragma unroll 1
        for (int t = 0; t < nt; t += 2) {
            const bool last = (t == nt - 2);
            const char* a1 = cA + (size_t)(t + 1) * kstep;
            const char* a2 = last ? nA : cA + (size_t)(t + 2) * kstep; const char* b2 = last ? nB : cB + (size_t)(t + 2) * kstep;
            const char* a3 = a2 + kstep; const char* b3 = b2 + kstep;
            if (last && has_next) S.a_ready(nxt);
            if constexpr (SP2) {
            PG8_LDB(B0, 0, 0); PG8_LDB(B1, 0, 1); PG8_SCHED; PG8_LDA(At, 0, 0); PG8_STAGE(PG8_SA(1, 1), a1 + hstep, voffA);
            PG8_WAIT_V(8); PG8_WAIT_L(0); PG8_BAR; PG8_MMA(0, 0, At, B0); PG8_MMA(0, 1, At, B1); PG8_BAR; PG8_SCHED;
            PG8_LDA(At, 0, 1); PG8_STAGE(PG8_SB(0, 0), b2, voffB); PG8_STAGE(PG8_SB(0, 1), b2 + hstep, voffB); PG8_STAGE(PG8_SA(0, 0), a2, voffA);
            PG8_WAIT_V(8); PG8_WAIT_L(0); PG8_BAR; PG8_MMA(1, 0, At, B0); PG8_MMA(1, 1, At, B1); PG8_BAR; PG8_SCHED;
            PG8_LDB(B0, 1, 0); PG8_LDB(B1, 1, 1); PG8_SCHED; PG8_LDA(At, 1, 0); PG8_STAGE(PG8_SA(0, 1), a2 + hstep, voffA);
            PG8_WAIT_V(8); PG8_WAIT_L(0); PG8_BAR; PG8_MMA(0, 0, At, B0); PG8_MMA(0, 1, At, B1); PG8_BAR; PG8_SCHED;
            PG8_LDA(At, 1, 1); PG8_STAGE(PG8_SB(1, 0), b3, voffB); PG8_STAGE(PG8_SB(1, 1), b3 + hstep, voffB); PG8_STAGE(PG8_SA(1, 0), a3, voffA);
            PG8_WAIT_V(8); PG8_WAIT_L(0); PG8_BAR; PG8_MMA(1, 0, At, B0); PG8_MMA(1, 1, At, B1); PG8_BAR; PG8_SCHED;
            } else {
            PG8_LDB(B0, 0, 0); PG8_SCHED; PG8_LDA(At, 0, 0); PG8_STAGE(PG8_SA(1, 1), a1 + hstep, voffA);
            PG8_WAIT_L(8); PG8_BAR; PG8_WAIT_L(0); PG8_MMA(0, 0, At, B0); PG8_BAR; PG8_SCHED;
            PG8_LDB(B1, 0, 1); PG8_STAGE(PG8_SB(0, 0), b2, voffB);
            PG8_BAR; PG8_WAIT_L(0); PG8_MMA(0, 1, At, B1); PG8_BAR;
            PG8_LDA(At, 0, 1); PG8_STAGE(PG8_SA(0, 0), a2, voffA);
            PG8_BAR; PG8_WAIT_L(0); PG8_MMA(1, 0, At, B0); PG8_BAR; PG8_SCHED;
            PG8_STAGE(PG8_SB(0, 1), b2 + hstep, voffB);
            PG8_WAIT_V(6); PG8_BAR; PG8_MMA(1, 1, At, B1); PG8_BAR;
            PG8_LDB(B0, 1, 0); PG8_SCHED; PG8_LDA(At, 1, 0); PG8_STAGE(PG8_SA(0, 1), a2 + hstep, voffA);
            PG8_WAIT_L(8); PG8_BAR; PG8_WAIT_L(0); PG8_MMA(0, 0, At, B0); PG8_BAR; PG8_SCHED;
            PG8_LDB(B1, 1, 1); PG8_STAGE(PG8_SB(1, 0), b3, voffB);
            PG8_BAR; PG8_WAIT_L(0); PG8_MMA(0, 1, At, B1); PG8_BAR;
            PG8_LDA(At, 1, 1); PG8_STAGE(PG8_SA(1, 0), a3, voffA);
            PG8_BAR; PG8_WAIT_L(0); PG8_MMA(1, 0, At, B0); PG8_BAR; PG8_SCHED;
            PG8_STAGE(PG8_SB(1, 1), b3 + hstep, voffB);
            PG8_WAIT_V(6); PG8_BAR; PG8_MMA(1, 1, At, B1); PG8_BAR;
            }
        }
        if constexpr (ALIGN_EPI) { if (wr == 0) PG8_BAR; }
        if constexpr (!Epi::AFTER_DRAIN) { PG8_SCHED; int fr_l = fr, fq_l = fq; asm volatile("" : "+v"(fr_l), "+v"(fq_l) :: "memory"); E(acc, cur, wr, wc, fr_l, fq_l); asm volatile("" ::: "memory"); PG8_SCHED; S.done(cur); }
        if (!has_next) break;
#pragma unroll
        for (int a = 0; a < 2; ++a)
#pragma unroll
            for (int b = 0; b < 2; ++b)
#pragma unroll
                for (int m = 0; m < 4; ++m)
#pragma unroll
                    for (int n = 0; n < 2; ++n) acc[a][b][m][n] = (f32x4){0.f, 0.f, 0.f, 0.f};
        cur = nxt; cA = nA; cB = nB; ++ui;
        if constexpr (ALIGN_EPI) { if (wr == 1) PG8_BAR; }
    }
    PG8_WAIT_V(0);
    if constexpr (!ALIGN_EPI) { if (wr == 0) PG8_BAR; }
    PG8_BAR;
#undef PG8_SA
#undef PG8_SB
#undef PG8_STAGE
#undef PG8_LDA
#undef PG8_LDB
#undef PG8_MMA
#undef PG8_WAIT_V
#undef PG8_WAIT_L
#undef PG8_BAR
#undef PG8_SCHED
}
}

constexpr int BATCH = 16, SEQ = 4096, DM = 1024, TT = BATCH * SEQ;
constexpr int NB = 4, TG = NB * SEQ, NROUND = BATCH / NB;
constexpr int NPROJ = 8960;
constexpr float EPS = 1e-6f;
constexpr int LDS_BYTES = 147456;
constexpr size_t MiB = 1u << 20;
constexpr size_t WS_MOD = 1 * MiB, WS_WIN = 2 * MiB, WS_WUQ = 20 * MiB, WS_WUKN = 21 * MiB, WS_WUV = 22 * MiB, WS_WOA = 23 * MiB, WS_WOB = 25 * MiB,
                 WS_WOUT = 29 * MiB, WS_WFF1 = 31 * MiB, WS_WFF2 = 39 * MiB, WS_ROPE = 48 * MiB, WS_SSQ = 64 * MiB, WS_DEC = 65 * MiB;
constexpr size_t WS_H = 66 * MiB, WS_QL = 98 * MiB, WS_KVL = 106 * MiB, WS_KR = 114 * MiB, WS_DT = 116 * MiB, WS_Z = 118 * MiB, WS_XBC = 182 * MiB,
                 WS_SGA = 310 * MiB, WS_SGB = 342 * MiB, WS_QN = 374 * MiB, WS_QR = 406 * MiB, WS_KN = 422 * MiB, WS_VT = 454 * MiB, WS_CC = 486 * MiB,
                 WS_BC = 518 * MiB, WS_BT = 550 * MiB, WS_XT = 582 * MiB, WS_ATT = 646 * MiB, WS_ST = 678 * MiB, WS_HP = 806 * MiB, WS_SSM = 870 * MiB,
                 WS_END = 934 * MiB;
constexpr size_t WS_FF1 = WS_XBC, WS_MA = WS_QN, WS_MERGED = WS_KN, WS_MIX = WS_VT, WS_FF = WS_ATT;

__device__ const double ROPE_INV[32] = {1.0, 0.7498942093324559, 0.5623413251903491, 0.4216965034285822, 0.31622776601683794, 0.23713737056616552, 0.1778279410038923, 0.1333521432163324, 0.1, 0.07498942093324558, 0.05623413251903491, 0.042169650342858224, 0.03162277660168379, 0.023713737056616554, 0.01778279410038923, 0.01333521432163324, 0.01, 0.007498942093324558, 0.005623413251903491, 0.004216965034285823, 0.0031622776601683794, 0.0023713737056616554, 0.0017782794100389228, 0.001333521432163324, 0.001, 0.0007498942093324559, 0.0005623413251903491, 0.00042169650342858224, 0.00031622776601683794, 0.00023713737056616554, 0.00017782794100389227, 0.0001333521432163324};

__device__ __forceinline__ unsigned pk2(float lo, float hi) { return pg8::cvt_pk_bf16(lo, hi); }
__device__ __forceinline__ float bflo(unsigned w) { return __builtin_bit_cast(float, w << 16); }
__device__ __forceinline__ float bfhi(unsigned w) { return __builtin_bit_cast(float, w & 0xffff0000u); }
__device__ __forceinline__ float wave_sum(float v) {
#pragma unroll
    for (int o = 1; o < 64; o <<= 1) v += __shfl_xor(v, o);
    return v;
}
__device__ __forceinline__ void st8(bf16_t* p, f32x4 a, f32x4 b) { u32x4 w; w.x = pk2(a[0], a[1]); w.y = pk2(a[2], a[3]); w.z = pk2(b[0], b[1]); w.w = pk2(b[2], b[3]); *(u32x4*)p = w; }
__device__ __forceinline__ void ld8(const bf16_t* p, f32x4& a, f32x4& b) { const u32x4 w = *(const u32x4*)p; a[0] = bflo(w.x); a[1] = bfhi(w.x); a[2] = bflo(w.y); a[3] = bfhi(w.y); b[0] = bflo(w.z); b[1] = bfhi(w.z); b[2] = bflo(w.w); b[3] = bfhi(w.w); }
__device__ __forceinline__ float sigm(float x) { return 1.f / (1.f + __expf(-x)); }
__device__ __forceinline__ float silu(float x) { return x / (1.f + __expf(-x)); }
__device__ __forceinline__ float softplus(float x) {
    const float e = __expf(-fabsf(x));
    const float l = e < 0.03125f ? e * (1.f - e * (0.5f - e * (0.33333334f - 0.25f * e))) : __logf(1.f + e);
    return fmaxf(x, 0.f) + l;
}
__device__ __forceinline__ float dot4(f32x4 a) { return (a[0] * a[0] + a[1] * a[1]) + (a[2] * a[2] + a[3] * a[3]); }
#define LDS_WAIT() asm volatile("s_waitcnt lgkmcnt(0)" ::: "memory")

__device__ __forceinline__ int srcmap(int map, int r) {
    if (map == 0) return r;
    if (map == 1) {
        if (r < 512) return r;
        if (r < 6656) return r + 64;
        if (r < 8704) return r + 96;
        if (r < 8768) { const int j = r - 8704, g8 = j >> 3, e = j & 7; return 512 + (e < 4 ? 4 * g8 + e : 32 + 4 * g8 + (e - 4)); }
        if (r < 8800) return 6720 + (r - 8768);
        return -1;
    }
    if (map == 2) {
        if (r < 1024) return (r >> 7) * 192 + (r & 127);
        const int rr = r - 1024, h = rr >> 6, j = rr & 63, g8 = j >> 3, e = j & 7;
        return h * 192 + 128 + (e < 4 ? 4 * g8 + e : 32 + 4 * g8 + (e - 4));
    }
    if (map == 3) return (r >> 7) * 256 + (r & 127);
    return (r >> 7) * 256 + 128 + (r & 127);
}
__device__ __forceinline__ void transpose_item(const float* W, int K, int N, bf16_t* WT, int map, const float* ks, int nblk, LAS float* scr, int item, int lane) {
    const int kb = item / nblk, nb = item % nblk, k0 = 64 * kb, n0 = 32 * nb;
    const int src = srcmap(map, n0 + (lane & 31));
#pragma unroll 8
    for (int i = 0; i < 32; ++i) { const int kk = 2 * i + (lane >> 5); float v = src >= 0 ? W[(size_t)(k0 + kk) * N + src] : 0.f; if (ks) v *= ks[k0 + kk]; scr[kk * 33 + (lane & 31)] = v; }
    LDS_WAIT(); asm volatile("" ::: "memory");
    const int c = lane & 7;
#pragma unroll
    for (int j = 0; j < 4; ++j) { const int n = (lane >> 3) + 8 * j; const LAS float* s = scr + (8 * c) * 33 + n;
        u32x4 o; o.x = pk2(s[0 * 33], s[1 * 33]); o.y = pk2(s[2 * 33], s[3 * 33]); o.z = pk2(s[4 * 33], s[5 * 33]); o.w = pk2(s[6 * 33], s[7 * 33]);
        *(u32x4*)(WT + (size_t)(n0 + n) * K + k0 + 8 * c) = o; }
    LDS_WAIT(); asm volatile("" ::: "memory");
}

#define ACC_T const f32x4 (&acc)[2][2][4][2]
struct EpiProj {
    static constexpr bool PERM = true, AFTER_DRAIN = false;
    bf16_t *QL, *KVL, *KR, *Z, *XBC, *SGA, *SGB; float* DT; float *ssq_q, *ssq_kv; const float* rope; const float* dt_bias; int tbase;
    __device__ __forceinline__ void operator()(ACC_T, const pg8::Unit& u, int wr, int wc, int fr, int fq) const {
        const int pn = u.pn, row0 = u.pm * 256 + wr * 64 + fr, cw = wc * 32 + 8 * fq;
        if (pn < 2) {
            bf16_t* O = pn == 0 ? QL : KVL; float* sq = (pn == 0 ? ssq_q : ssq_kv) + tbase;
#pragma unroll
            for (int ai = 0; ai < 2; ++ai)
#pragma unroll
                for (int m = 0; m < 4; ++m) { const int row = row0 + ai * 128 + m * 16; float s = 0.f;
#pragma unroll
                    for (int bj = 0; bj < 2; ++bj) { const f32x4 v0 = acc[ai][bj][m][0], v1 = acc[ai][bj][m][1]; st8(O + (unsigned)row * 256u + cw + bj * 128, v0, v1); s += dot4(v0) + dot4(v1); }
                    s += __shfl_xor(s, 16); s += __shfl_xor(s, 32);
                    if (fq == 0) unsafeAtomicAdd(sq + row, s); }
        } else if (pn < 26) {
            bf16_t* O; int ld, c0; if (pn < 10) { O = Z; ld = 2048; c0 = (pn - 2) * 256; } else { O = XBC; ld = 4096; c0 = (pn - 10) * 256; }
#pragma unroll
            for (int ai = 0; ai < 2; ++ai)
#pragma unroll
                for (int m = 0; m < 4; ++m) { const int row = row0 + ai * 128 + m * 16;
#pragma unroll
                    for (int bj = 0; bj < 2; ++bj) st8(O + (unsigned)row * (unsigned)ld + c0 + cw + bj * 128, acc[ai][bj][m][0], acc[ai][bj][m][1]); }
        } else if (pn < 34) {
            bf16_t* O = pn < 30 ? SGA : SGB; const int c0 = ((pn - 26) & 3) * 256;
#pragma unroll
            for (int ai = 0; ai < 2; ++ai)
#pragma unroll
                for (int m = 0; m < 4; ++m) { const int row = row0 + ai * 128 + m * 16;
#pragma unroll
                    for (int bj = 0; bj < 2; ++bj) { f32x4 v0 = acc[ai][bj][m][0], v1 = acc[ai][bj][m][1];
#pragma unroll
                        for (int e = 0; e < 4; ++e) { v0[e] = sigm(v0[e]); v1[e] = sigm(v1[e]); }
                        st8(O + (unsigned)row * 1024u + c0 + cw + bj * 128, v0, v1); }
                    asm volatile("" ::: "memory"); }
        } else {
            if (wc < 2) {
                const int g8 = wc * 4 + fq;
#pragma unroll
                for (int ai = 0; ai < 2; ++ai)
#pragma unroll
                    for (int m = 0; m < 4; ++m) { const int row = row0 + ai * 128 + m * 16; const f32x4 v0 = acc[ai][0][m][0], v1 = acc[ai][0][m][1];
                        const f32x4* rp = (const f32x4*)(rope + (unsigned)((tbase + row) * 64 + 8 * g8)); const f32x4 c01 = rp[0], c23 = rp[1];
                        f32x4 o1, o2;
                        o1[0] = v0[0] * c01[0] - v1[0] * c01[1]; o2[0] = v0[0] * c01[1] + v1[0] * c01[0];
                        o1[1] = v0[1] * c01[2] - v1[1] * c01[3]; o2[1] = v0[1] * c01[3] + v1[1] * c01[2];
                        o1[2] = v0[2] * c23[0] - v1[2] * c23[1]; o2[2] = v0[2] * c23[1] + v1[2] * c23[0];
                        o1[3] = v0[3] * c23[2] - v1[3] * c23[3]; o2[3] = v0[3] * c23[3] + v1[3] * c23[2];
                        st8(KR + (unsigned)row * 64u + 8 * g8, o1, o2); asm volatile("" ::: "memory"); }
            } else if (wc == 2) {
                const int i0 = 8 * fq; const f32x4 b0 = *(const f32x4*)(dt_bias + i0), b1 = *(const f32x4*)(dt_bias + i0 + 4);
#pragma unroll
                for (int ai = 0; ai < 2; ++ai)
#pragma unroll
                    for (int m = 0; m < 4; ++m) { const int row = row0 + ai * 128 + m * 16; f32x4 v0 = acc[ai][0][m][0] + b0, v1 = acc[ai][0][m][1] + b1;
#pragma unroll
                        for (int e = 0; e < 4; ++e) { v0[e] = softplus(v0[e]); v1[e] = softplus(v1[e]); }
                        *(f32x4*)(DT + (unsigned)row * 32u + i0) = v0; *(f32x4*)(DT + (unsigned)row * 32u + i0 + 4) = v1; asm volatile("" ::: "memory"); }
            }
        }
    }
};
struct EpiQ {
    static constexpr bool PERM = true, AFTER_DRAIN = false;
    bf16_t *QN, *QR; const float* ssq; const float* rope; int tbase; float c2;
    __device__ __forceinline__ void operator()(ACC_T, const pg8::Unit& u, int wr, int wc, int fr, int fq) const {
        const int pn = u.pn, row0 = u.pm * 256 + wr * 64 + fr, cw = wc * 32 + 8 * fq;
#pragma unroll
        for (int ai = 0; ai < 2; ++ai)
#pragma unroll
            for (int m = 0; m < 4; ++m) { const int row = row0 + ai * 128 + m * 16; const float rs = rsqrtf(ssq[tbase + row] * (1.f / 256.f) + EPS) * c2;
#pragma unroll
                for (int bj = 0; bj < 2; ++bj) { const f32x4 v0 = acc[ai][bj][m][0] * rs, v1 = acc[ai][bj][m][1] * rs;
                    if (pn < 4) st8(QN + (unsigned)row * 1024u + pn * 256 + cw + bj * 128, v0, v1);
                    else { const int colr = (pn - 4) * 256 + cw + bj * 128, g8 = (colr & 63) >> 3;
                        const f32x4* rp = (const f32x4*)(rope + (unsigned)((tbase + row) * 64 + 8 * g8)); const f32x4 c01 = rp[0], c23 = rp[1];
                        f32x4 o1, o2;
                        o1[0] = v0[0] * c01[0] - v1[0] * c01[1]; o2[0] = v0[0] * c01[1] + v1[0] * c01[0];
                        o1[1] = v0[1] * c01[2] - v1[1] * c01[3]; o2[1] = v0[1] * c01[3] + v1[1] * c01[2];
                        o1[2] = v0[2] * c23[0] - v1[2] * c23[1]; o2[2] = v0[2] * c23[1] + v1[2] * c23[0];
                        o1[3] = v0[3] * c23[2] - v1[3] * c23[3]; o2[3] = v0[3] * c23[3] + v1[3] * c23[2];
                        st8(QR + (unsigned)row * 512u + colr, o1, o2); } }
                asm volatile("" ::: "memory"); }
    }
};
struct EpiRowScale {
    static constexpr bool PERM = true, AFTER_DRAIN = false;
    bf16_t* O; int ldc; const float* ssq; int tbase;
    __device__ __forceinline__ void operator()(ACC_T, const pg8::Unit& u, int wr, int wc, int fr, int fq) const {
        const int row0 = u.pm * 256 + wr * 64 + fr, col0 = u.pn * 256 + wc * 32 + 8 * fq;
#pragma unroll
        for (int ai = 0; ai < 2; ++ai)
#pragma unroll
            for (int m = 0; m < 4; ++m) { const int row = row0 + ai * 128 + m * 16; const float rs = rsqrtf(ssq[tbase + row] * (1.f / 256.f) + EPS);
#pragma unroll
                for (int bj = 0; bj < 2; ++bj) st8(O + (unsigned)row * (unsigned)ldc + col0 + bj * 128, acc[ai][bj][m][0] * rs, acc[ai][bj][m][1] * rs);
                asm volatile("" ::: "memory"); }
    }
};
struct EpiColScale {
    static constexpr bool PERM = true, AFTER_DRAIN = false;
    bf16_t* O; int ldc; const float* ssq; int tbase;
    __device__ __forceinline__ void operator()(ACC_T, const pg8::Unit& u, int wr, int wc, int fr, int fq) const {
        const int row0 = u.pm * 256 + wr * 64 + fr, col0 = u.pn * 256 + wc * 32 + 8 * fq;
#pragma unroll
        for (int bj = 0; bj < 2; ++bj) {
            f32x4 r0 = *(const f32x4*)(ssq + tbase + col0 + bj * 128), r1 = *(const f32x4*)(ssq + tbase + col0 + bj * 128 + 4);
#pragma unroll
            for (int e = 0; e < 4; ++e) { r0[e] = rsqrtf(r0[e] * (1.f / 256.f) + EPS); r1[e] = rsqrtf(r1[e] * (1.f / 256.f) + EPS); }
#pragma unroll
            for (int ai = 0; ai < 2; ++ai)
#pragma unroll
                for (int m = 0; m < 4; ++m) { const int row = row0 + ai * 128 + m * 16; st8(O + (unsigned)row * (unsigned)ldc + col0 + bj * 128, acc[ai][bj][m][0] * r0, acc[ai][bj][m][1] * r1); }
            asm volatile("" ::: "memory");
        }
    }
};
template <int MODE> struct EpiGate {
    static constexpr bool PERM = true, AFTER_DRAIN = false;
    bf16_t* O; const bf16_t* G; const bf16_t* P;
    __device__ __forceinline__ void operator()(ACC_T, const pg8::Unit& u, int wr, int wc, int fr, int fq) const {
        const int row0 = u.pm * 256 + wr * 64 + fr, col0 = u.pn * 256 + wc * 32 + 8 * fq;
#pragma unroll
        for (int ai = 0; ai < 2; ++ai)
#pragma unroll
            for (int m = 0; m < 4; ++m) { const int row = row0 + ai * 128 + m * 16;
#pragma unroll
                for (int bj = 0; bj < 2; ++bj) { const unsigned off = (unsigned)row * 1024u + col0 + bj * 128; f32x4 g0, g1; ld8(G + off, g0, g1);
                    f32x4 v0 = acc[ai][bj][m][0] * g0, v1 = acc[ai][bj][m][1] * g1;
                    if (MODE == 1) { f32x4 p0, p1; ld8(P + off, p0, p1); v0 += p0; v1 += p1; }
                    st8(O + off, v0, v1); }
                asm volatile("" ::: "memory"); }
    }
};
struct EpiSsq {
    static constexpr bool PERM = true, AFTER_DRAIN = false;
    bf16_t* O; int ldc; float* ssq; int tbase;
    __device__ __forceinline__ void operator()(ACC_T, const pg8::Unit& u, int wr, int wc, int fr, int fq) const {
        const int row0 = u.pm * 256 + wr * 64 + fr, col0 = u.pn * 256 + wc * 32 + 8 * fq;
#pragma unroll
        for (int ai = 0; ai < 2; ++ai)
#pragma unroll
            for (int m = 0; m < 4; ++m) { const int row = row0 + ai * 128 + m * 16; float s = 0.f;
#pragma unroll
                for (int bj = 0; bj < 2; ++bj) { const f32x4 v0 = acc[ai][bj][m][0], v1 = acc[ai][bj][m][1]; st8(O + (unsigned)row * (unsigned)ldc + col0 + bj * 128, v0, v1); s += dot4(v0) + dot4(v1); }
                s += __shfl_xor(s, 16); s += __shfl_xor(s, 32);
                if (fq == 0) unsafeAtomicAdd(ssq + tbase + row, s); }
    }
};
struct EpiRelu2 {
    static constexpr bool PERM = true, AFTER_DRAIN = false;
    bf16_t* O; int ldc;
    __device__ __forceinline__ void operator()(ACC_T, const pg8::Unit& u, int wr, int wc, int fr, int fq) const {
        const int row0 = u.pm * 256 + wr * 64 + fr, col0 = u.pn * 256 + wc * 32 + 8 * fq;
#pragma unroll
        for (int ai = 0; ai < 2; ++ai)
#pragma unroll
            for (int m = 0; m < 4; ++m) { const int row = row0 + ai * 128 + m * 16;
#pragma unroll
                for (int bj = 0; bj < 2; ++bj) { f32x4 v0 = acc[ai][bj][m][0], v1 = acc[ai][bj][m][1];
#pragma unroll
                    for (int e = 0; e < 4; ++e) { const float a = fmaxf(v0[e], 0.f), b = fmaxf(v1[e], 0.f); v0[e] = a * a; v1[e] = b * b; }
                    st8(O + (unsigned)row * (unsigned)ldc + col0 + bj * 128, v0, v1); } }
    }
};

constexpr int ATT_KB = 24576, ATT_BUF = 40960;
__device__ __forceinline__ void attn_unit(LAS unsigned char* lds, const bf16_t* QN, const bf16_t* QR, const bf16_t* KN, const bf16_t* KR, const bf16_t* VT, bf16_t* ATT, int b, int h, int qb) {
    const int tid = ltid(), wid = __builtin_amdgcn_readfirstlane(tid >> 6), lane = tid & 63, r32 = lane & 31, hf = lane >> 5;
    const int tb = b * SEQ, q0w = qb * 256 + wid * 32;
    bf16x8 qf[12];
    { const unsigned t = (unsigned)(tb + q0w + r32);
#pragma unroll
      for (int ks = 0; ks < 8; ++ks) qf[ks] = *(const bf16x8*)(QN + t * 1024u + h * 128 + ks * 16 + hf * 8);
#pragma unroll
      for (int ks = 0; ks < 4; ++ks) qf[8 + ks] = *(const bf16x8*)(QR + t * 512u + h * 64 + ks * 16 + hf * 8); }
    f32x16 o[4];
#pragma unroll
    for (int i = 0; i < 4; ++i)
#pragma unroll
        for (int r = 0; r < 16; ++r) o[i][r] = 0.f;
    float m_i = -INFINITY, l_i = 0.f;
    const int nkt = 4 * (qb + 1);
    unsigned ksrc[3]; unsigned vsrc[2];
#pragma unroll
    for (int i = 0; i < 3; ++i) { const int pid = (wid + 8 * i) * 64 + lane, row = pid / 24, cp = pid % 24, c = (cp & ~7) | ((cp ^ row) & 7);
        ksrc[i] = c < 16 ? (unsigned)((tb + row) * 1024 + h * 128 + c * 8) : (0x80000000u | (unsigned)((tb + row) * 64 + (c - 16) * 8)); }
#pragma unroll
    for (int i = 0; i < 2; ++i) { const int pid = (wid + 8 * i) * 64 + lane, dv = pid >> 3, cp = pid & 7, c = cp ^ (dv & 7);
        vsrc[i] = (unsigned)((h * 128 + dv) * TG + tb + c * 8); }
#define ATT_DMA(kt, buf) do { \
    _Pragma("unroll") for (int i = 0; i < 3; ++i) { const bf16_t* src = (ksrc[i] & 0x80000000u) ? KR + ((ksrc[i] & 0x7fffffffu) + (unsigned)(kt) * 4096u) : KN + (ksrc[i] + (unsigned)(kt) * 65536u); \
        __builtin_amdgcn_global_load_lds((const unsigned*)src, (LAS unsigned*)(lds + (buf) * ATT_BUF + (wid + 8 * i) * 1024), 16, 0, 0); } \
    _Pragma("unroll") for (int i = 0; i < 2; ++i) \
        __builtin_amdgcn_global_load_lds((const unsigned*)(VT + (vsrc[i] + (unsigned)(kt) * 64u)), (LAS unsigned*)(lds + (buf) * ATT_BUF + ATT_KB + (wid + 8 * i) * 1024), 16, 0, 0); } while (0)
    __syncthreads();
    ATT_DMA(0, 0);
    const int tx = hf ^ (r32 & 7);
    for (int kt = 0; kt < nkt; ++kt) {
        asm volatile("s_waitcnt vmcnt(0)" ::: "memory");
        __syncthreads();
        if (kt + 1 < nkt) ATT_DMA(kt + 1, (kt + 1) & 1);
        const LAS unsigned char* kbuf = lds + (kt & 1) * ATT_BUF; const LAS unsigned char* vbuf = kbuf + ATT_KB;
        const int key0 = kt * 64;
        if (key0 <= q0w + 31) {
            f32x16 s[2];
#pragma unroll
            for (int kb = 0; kb < 2; ++kb) {
#pragma unroll
                for (int r = 0; r < 16; ++r) s[kb][r] = 0.f;
                const LAS unsigned char* krow = kbuf + (kb * 32 + r32) * 384;
#pragma unroll
                for (int ks = 0; ks < 12; ++ks) { const bf16x8 a = *(const LAS bf16x8*)(krow + (((2 * ks) & ~7) + (((2 * ks) & 7) ^ tx)) * 16);
                    s[kb] = __builtin_amdgcn_mfma_f32_32x32x16_bf16(a, qf[ks], s[kb], 0, 0, 0);
                    if ((ks & 3) == 3) __builtin_amdgcn_sched_barrier(0); }
            }
            if (key0 + 63 > q0w) {
                const int qi = q0w + r32;
#pragma unroll
                for (int kb = 0; kb < 2; ++kb)
#pragma unroll
                    for (int r = 0; r < 16; ++r) { const int key = key0 + kb * 32 + (r & 3) + 8 * (r >> 2) + 4 * hf; if (key > qi) s[kb][r] = -INFINITY; }
            }
            float mx = s[0][0];
#pragma unroll
            for (int kb = 0; kb < 2; ++kb)
#pragma unroll
                for (int r = 0; r < 16; ++r) mx = fmaxf(mx, s[kb][r]);
            mx = fmaxf(mx, __shfl_xor(mx, 32));
            const float m_new = fmaxf(m_i, mx), alpha = __builtin_amdgcn_exp2f(m_i - m_new);
            float ps = 0.f;
#pragma unroll
            for (int kb = 0; kb < 2; ++kb)
#pragma unroll
                for (int r = 0; r < 16; ++r) { const float p = __builtin_amdgcn_exp2f(s[kb][r] - m_new); s[kb][r] = p; ps += p; }
            l_i = l_i * alpha + ps; m_i = m_new;
#pragma unroll
            for (int i = 0; i < 4; ++i)
#pragma unroll
                for (int r = 0; r < 16; ++r) o[i][r] *= alpha;
            bf16x8 pb[2][2];
#pragma unroll
            for (int kb = 0; kb < 2; ++kb)
#pragma unroll
                for (int s2 = 0; s2 < 2; ++s2) { u32x4 w; w.x = pk2(s[kb][8 * s2 + 0], s[kb][8 * s2 + 1]); w.y = pk2(s[kb][8 * s2 + 2], s[kb][8 * s2 + 3]);
                    w.z = pk2(s[kb][8 * s2 + 4], s[kb][8 * s2 + 5]); w.w = pk2(s[kb][8 * s2 + 6], s[kb][8 * s2 + 7]); pb[kb][s2] = __builtin_bit_cast(bf16x8, w); }
            const int vx = r32 & 7;
#pragma unroll
            for (int dvb = 0; dvb < 4; ++dvb) {
                const LAS unsigned char* vrow = vbuf + (dvb * 32 + r32) * 128 + hf * 8;
#pragma unroll
                for (int kb = 0; kb < 2; ++kb)
#pragma unroll
                    for (int s2 = 0; s2 < 2; ++s2) { const int c = kb * 4 + s2 * 2;
                        const u32x2 lo = *(const LAS u32x2*)(vrow + ((c ^ vx) * 16)), hi = *(const LAS u32x2*)(vrow + (((c + 1) ^ vx) * 16)); u32x4 w; w.x = lo.x; w.y = lo.y; w.z = hi.x; w.w = hi.y;
                        o[dvb] = __builtin_amdgcn_mfma_f32_32x32x16_bf16(__builtin_bit_cast(bf16x8, w), pb[kb][s2], o[dvb], 0, 0, 0); }
                __builtin_amdgcn_sched_barrier(0);
            }
        }
    }
#undef ATT_DMA
    l_i += __shfl_xor(l_i, 32);
    const float inv = 1.f / l_i;
    bf16_t* orow = ATT + (unsigned)(tb + q0w + r32) * 1024u + h * 128;
#pragma unroll
    for (int dvb = 0; dvb < 4; ++dvb)
#pragma unroll
        for (int rg = 0; rg < 4; ++rg) { u32x2 w; w.x = pk2(o[dvb][4 * rg] * inv, o[dvb][4 * rg + 1] * inv); w.y = pk2(o[dvb][4 * rg + 2] * inv, o[dvb][4 * rg + 3] * inv);
            *(u32x2*)(orow + dvb * 32 + 8 * rg + 4 * hf) = w; }
}

constexpr int SP = 272;
__device__ __forceinline__ void ld_tile(LAS unsigned char* dst, const bf16_t* src, int rows) {
    for (int p = ltid(); p < rows * 16; p += 512) { const int r = p >> 4, c = p & 15; *(LAS u32x4*)(dst + r * SP + c * 16) = *(const u32x4*)(src + r * 128 + c * 8); }
}
__device__ __forceinline__ void chunk_prep(LAS float* dts, LAS float* acs, const float* DT, int trow0, int g, const float* a_log) {
    const int tid = ltid(), wid = tid >> 6, lane = tid & 63;
    if (wid < 4) {
        const float A = -__expf(a_log[g * 4 + wid]);
        const float d0 = DT[(size_t)(trow0 + 2 * lane) * 32 + g * 4 + wid], d1 = DT[(size_t)(trow0 + 2 * lane + 1) * 32 + g * 4 + wid];
        const float x0 = d0 * A, x1 = x0 + d1 * A;
        float incl = x1;
#pragma unroll
        for (int o = 1; o < 64; o <<= 1) { const float v = __shfl_up(incl, o); if (lane >= o) incl += v; }
        const float excl = incl - x1;
        acs[wid * 128 + 2 * lane] = excl + x0; acs[wid * 128 + 2 * lane + 1] = excl + x1;
        dts[wid * 128 + 2 * lane] = d0; dts[wid * 128 + 2 * lane + 1] = d1;
    }
    __syncthreads();
}
__device__ __forceinline__ bf16x8 ldsfrag(const LAS unsigned char* base, int row, int k0) { return *(const LAS bf16x8*)(base + row * SP + k0 * 2); }

struct Args { const void* in[25]; float* out; unsigned char* ws; };
__device__ __forceinline__ const void* in_ptr(int i) {
    int off = i * 8; asm volatile("" : "+s"(off));
    const __attribute__((address_space(4))) char* kp = (const __attribute__((address_space(4))) char*)__builtin_amdgcn_kernarg_segment_ptr();
    return *(const void* const __attribute__((address_space(4)))*)(kp + off);
}
#define INF(i) ((const float*)in_ptr(i))
#define WSB() ((unsigned char*)in_ptr(26))
#define OUTP() ((float*)in_ptr(25))

__device__ __forceinline__ void ph_mod(LAS unsigned char* lds) {
    const int tid = ltid(), lane = tid & 63, wid = __builtin_amdgcn_readfirstlane(tid >> 6), G = lgrid(), bx = lbid();
    float* MOD = (float*)(WSB() + WS_MOD);
    const float* cvec = INF(1); const float* w_ada = INF(3); const float* b_ada = INF(4);
    for (int item = bx; item < 96; item += G) {
        LAS float* sc = (LAS float*)lds;
        LAS float* red = (LAS float*)(lds + 65536);
        for (int i = tid; i < 16384; i += 512) { const int b = i >> 10, k = i & 1023; sc[k * 16 + b] = silu(cvec[i]); }
        __syncthreads();
        const int kg = tid >> 4, cl = tid & 15, j0 = item * 64 + cl * 4;
        f32x4 ac[16];
#pragma unroll
        for (int b = 0; b < 16; ++b) ac[b] = (f32x4){0.f, 0.f, 0.f, 0.f};
#pragma unroll 2
        for (int i = 0; i < 32; ++i) { const int k = kg + 32 * i; const f32x4 w = *(const f32x4*)(w_ada + (size_t)k * 6144 + j0);
            const LAS f32x4* sp = (const LAS f32x4*)(sc + k * 16);
#pragma unroll
            for (int q = 0; q < 4; ++q) { const f32x4 s4 = sp[q];
#pragma unroll
                for (int e = 0; e < 4; ++e) ac[q * 4 + e] += w * s4[e]; } }
#pragma unroll
        for (int b = 0; b < 16; ++b)
#pragma unroll
            for (int e = 0; e < 4; ++e) { float v = ac[b][e]; v += __shfl_xor(v, 16); v += __shfl_xor(v, 32); ac[b][e] = v; }
        if (lane < 16) {
#pragma unroll
            for (int b = 0; b < 16; ++b) *(LAS f32x4*)(red + (wid * 16 + b) * 64 + cl * 4) = ac[b];
        }
        __syncthreads();
        for (int i = tid; i < 1024; i += 512) { const int b = i >> 6, cc = i & 63; float s = b_ada[item * 64 + cc];
#pragma unroll
            for (int w = 0; w < 8; ++w) s += red[(w * 16 + b) * 64 + cc];
            MOD[b * 6144 + item * 64 + cc] = s; }
        __syncthreads();
    }
}
__device__ __forceinline__ void ph_wcopy(LAS unsigned char* lds) {
    const int tid = ltid(), lane = tid & 63, wid = __builtin_amdgcn_readfirstlane(tid >> 6), G = lgrid(), bx = lbid();
    const int gw = bx * 8 + wid, NGW = G * 8;
    unsigned char* ws = WSB();
    LAS float* scr = (LAS float*)(lds + wid * 8448);
    constexpr int I0 = 16 * 280, I1 = 4 * 48, I2 = 4 * 32, I3 = 4 * 32, I4 = 16 * 32, I5 = 32 * 32, I6 = 16 * 32, I7 = 16 * 128, I8 = 64 * 32;
    constexpr int NIT = I0 + I1 + I2 + I3 + I4 + I5 + I6 + I7 + I8;
    for (int it = gw; it < NIT; it += NGW) {
        int r = it;
        if (r < I0) { transpose_item(INF(7), 1024, 8800, (bf16_t*)(ws + WS_WIN), 1, nullptr, 280, scr, r, lane); continue; } r -= I0;
        if (r < I1) { transpose_item(INF(10), 256, 1536, (bf16_t*)(ws + WS_WUQ), 2, INF(8), 48, scr, r, lane); continue; } r -= I1;
        if (r < I2) { transpose_item(INF(11), 256, 2048, (bf16_t*)(ws + WS_WUKN), 3, INF(9), 32, scr, r, lane); continue; } r -= I2;
        if (r < I3) { transpose_item(INF(11), 256, 2048, (bf16_t*)(ws + WS_WUV), 4, INF(9), 32, scr, r, lane); continue; } r -= I3;
        if (r < I4) { transpose_item(INF(12), 1024, 1024, (bf16_t*)(ws + WS_WOA), 0, nullptr, 32, scr, r, lane); continue; } r -= I4;
        if (r < I5) { transpose_item(INF(19), 2048, 1024, (bf16_t*)(ws + WS_WOB), 0, nullptr, 32, scr, r, lane); continue; } r -= I5;
        if (r < I6) { transpose_item(INF(20), 1024, 1024, (bf16_t*)(ws + WS_WOUT), 0, nullptr, 32, scr, r, lane); continue; } r -= I6;
        if (r < I7) { transpose_item(INF(23), 1024, 4096, (bf16_t*)(ws + WS_WFF1), 0, nullptr, 128, scr, r, lane); continue; } r -= I7;
        transpose_item(INF(24), 4096, 1024, (bf16_t*)(ws + WS_WFF2), 0, nullptr, 32, scr, r, lane);
    }
}
__device__ __forceinline__ void ph_rope_zero() {
    const int tid = ltid(), G = lgrid(), bx = lbid();
    unsigned char* ws = WSB(); float* ROPE = (float*)(ws + WS_ROPE); float* SSQ = (float*)(ws + WS_SSQ); const int* positions = (const int*)in_ptr(2);
    for (int idx = bx * 512 + tid; idx < TT * 32; idx += G * 512) {
        const int t = idx >> 5, i = idx & 31;
        const double ang = (double)positions[t] * ROPE_INV[i];
        const double n = __builtin_rint(ang * 0.15915494309189535);
        const double r = ang - n * 6.283185307179586476925, x2 = r * r;
        double ts = r, s = r, tc = 1.0, c = 1.0;
#pragma unroll
        for (int k = 1; k <= 13; ++k) { ts *= -x2 * (1.0 / (double)((2 * k) * (2 * k + 1))); s += ts; tc *= -x2 * (1.0 / (double)((2 * k - 1) * (2 * k))); c += tc; }
        *(f32x2*)(ROPE + (size_t)idx * 2) = (f32x2){(float)c, (float)s};
    }
    for (int idx = bx * 512 + tid; idx < 4 * TT; idx += G * 512) SSQ[idx] = 0.f;
}
__device__ __forceinline__ void ph_final_rows(int pb) {
    const int tid = ltid(), lane = tid & 63, wid = __builtin_amdgcn_readfirstlane(tid >> 6), G = lgrid(), bx = lbid();
    const int gw = bx * 8 + wid, NGW = G * 8;
    unsigned char* ws = WSB(); const float* SSQ_FF = (const float*)(ws + WS_SSQ) + 3 * TT; const float* MOD = (const float*)(ws + WS_MOD); const bf16_t* FF = (const bf16_t*)(ws + WS_FF);
    const float* g_post_mlp = INF(22); float* out = OUTP();
    for (int m = gw; m < TG; m += NGW) { const int t = pb + m, b = t >> 12;
        const float rs = rsqrtf(SSQ_FF[t] * (1.f / 1024.f) + EPS); const float* gate2 = MOD + b * 6144 + 5120;
#pragma unroll
        for (int j = 0; j < 4; ++j) { const int c0 = 4 * lane + 256 * j; const u32x2 w = *(const u32x2*)(FF + (size_t)m * 1024 + c0);
            f32x4 f = {bflo(w.x), bfhi(w.x), bflo(w.y), bfhi(w.y)}; const f32x4 g = *(const f32x4*)(g_post_mlp + c0), ga = *(const f32x4*)(gate2 + c0);
            f32x4* op = (f32x4*)(out + (size_t)t * 1024 + c0); *op = *op + ga * (f * rs * g); } }
}
__device__ __forceinline__ void ph_hrows(int tbase) {
    const int tid = ltid(), lane = tid & 63, wid = __builtin_amdgcn_readfirstlane(tid >> 6), G = lgrid(), bx = lbid();
    const int gw = bx * 8 + wid, NGW = G * 8;
    unsigned char* ws = WSB(); const float* MOD = (const float*)(ws + WS_MOD); bf16_t* H = (bf16_t*)(ws + WS_H);
    const float* x = INF(0); const float* g_pre_mix = INF(5);
    for (int m = gw; m < TG; m += NGW) { const int t = tbase + m, b = t >> 12;
        const f32x4* xr = (const f32x4*)(x + (size_t)t * 1024) + lane; f32x4 v[4]; float s = 0.f;
#pragma unroll
        for (int j = 0; j < 4; ++j) { v[j] = xr[64 * j]; s += dot4(v[j]); }
        const float rs = rsqrtf(wave_sum(s) * (1.f / 1024.f) + EPS); const float* shift = MOD + b * 6144; const float* scale = shift + 1024;
#pragma unroll
        for (int j = 0; j < 4; ++j) { const int c0 = 4 * lane + 256 * j; const f32x4 g = *(const f32x4*)(g_pre_mix + c0), sc = *(const f32x4*)(scale + c0), sh = *(const f32x4*)(shift + c0);
            const f32x4 hv = v[j] * rs * g * (sc + 1.f) + sh; u32x2 w; w.x = pk2(hv[0], hv[1]); w.y = pk2(hv[2], hv[3]); *(u32x2*)(H + (size_t)m * 1024 + c0) = w; } }
}
__device__ __forceinline__ void ph_proj(LAS unsigned char* lds, int tbase) {
    unsigned char* ws = WSB(); const int G = lgrid(), bx = lbid();
    pg8::Gemm g{(const bf16_t*)(ws + WS_H), (const bf16_t*)(ws + WS_WIN), TG, NPROJ, 1024}; pg8::StaticOrder S; S.init(TG, NPROJ, G, bx);
    float* SSQ = (float*)(ws + WS_SSQ);
    EpiProj E{(bf16_t*)(ws + WS_QL), (bf16_t*)(ws + WS_KVL), (bf16_t*)(ws + WS_KR), (bf16_t*)(ws + WS_Z), (bf16_t*)(ws + WS_XBC), (bf16_t*)(ws + WS_SGA), (bf16_t*)(ws + WS_SGB),
              (float*)(ws + WS_DT), SSQ, SSQ + TT, (const float*)(ws + WS_ROPE), INF(15), tbase};
    pg8::gemm_phase<EpiProj, pg8::StaticOrder, true, true>(lds, g, S, E);
}
__device__ __forceinline__ void ph_upq(LAS unsigned char* lds, int tbase) {
    unsigned char* ws = WSB(); const int G = lgrid(), bx = lbid();
    pg8::Gemm g{(const bf16_t*)(ws + WS_QL), (const bf16_t*)(ws + WS_WUQ), TG, 1536, 256}; pg8::StaticOrder S; S.init(TG, 1536, G, bx);
    EpiQ E{(bf16_t*)(ws + WS_QN), (bf16_t*)(ws + WS_QR), (const float*)(ws + WS_SSQ), (const float*)(ws + WS_ROPE), tbase, 0.07216878364870322f * 1.4426950408889634f};
    pg8::gemm_phase<EpiQ, pg8::StaticOrder, true, true>(lds, g, S, E);
}
__device__ __forceinline__ void ph_upk(LAS unsigned char* lds, int tbase) {
    unsigned char* ws = WSB(); const int G = lgrid(), bx = lbid();
    pg8::Gemm g{(const bf16_t*)(ws + WS_KVL), (const bf16_t*)(ws + WS_WUKN), TG, 1024, 256}; pg8::StaticOrder S; S.init(TG, 1024, G, bx);
    EpiRowScale E{(bf16_t*)(ws + WS_KN), 1024, (const float*)(ws + WS_SSQ) + TT, tbase};
    pg8::gemm_phase<EpiRowScale, pg8::StaticOrder, true, true>(lds, g, S, E);
}
__device__ __forceinline__ void ph_upv(LAS unsigned char* lds, int tbase) {
    unsigned char* ws = WSB(); const int G = lgrid(), bx = lbid();
    pg8::Gemm g{(const bf16_t*)(ws + WS_WUV), (const bf16_t*)(ws + WS_KVL), 1024, TG, 256}; pg8::StaticOrder S; S.init(1024, TG, G, bx);
    EpiColScale E{(bf16_t*)(ws + WS_VT), TG, (const float*)(ws + WS_SSQ) + TT, tbase};
    pg8::gemm_phase<EpiColScale, pg8::StaticOrder, true, true>(lds, g, S, E);
}
__device__ __forceinline__ void ph_conv(LAS unsigned char* lds) {
    const int tid = ltid(), G = lgrid(), bx = lbid();
    unsigned char* ws = WSB(); const bf16_t* XBC = (const bf16_t*)(ws + WS_XBC);
    const float* conv_w = INF(13); const float* conv_b = INF(14);
    for (int item = bx; item < NB * 32 * 64; item += G) {
        const int slab = item & 63, c = (item >> 6) & 31, b = item >> 11;
        LAS unsigned char* tile = lds;
        for (int p = tid; p < 131 * 8; p += 512) { const int r = p >> 3, cc = p & 7; const int trow = c * 128 + r - 3;
            u32x4 v = {0u, 0u, 0u, 0u}; if (trow >= 0) v = *(const u32x4*)(XBC + (size_t)(b * SEQ + trow) * 4096 + slab * 64 + cc * 8);
            *(LAS u32x4*)(tile + r * 144 + cc * 16) = v; }
        __syncthreads();
        const int ch0 = slab * 64;
        if (slab < 48) {
            bf16_t* dst;
            if (slab < 32) { const int bl = (b * 32 + c) * 8 + (slab >> 2); dst = (bf16_t*)(ws + WS_XT) + ((size_t)(bl * 4 + (slab & 3)) * 64) * 128; }
            else { const int bl = (b * 32 + c) * 8 + ((slab - 32) >> 1); dst = (bf16_t*)(ws + WS_BT) + ((size_t)bl * 128 + ((slab - 32) & 1) * 64) * 128; }
#pragma unroll 1
            for (int q = 0; q < 2; ++q) { const int task = tid + 512 * q, ch = task & 63, l0 = (task >> 6) * 8;
                const float w0 = conv_w[ch0 + ch], w1 = conv_w[4096 + ch0 + ch], w2 = conv_w[8192 + ch0 + ch], w3 = conv_w[12288 + ch0 + ch], bb = conv_b[ch0 + ch];
                float uu[11];
#pragma unroll
                for (int i = 0; i < 11; ++i) uu[i] = __builtin_bit_cast(float, (unsigned)(*(const LAS unsigned short*)(tile + (l0 + i) * 144 + ch * 2)) << 16);
                float ov[8];
#pragma unroll
                for (int j = 0; j < 8; ++j) ov[j] = silu(bb + w0 * uu[j] + w1 * uu[j + 1] + w2 * uu[j + 2] + w3 * uu[j + 3]);
                u32x4 w; w.x = pk2(ov[0], ov[1]); w.y = pk2(ov[2], ov[3]); w.z = pk2(ov[4], ov[5]); w.w = pk2(ov[6], ov[7]);
                *(u32x4*)(dst + (size_t)ch * 128 + l0) = w; }
        }
        if (slab >= 32) {
            const int s2 = slab - (slab < 48 ? 32 : 48); const int bl = (b * 32 + c) * 8 + (s2 >> 1);
            bf16_t* dst = (bf16_t*)(ws + (slab < 48 ? WS_BC : WS_CC)) + (size_t)bl * 128 * 128 + (s2 & 1) * 64;
#pragma unroll 1
            for (int q = 0; q < 2; ++q) { const int task = tid + 512 * q, cgp = task & 7, l = task >> 3; const int chb = ch0 + cgp * 8;
                f32x4 a0 = *(const f32x4*)(conv_b + chb), a1 = *(const f32x4*)(conv_b + chb + 4);
#pragma unroll
                for (int k = 0; k < 4; ++k) { const u32x4 uw = *(const LAS u32x4*)(tile + (l + k) * 144 + cgp * 16);
                    const f32x4 wa = *(const f32x4*)(conv_w + k * 4096 + chb), wb = *(const f32x4*)(conv_w + k * 4096 + chb + 4);
                    const f32x4 u0 = {bflo(uw.x), bfhi(uw.x), bflo(uw.y), bfhi(uw.y)}, u1 = {bflo(uw.z), bfhi(uw.z), bflo(uw.w), bfhi(uw.w)};
                    a0 += wa * u0; a1 += wb * u1; }
#pragma unroll
                for (int e = 0; e < 4; ++e) { a0[e] = silu(a0[e]); a1[e] = silu(a1[e]); }
                st8(dst + (size_t)l * 128 + cgp * 8, a0, a1); }
        }
        __syncthreads();
    }
}
__device__ __forceinline__ void ph_states(LAS unsigned char* lds) {
    const int tid = ltid(), lane = tid & 63, wid = __builtin_amdgcn_readfirstlane(tid >> 6), G = lgrid(), bx = lbid();
    unsigned char* ws = WSB(); const float* DT = (const float*)(ws + WS_DT); float* DEC = (float*)(ws + WS_DEC); const float* a_log = INF(16);
    for (int item = bx; item < NB * 32 * 8; item += G) {
        const int bl = item, g = item & 7, c = (item >> 3) & 31, b = item >> 8;
        LAS unsigned char* XTs = lds; LAS unsigned char* BTs = lds + 256 * SP;
        LAS float* dts = (LAS float*)(lds + 384 * SP); LAS float* acs = dts + 512; LAS float* wsc = acs + 512;
        ld_tile(XTs, (const bf16_t*)(ws + WS_XT) + (size_t)bl * 4 * 8192, 256); ld_tile(BTs, (const bf16_t*)(ws + WS_BT) + (size_t)bl * 16384, 128);
        chunk_prep(dts, acs, DT, b * SEQ + c * 128, g, a_log);
        { const int hh = tid >> 7; wsc[tid] = dts[tid] * __expf(acs[hh * 128 + 127] - acs[tid]); }
        if (tid < 4) DEC[(b * 32 + c) * 32 + g * 4 + tid] = __expf(acs[tid * 128 + 127]);
        __syncthreads();
        const int r32 = lane & 31, hf = lane >> 5, pb = wid >> 2, nb = wid & 3;
#pragma unroll 1
        for (int hh = 0; hh < 4; ++hh) {
            f32x16 acc;
#pragma unroll
            for (int r = 0; r < 16; ++r) acc[r] = 0.f;
#pragma unroll 2
            for (int ks = 0; ks < 8; ++ks) {
                const u32x4 xa = *(const LAS u32x4*)(XTs + (hh * 64 + pb * 32 + r32) * SP + (ks * 16 + hf * 8) * 2);
                const LAS f32x4* wp = (const LAS f32x4*)(wsc + hh * 128 + ks * 16 + hf * 8); const f32x4 w0 = wp[0], w1 = wp[1];
                u32x4 xs; xs.x = pk2(bflo(xa.x) * w0[0], bfhi(xa.x) * w0[1]); xs.y = pk2(bflo(xa.y) * w0[2], bfhi(xa.y) * w0[3]);
                xs.z = pk2(bflo(xa.z) * w1[0], bfhi(xa.z) * w1[1]); xs.w = pk2(bflo(xa.w) * w1[2], bfhi(xa.w) * w1[3]);
                const bf16x8 bb = ldsfrag(BTs, nb * 32 + r32, ks * 16 + hf * 8);
                acc = __builtin_amdgcn_mfma_f32_32x32x16_bf16(__builtin_bit_cast(bf16x8, xs), bb, acc, 0, 0, 0);
            }
            float* sp = (float*)(ws + WS_ST) + ((size_t)bl * 4 + hh) * 8192 + nb * 32 + r32;
#pragma unroll
            for (int r = 0; r < 16; ++r) sp[(pb * 32 + (r & 3) + 8 * (r >> 2) + 4 * hf) * 128] = acc[r];
        }
        __syncthreads();
    }
}
__device__ __forceinline__ void ph_scan() {
    const int tid = ltid(), G = lgrid(), bx = lbid();
    unsigned char* ws = WSB(); const float* ST = (const float*)(ws + WS_ST); bf16_t* HP = (bf16_t*)(ws + WS_HP); const float* DEC = (const float*)(ws + WS_DEC);
    for (int e = bx * 512 + tid; e < NB * 32 * 2048; e += G * 512) {
        const int bgh = e >> 11, pn4 = e & 2047, b = bgh >> 5, gh = bgh & 31;
        f32x4 st = {0.f, 0.f, 0.f, 0.f};
#pragma unroll 4
        for (int c = 0; c < 32; ++c) { const size_t off = ((size_t)((b * 32 + c) * 32 + gh)) * 8192 + pn4 * 4;
            const f32x4 s = *(const f32x4*)(ST + off); u32x2 w; w.x = pk2(st[0], st[1]); w.y = pk2(st[2], st[3]); *(u32x2*)(HP + off) = w;
            st = st * DEC[(b * 32 + c) * 32 + gh] + s; }
    }
}
__device__ __forceinline__ void ph_attn(LAS unsigned char* lds) {
    const int G = lgrid(), bx = lbid();
    unsigned char* ws = WSB();
    const bf16_t* QN = (const bf16_t*)(ws + WS_QN); const bf16_t* QR = (const bf16_t*)(ws + WS_QR); const bf16_t* KN = (const bf16_t*)(ws + WS_KN);
    const bf16_t* KR = (const bf16_t*)(ws + WS_KR); const bf16_t* VT = (const bf16_t*)(ws + WS_VT); bf16_t* ATT = (bf16_t*)(ws + WS_ATT);
    for (int pi = bx; pi < NB * 64; pi += G) { const int b = pi >> 6, h = (pi >> 3) & 7, j = pi & 7;
#pragma unroll 1
        for (int k = 0; k < 2; ++k) attn_unit(lds, QN, QR, KN, KR, VT, ATT, b, h, k ? j : 15 - j); }
    __syncthreads();
}
__device__ __forceinline__ void ph_ssdc(LAS unsigned char* lds) {
    const int tid = ltid(), lane = tid & 63, wid = __builtin_amdgcn_readfirstlane(tid >> 6), G = lgrid(), bx = lbid();
    unsigned char* ws = WSB(); const float* DT = (const float*)(ws + WS_DT); const float* a_log = INF(16);
    for (int item = bx; item < NB * 32 * 8; item += G) {
        const int bl = item, g = item & 7, c = (item >> 3) & 31, b = item >> 8;
        const int trow0 = b * SEQ + c * 128;
        LAS unsigned char* Cs = lds; LAS unsigned char* Bs = lds + 128 * SP; LAS unsigned char* Ms = lds + 256 * SP;
        LAS unsigned char* XTs = Bs; LAS unsigned char* HPs = Bs + 64 * SP;
        LAS float* dts = (LAS float*)(lds + 384 * SP); LAS float* acs = dts + 512; LAS float* rowp = acs + 512;
        ld_tile(Cs, (const bf16_t*)(ws + WS_CC) + (size_t)bl * 16384, 128); ld_tile(Bs, (const bf16_t*)(ws + WS_BC) + (size_t)bl * 16384, 128);
        chunk_prep(dts, acs, DT, trow0, g, a_log);
        const int r32 = lane & 31, hf = lane >> 5;
        const int lb = wid >> 1, sb0 = (wid & 1) * 2;
        f32x16 cb[2];
#pragma unroll
        for (int j = 0; j < 2; ++j) {
#pragma unroll
            for (int r = 0; r < 16; ++r) cb[j][r] = 0.f;
#pragma unroll 2
            for (int ks = 0; ks < 8; ++ks) cb[j] = __builtin_amdgcn_mfma_f32_32x32x16_bf16(ldsfrag(Cs, lb * 32 + r32, ks * 16 + hf * 8), ldsfrag(Bs, (sb0 + j) * 32 + r32, ks * 16 + hf * 8), cb[j], 0, 0, 0);
        }
        __syncthreads();
        const int pb = wid & 1, lq = wid >> 1;
        float ssq = 0.f;
        bf16_t* op = (bf16_t*)(ws + WS_SSM) + (size_t)(trow0 + lq * 32 + r32) * 2048 + g * 256 + pb * 32 + 4 * hf;
#pragma unroll 1
        for (int hh = 0; hh < 4; ++hh) {
            ld_tile(XTs, (const bf16_t*)(ws + WS_XT) + ((size_t)bl * 4 + hh) * 8192, 64); ld_tile(HPs, (const bf16_t*)(ws + WS_HP) + ((size_t)bl * 4 + hh) * 8192, 64);
            const float dsk = INF(17)[g * 4 + hh];
#pragma unroll
            for (int j = 0; j < 2; ++j) { const int s = (sb0 + j) * 32 + r32; const float as = acs[hh * 128 + s], ds = dts[hh * 128 + s];
#pragma unroll
                for (int r = 0; r < 16; ++r) { const int l = lb * 32 + (r & 3) + 8 * (r >> 2) + 4 * hf;
                    const float al = acs[hh * 128 + l];
                    float val = cb[j][r] * __expf(fminf(al - as, 0.f)) * ds;
                    if (s == l) val += dsk;
                    if (s > l) val = 0.f;
                    *(LAS unsigned short*)(Ms + l * SP + s * 2) = (unsigned short)(pk2(val, 0.f) & 0xffffu); } }
            __syncthreads();
            f32x16 yd;
#pragma unroll
            for (int r = 0; r < 16; ++r) yd[r] = 0.f;
#pragma unroll 2
            for (int ks = 0; ks < 8; ++ks) yd = __builtin_amdgcn_mfma_f32_32x32x16_bf16(ldsfrag(HPs, pb * 32 + r32, ks * 16 + hf * 8), ldsfrag(Cs, lq * 32 + r32, ks * 16 + hf * 8), yd, 0, 0, 0);
            const float ea = __expf(acs[hh * 128 + lq * 32 + r32]);
#pragma unroll
            for (int r = 0; r < 16; ++r) yd[r] *= ea;
#pragma unroll 2
            for (int ks = 0; ks < 8; ++ks) yd = __builtin_amdgcn_mfma_f32_32x32x16_bf16(ldsfrag(XTs, pb * 32 + r32, ks * 16 + hf * 8), ldsfrag(Ms, lq * 32 + r32, ks * 16 + hf * 8), yd, 0, 0, 0);
            const bf16_t* zp = (const bf16_t*)(ws + WS_Z) + (size_t)(trow0 + lq * 32 + r32) * 2048 + g * 256 + hh * 64 + pb * 32 + 4 * hf;
#pragma unroll
            for (int rg = 0; rg < 4; ++rg) { const u32x2 zw = *(const u32x2*)(zp + 8 * rg); const float zz[4] = {bflo(zw.x), bfhi(zw.x), bflo(zw.y), bfhi(zw.y)};
                float v[4];
#pragma unroll
                for (int e = 0; e < 4; ++e) { v[e] = yd[4 * rg + e] * silu(zz[e]); ssq += v[e] * v[e]; }
                u32x2 w; w.x = pk2(v[0], v[1]); w.y = pk2(v[2], v[3]); *(u32x2*)(op + hh * 64 + 8 * rg) = w; }
            __syncthreads();
        }
        asm volatile("s_waitcnt vmcnt(0)" ::: "memory");
        rowp[(pb * 2 + hf) * 128 + lq * 32 + r32] = ssq;
        __syncthreads();
        { const int l = lq * 32 + r32; const float rs = rsqrtf((rowp[l] + rowp[128 + l] + rowp[256 + l] + rowp[384 + l]) * (1.f / 256.f) + EPS);
          const float* gp = INF(18) + g * 256 + pb * 32 + 4 * hf;
#pragma unroll 1
          for (int hh = 0; hh < 4; ++hh)
#pragma unroll
              for (int rg = 0; rg < 4; ++rg) { const f32x4 gs = *(const f32x4*)(gp + hh * 64 + 8 * rg);
                  const unsigned long long yraw = __hip_atomic_load((const unsigned long long*)(op + hh * 64 + 8 * rg), __ATOMIC_RELAXED, __HIP_MEMORY_SCOPE_AGENT);
                  u32x2 yw; yw.x = (unsigned)yraw; yw.y = (unsigned)(yraw >> 32);
                  u32x2 w; w.x = pk2(bflo(yw.x) * rs * gs[0], bfhi(yw.x) * rs * gs[1]); w.y = pk2(bflo(yw.y) * rs * gs[2], bfhi(yw.y) * rs * gs[3]);
                  *(u32x2*)(op + hh * 64 + 8 * rg) = w; } }
        __syncthreads();
    }
}
__device__ __forceinline__ void ph_merge_a(LAS unsigned char* lds) {
    unsigned char* ws = WSB(); const int G = lgrid(), bx = lbid();
    pg8::Gemm g{(const bf16_t*)(ws + WS_ATT), (const bf16_t*)(ws + WS_WOA), TG, 1024, 1024}; pg8::StaticOrder S; S.init(TG, 1024, G, bx);
    EpiGate<0> E{(bf16_t*)(ws + WS_MA), (const bf16_t*)(ws + WS_SGA), nullptr};
    pg8::gemm_phase<EpiGate<0>, pg8::StaticOrder, true, true>(lds, g, S, E);
    asm volatile("s_waitcnt vmcnt(0)" ::: "memory");
}
__device__ __forceinline__ void ph_merge_b(LAS unsigned char* lds) {
    unsigned char* ws = WSB(); const int G = lgrid(), bx = lbid();
    pg8::Gemm g{(const bf16_t*)(ws + WS_SSM), (const bf16_t*)(ws + WS_WOB), TG, 1024, 2048}; pg8::StaticOrder S; S.init(TG, 1024, G, bx);
    EpiGate<1> E{(bf16_t*)(ws + WS_MERGED), (const bf16_t*)(ws + WS_SGB), (const bf16_t*)(ws + WS_MA)};
    pg8::gemm_phase<EpiGate<1>, pg8::StaticOrder, true, true>(lds, g, S, E);
}
__device__ __forceinline__ void ph_mix(LAS unsigned char* lds, int tbase) {
    unsigned char* ws = WSB(); const int G = lgrid(), bx = lbid();
    pg8::Gemm g{(const bf16_t*)(ws + WS_MERGED), (const bf16_t*)(ws + WS_WOUT), TG, 1024, 1024}; pg8::StaticOrder S; S.init(TG, 1024, G, bx);
    EpiSsq E{(bf16_t*)(ws + WS_MIX), 1024, (float*)(ws + WS_SSQ) + 2 * TT, tbase};
    pg8::gemm_phase<EpiSsq, pg8::StaticOrder, true, true>(lds, g, S, E);
}
__device__ __forceinline__ void ph_x1rows(int tbase) {
    const int tid = ltid(), lane = tid & 63, wid = __builtin_amdgcn_readfirstlane(tid >> 6), G = lgrid(), bx = lbid();
    const int gw = bx * 8 + wid, NGW = G * 8;
    unsigned char* ws = WSB(); const float* SSQ_MIX = (const float*)(ws + WS_SSQ) + 2 * TT; const float* MOD = (const float*)(ws + WS_MOD);
    const bf16_t* MIX = (const bf16_t*)(ws + WS_MIX); bf16_t* H = (bf16_t*)(ws + WS_H);
    const float* x = INF(0); const float* g_post_mix = INF(6); const float* g_pre_mlp = INF(21); float* out = OUTP();
    for (int m = gw; m < TG; m += NGW) { const int t = tbase + m, b = t >> 12;
        const float rs1 = rsqrtf(SSQ_MIX[t] * (1.f / 1024.f) + EPS); const float* mod = MOD + b * 6144;
        f32x4 v[4]; float s = 0.f;
#pragma unroll
        for (int j = 0; j < 4; ++j) { const int c0 = 4 * lane + 256 * j; const u32x2 w = *(const u32x2*)(MIX + (size_t)m * 1024 + c0);
            const f32x4 f = {bflo(w.x), bfhi(w.x), bflo(w.y), bfhi(w.y)}; const f32x4 g = *(const f32x4*)(g_post_mix + c0), ga = *(const f32x4*)(mod + 2048 + c0);
            v[j] = *(const f32x4*)(x + (size_t)t * 1024 + c0) + ga * (f * rs1 * g); *(f32x4*)(out + (size_t)t * 1024 + c0) = v[j]; s += dot4(v[j]); }
        const float rs2 = rsqrtf(wave_sum(s) * (1.f / 1024.f) + EPS);
#pragma unroll
        for (int j = 0; j < 4; ++j) { const int c0 = 4 * lane + 256 * j; const f32x4 g = *(const f32x4*)(g_pre_mlp + c0), sc = *(const f32x4*)(mod + 4096 + c0), sh = *(const f32x4*)(mod + 3072 + c0);
            const f32x4 hv = v[j] * rs2 * g * (sc + 1.f) + sh; u32x2 w; w.x = pk2(hv[0], hv[1]); w.y = pk2(hv[2], hv[3]); *(u32x2*)(H + (size_t)m * 1024 + c0) = w; } }
}
__device__ __forceinline__ void ph_ff1(LAS unsigned char* lds) {
    unsigned char* ws = WSB(); const int G = lgrid(), bx = lbid();
    pg8::Gemm g{(const bf16_t*)(ws + WS_H), (const bf16_t*)(ws + WS_WFF1), TG, 4096, 1024}; pg8::StaticOrder S; S.init(TG, 4096, G, bx);
    EpiRelu2 E{(bf16_t*)(ws + WS_FF1), 4096};
    pg8::gemm_phase<EpiRelu2, pg8::StaticOrder, true, true>(lds, g, S, E);
}
__device__ __forceinline__ void ph_ff2(LAS unsigned char* lds, int tbase) {
    unsigned char* ws = WSB(); const int G = lgrid(), bx = lbid();
    pg8::Gemm g{(const bf16_t*)(ws + WS_FF1), (const bf16_t*)(ws + WS_WFF2), TG, 1024, 4096}; pg8::StaticOrder S; S.init(TG, 1024, G, bx);
    EpiSsq E{(bf16_t*)(ws + WS_FF), 1024, (float*)(ws + WS_SSQ) + 3 * TT, tbase};
    pg8::gemm_phase<EpiSsq, pg8::StaticOrder, true, true>(lds, g, S, E);
}

__global__ void __launch_bounds__(512, 2) mega(Args a) {
    extern __shared__ __attribute__((aligned(16))) unsigned char lds_raw[];
    LAS unsigned char* lds = (LAS unsigned char*)lds_raw;
    cg::grid_group grid = cg::this_grid();
#ifndef NO_MOD
    ph_mod(lds);
#endif
#ifndef NO_WCP
    ph_wcopy(lds);
#endif
    ph_rope_zero();
    grid.sync();
#pragma unroll 1
    for (int rd = 0; rd < NROUND; ++rd) {
        const int tbase = rd * TG;
        if (rd > 0) ph_final_rows(tbase - TG);
        ph_hrows(tbase);
        grid.sync();
#ifndef NO_GB
        ph_proj(lds, tbase);
#endif
        grid.sync();
#ifndef NO_GC
        ph_upq(lds, tbase); ph_upk(lds, tbase); ph_upv(lds, tbase);
#endif
#ifndef NO_CONV
        ph_conv(lds);
#endif
        grid.sync();
#ifndef NO_PD
        ph_states(lds);
#endif
        grid.sync();
        ph_scan();
        grid.sync();
#ifndef NO_ATT
        ph_attn(lds);
#endif
#ifndef NO_SSDC
        ph_ssdc(lds);
#endif
        grid.sync();
#ifndef NO_GG
        ph_merge_a(lds); ph_merge_b(lds);
#endif
        grid.sync();
#ifndef NO_GH
        ph_mix(lds, tbase);
#endif
        grid.sync();
        ph_x1rows(tbase);
        grid.sync();
#ifndef NO_GJ
        ph_ff1(lds);
#endif
        grid.sync();
#ifndef NO_GK
        ph_ff2(lds, tbase);
#endif
        grid.sync();
    }
    ph_final_rows(TT - TG);
}


extern "C" void kernel_launch(void* const* d_in, const int* in_sizes, int n_in, void* d_out, int out_size, void* d_ws, size_t ws_size, hipStream_t stream) {
    static int grid = 0;
    if (grid == 0) {
        if (n_in != 25 || out_size != TT * DM || ws_size < WS_END) { fprintf(stderr, "kernel_launch: unexpected problem (n_in %d out %d ws %zu)\n", n_in, out_size, ws_size); grid = -1; return; }
        int dev = 0, cus = 0, per_cu = 0;
        hipGetDevice(&dev); hipDeviceGetAttribute(&cus, hipDeviceAttributeMultiprocessorCount, dev);
        hipFuncSetAttribute((const void*)mega, hipFuncAttributeMaxDynamicSharedMemorySize, LDS_BYTES);
        hipOccupancyMaxActiveBlocksPerMultiprocessor(&per_cu, (const void*)mega, 512, LDS_BYTES);
        (void)hipGetLastError();
        if (per_cu < 1) per_cu = 1;
        grid = cus;
    }
    if (grid < 0) return;
    Args a{};
    for (int i = 0; i < 25; ++i) a.in[i] = d_in[i];
    a.out = (float*)d_out; a.ws = (unsigned char*)d_ws;
    void* args[] = {&a};
    hipError_t e = hipLaunchCooperativeKernel((const void*)mega, dim3(grid), dim3(512), args, LDS_BYTES, stream);
    if (e != hipSuccess) fprintf(stderr, "cooperative launch failed: %s (grid %d)\n", hipGetErrorString(e), grid);
}
```

```cpp
#include <hip/hip_runtime.h>
#include <hip/hip_cooperative_groups.h>
#include <cstdio>
#include <cstdint>
namespace cg = cooperative_groups;
#ifndef DUP_ATT
#define DUP_ATT 0
#endif
#ifndef DUP_SYNC
#define DUP_SYNC 0
#endif
#ifndef DUP_CONV
#define DUP_CONV 0
#endif
#ifndef DUP_SSDC
#define DUP_SSDC 0
#endif
#define GSYNC() do { xcd_barrier(xbar); if (DUP_SYNC) xcd_barrier(xbar); } while (0)

#define LAS __attribute__((address_space(3)))
typedef unsigned short bf16_t;
typedef short bf16x8 __attribute__((ext_vector_type(8)));
typedef float f32x4 __attribute__((ext_vector_type(4)));
typedef float f32x2 __attribute__((ext_vector_type(2)));
typedef float f32x16 __attribute__((ext_vector_type(16)));
typedef unsigned u32x4 __attribute__((ext_vector_type(4)));
typedef unsigned u32x2 __attribute__((ext_vector_type(2)));

__device__ __forceinline__ int ltid() { int t = threadIdx.x; asm volatile("" : "+v"(t)); return t; }
__device__ __forceinline__ int lbid() { int b = blockIdx.x; asm volatile("" : "+s"(b)); return b; }
__device__ __forceinline__ int lgrid() { int g = gridDim.x; asm volatile("" : "+s"(g)); return g; }

namespace pg8 {
#define PG8_LAS __attribute__((address_space(3)))
constexpr int BM = 256, BK = 64, HALF = 128, HTB = HALF * BK * 2, STAGE_BYTES = 8 * HTB, NXCD = 8, WGM = 8;
__host__ __device__ __forceinline__ int lds_byte(int r, int c) { const int st = (r >> 4) * 2 + (c >> 5), rr = r & 15, cc = c & 31, ob = rr * 64 + cc * 2; return st * 1024 + (ob ^ (((ob >> 9) & 1) << 5)); }
__host__ __device__ __forceinline__ void stage_rc(int b, int& R, int& C) { const int st = b / 1024, sb = b % 1024, swz = sb ^ (((sb >> 9) & 1) << 5); R = (st >> 1) * 16 + swz / 64; C = (st & 1) * 32 + (swz % 64) / 2; }
__host__ __device__ __forceinline__ int perm32(int rho) { const int n = rho >> 4, i = rho & 15; return 8 * (i >> 2) + 4 * n + (i & 3); }
struct Unit { int pm, pn; };
struct Gemm { const bf16_t* A; const bf16_t* Bt; int M, N, K; };
struct StaticOrder {
    int nM, nN, nwg, G, c;
    __host__ __device__ void init(int M, int N, int G_, int c_) { nM = M / BM; nN = N / BM; nwg = nM * nN; G = G_; c = c_; }
    __host__ __device__ bool next(int i, Unit& u) const {
        const long L = (long)i * G + c; if (L >= nwg) return false;
        int wgid = (int)L; { const int q = nwg / NXCD, r = nwg % NXCD, xcd = wgid % NXCD, off = wgid / NXCD; wgid = (xcd < r ? xcd * (q + 1) : r * (q + 1) + (xcd - r) * q) + off; }
        const int nig = WGM * nN, gid = wgid / nig, fm = gid * WGM, gsz = (nM - fm) < WGM ? (nM - fm) : WGM;
        u.pm = fm + ((wgid % nig) % gsz); u.pn = (wgid % nig) / gsz; return true;
    }
    __device__ __forceinline__ void a_ready(const Unit&) const {}
    __device__ __forceinline__ void done(const Unit&) const {}
};
__device__ __forceinline__ unsigned cvt_pk_bf16(float lo, float hi) { unsigned r; asm volatile("v_cvt_pk_bf16_f32 %0, %1, %2" : "=v"(r) : "v"(lo), "v"(hi)); return r; }

template <class Epi, class Sched, bool ALIGN_EPI = false, bool SP2 = false>
__device__ __forceinline__ void gemm_phase(PG8_LAS unsigned char* lds, const Gemm g, const Sched& S, const Epi& E) {
    const int tid = ltid(), wid = __builtin_amdgcn_readfirstlane(tid >> 6), lane = tid & 63, wr = wid >> 2, wc = wid & 3, fr = lane & 15, fq = lane >> 4;
    const int K = g.K, nt = K / BK;
    unsigned voffA[2], voffB[2];
#pragma unroll
    for (int i = 0; i < 2; ++i) { int R, C; stage_rc(tid * 16 + i * 8192, R, C); const int Rb = Epi::PERM ? ((R & ~31) + perm32(R & 31)) : R;
        voffA[i] = (unsigned)(R * K + C) * 2u; voffB[i] = (unsigned)(Rb * K + C) * 2u; }
    const size_t kstep = (size_t)(BK * 2);
    const size_t hstep = (size_t)HALF * K * 2;
    const size_t tstep = 2 * hstep;
    const unsigned ldsw = (unsigned)wid * 1024u;
    const int aoff = lds_byte(wr * 64 + fr, fq * 8), boff = lds_byte(wc * 32 + fr, fq * 8);
#define PG8_SA(b, h) (((b) * 2 + (h)) * HTB)
#define PG8_SB(b, h) ((4 + (b) * 2 + (h)) * HTB)
#define PG8_STAGE(bufoff, gbase, voff) do { _Pragma("unroll") for (int _i = 0; _i < 2; ++_i) \
        __builtin_amdgcn_global_load_lds((const unsigned*)((const char*)(gbase) + (voff)[_i]), (PG8_LAS unsigned*)(lds + (bufoff) + ldsw + _i * 8192), 16, 0, 0); } while (0)
#define PG8_LDA(dst, b, h) do { _Pragma("unroll") for (int m = 0; m < 4; ++m) _Pragma("unroll") for (int k = 0; k < 2; ++k) dst[m][k] = *(const PG8_LAS bf16x8*)(lds + PG8_SA(b, h) + aoff + m * 2048 + k * 1024); } while (0)
#define PG8_LDB(dst, b, h) do { _Pragma("unroll") for (int n = 0; n < 2; ++n) _Pragma("unroll") for (int k = 0; k < 2; ++k) dst[n][k] = *(const PG8_LAS bf16x8*)(lds + PG8_SB(b, h) + boff + n * 2048 + k * 1024); } while (0)
#define PG8_MMA(ai, bj, At, Bt) do { __builtin_amdgcn_s_setprio(1); _Pragma("unroll") for (int m = 0; m < 4; ++m) _Pragma("unroll") for (int n = 0; n < 2; ++n) _Pragma("unroll") for (int k = 0; k < 2; ++k) \
        acc[ai][bj][m][n] = __builtin_amdgcn_mfma_f32_16x16x32_bf16(Bt[n][k], At[m][k], acc[ai][bj][m][n], 0, 0, 0); __builtin_amdgcn_s_setprio(0); } while (0)
#define PG8_WAIT_V(n) asm volatile("s_waitcnt vmcnt(" #n ")" ::: "memory")
#define PG8_WAIT_L(n) asm volatile("s_waitcnt lgkmcnt(" #n ")" ::: "memory")
#define PG8_BAR __builtin_amdgcn_s_barrier()
#define PG8_SCHED __builtin_amdgcn_sched_barrier(0)
    Unit cur, nxt; int ui = 0;
    if (!S.next(0, cur)) return;
    f32x4 acc[2][2][4][2];
#pragma unroll
    for (int a = 0; a < 2; ++a)
#pragma unroll
        for (int b = 0; b < 2; ++b)
#pragma unroll
            for (int m = 0; m < 4; ++m)
#pragma unroll
                for (int n = 0; n < 2; ++n) acc[a][b][m][n] = (f32x4){0.f, 0.f, 0.f, 0.f};
    bf16x8 At[4][2], B0[2][2], B1[2][2];
    const char* cA = (const char*)g.A + (size_t)cur.pm * tstep; const char* cB = (const char*)g.Bt + (size_t)cur.pn * tstep;
    S.a_ready(cur);
    if constexpr (SP2) {
        PG8_STAGE(PG8_SB(0, 0), cB, voffB); PG8_STAGE(PG8_SB(0, 1), cB + hstep, voffB); PG8_STAGE(PG8_SA(0, 0), cA, voffA); PG8_STAGE(PG8_SA(0, 1), cA + hstep, voffA);
        if (wr == 1) PG8_BAR;
        PG8_WAIT_V(2); PG8_BAR;
        PG8_STAGE(PG8_SB(1, 0), cB + kstep, voffB); PG8_STAGE(PG8_SA(1, 0), cA + kstep, voffA); PG8_STAGE(PG8_SB(1, 1), cB + hstep + kstep, voffB);
        PG8_WAIT_V(6); PG8_BAR;
    } else {
        PG8_STAGE(PG8_SB(0, 0), cB, voffB); PG8_STAGE(PG8_SA(0, 0), cA, voffA); PG8_STAGE(PG8_SB(0, 1), cB + hstep, voffB); PG8_STAGE(PG8_SA(0, 1), cA + hstep, voffA);
        if (wr == 1) PG8_BAR;
        PG8_WAIT_V(4); PG8_BAR;
        PG8_STAGE(PG8_SB(1, 0), cB + kstep, voffB); PG8_STAGE(PG8_SA(1, 0), cA + kstep, voffA); PG8_STAGE(PG8_SB(1, 1), cB + hstep + kstep, voffB);
        PG8_WAIT_V(6); PG8_BAR;
    }
    for (;;) {
        const bool has_next = S.next(ui + 1, nxt);
        const char* nA = has_next ? (const char*)g.A + (size_t)nxt.pm * tstep : cA; const char* nB = has_next ? (const char*)g.Bt + (size_t)nxt.pn * tstep : cB;
#pragma unroll 1
        for (int t = 0; t < nt; t += 2) {
            const bool last = (t == nt - 2);
            const char* a1 = cA + (size_t)(t + 1) * kstep;
            const char* a2 = last ? nA : cA + (size_t)(t + 2) * kstep; const char* b2 = last ? nB : cB + (size_t)(t + 2) * kstep;
            const char* a3 = a2 + kstep; const char* b3 = b2 + kstep;
            if (last && has_next) S.a_ready(nxt);
            if constexpr (SP2) {
            PG8_LDB(B0, 0, 0); PG8_LDB(B1, 0, 1); PG8_SCHED; PG8_LDA(At, 0, 0); PG8_STAGE(PG8_SA(1, 1), a1 + hstep, voffA);
            PG8_WAIT_V(8); PG8_WAIT_L(0); PG8_BAR; PG8_MMA(0, 0, At, B0); PG8_MMA(0, 1, At, B1); PG8_BAR; PG8_SCHED;
            PG8_LDA(At, 0, 1); PG8_STAGE(PG8_SB(0, 0), b2, voffB); PG8_STAGE(PG8_SB(0, 1), b2 + hstep, voffB); PG8_STAGE(PG8_SA(0, 0), a2, voffA);
            PG8_WAIT_V(8); PG8_WAIT_L(0); PG8_BAR; PG8_MMA(1, 0, At, B0); PG8_MMA(1, 1, At, B1); PG8_BAR; PG8_SCHED;
            PG8_LDB(B0, 1, 0); PG8_LDB(B1, 1, 1); PG8_SCHED; PG8_LDA(At, 1, 0); PG8_STAGE(PG8_SA(0, 1), a2 + hstep, voffA);
            PG8_WAIT_V(8); PG8_WAIT_L(0); PG8_BAR; PG8_MMA(0, 0, At, B0); PG8_MMA(0, 1, At, B1); PG8_BAR; PG8_SCHED;
            PG8_LDA(At, 1, 1); PG8_STAGE(PG8_SB(1, 0), b3, voffB); PG8_STAGE(PG8_SB(1, 1), b3 + hstep, voffB); PG8_STAGE(PG8_SA(1, 0), a3, voffA);
            PG8_WAIT_V(8); PG8_WAIT_L(0); PG8_BAR; PG8_MMA(1, 0, At, B0); PG8_MMA(1, 1, At, B1); PG8_BAR; PG8_SCHED;
            } else {
            PG8_LDB(B0, 0, 0); PG8_SCHED; PG8_LDA(At, 0, 0); PG8_STAGE(PG8_SA(1, 1), a1 + hstep, voffA);
            PG8_WAIT_L(8); PG8_BAR; PG8_WAIT_L(0); PG8_MMA(0, 0, At, B0); PG8_BAR; PG8_SCHED;
            PG8_LDB(B1, 0, 1); PG8_STAGE(PG8_SB(0, 0), b2, voffB);
            PG8_BAR; PG8_WAIT_L(0); PG8_MMA(0, 1, At, B1); PG8_BAR;
            PG8_LDA(At, 0, 1); PG8_STAGE(PG8_SA(0, 0), a2, voffA);
            PG8_BAR; PG8_WAIT_L(0); PG8_MMA(1, 0, At, B0); PG8_BAR; PG8_SCHED;
            PG8_STAGE(PG8_SB(0, 1), b2 + hstep, voffB);
            PG8_WAIT_V(6); PG8_BAR; PG8_MMA(1, 1, At, B1); PG8_BAR;
            PG8_LDB(B0, 1, 0); PG8_SCHED; PG8_LDA(At, 1, 0); PG8_STAGE(PG8_SA(0, 1), a2 + hstep, voffA);
            PG8_WAIT_L(8); PG8_BAR; PG8_WAIT_L(0); PG8_MMA(0, 0, At, B0); PG8_BAR; PG8_SCHED;
            PG8_LDB(B1, 1, 1); PG8_STAGE(PG8_SB(1, 0), b3, voffB);
            PG8_BAR; PG8_WAIT_L(0); PG8_MMA(0, 1, At, B1); PG8_BAR;
            PG8_LDA(At, 1, 1); PG8_STAGE(PG8_SA(1, 0), a3, voffA);
            PG8_BAR; PG8_WAIT_L(0); PG8_MMA(1, 0, At, B0); PG8_BAR; PG8_SCHED;
            PG8_STAGE(PG8_SB(1, 1), b3 + hstep, voffB);
            PG8_WAIT_V(6); PG8_BAR; PG8_MMA(1, 1, At, B1); PG8_BAR;
            }
        }
        if constexpr (ALIGN_EPI) { if (wr == 0) PG8_BAR; }
        if constexpr (!Epi::AFTER_DRAIN) { PG8_SCHED; int fr_l = fr, fq_l = fq; asm volatile("" : "+v"(fr_l), "+v"(fq_l) :: "memory"); E(acc, cur, wr, wc, fr_l, fq_l); asm volatile("" ::: "memory"); PG8_SCHED; S.done(cur); }
        if (!has_next) break;
#pragma unroll
        for (int a = 0; a < 2; ++a)
#pragma unroll
            for (int b = 0; b < 2; ++b)
#pragma unroll
                for (int m = 0; m < 4; ++m)
#pragma unroll
                    for (int n = 0; n < 2; ++n) acc[a][b][m][n] = (f32x4){0.f, 0.f, 0.f, 0.f};
        cur = nxt; cA = nA; cB = nB; ++ui;
        if constexpr (ALIGN_EPI) { if (wr == 1) PG8_BAR; }
    }
    PG8_WAIT_V(0);
    if constexpr (!ALIGN_EPI) { if (wr == 0) PG8_BAR; }
    PG8_BAR;
#undef PG8_SA
#undef PG8_SB
#undef PG8_STAGE
#undef PG8_LDA
#undef PG8_LDB
#undef PG8_MMA
#undef PG8_WAIT_V
#undef PG8_WAIT_L
#undef PG8_BAR
#undef PG8_SCHED
}
}

constexpr int BATCH = 16, SEQ = 4096, DM = 1024, TT = BATCH * SEQ;
constexpr int NB = 4, TG = NB * SEQ, NROUND = BATCH / NB;
constexpr int NPROJ = 8960;
constexpr float EPS = 1e-6f;
constexpr int LDS_BYTES = 147456;
constexpr size_t MiB = 1u << 20;
constexpr size_t WS_MOD = 1 * MiB, WS_WIN = 2 * MiB, WS_WUQ = 20 * MiB, WS_WUKN = 21 * MiB, WS_WUV = 22 * MiB, WS_WOA = 23 * MiB, WS_WOB = 25 * MiB,
                 WS_WOUT = 29 * MiB, WS_WFF1 = 31 * MiB, WS_WFF2 = 39 * MiB, WS_ROPE = 48 * MiB, WS_SSQ = 64 * MiB, WS_DEC = 65 * MiB;
constexpr size_t WS_H = 66 * MiB, WS_QL = 98 * MiB, WS_KVL = 106 * MiB, WS_KR = 114 * MiB, WS_DT = 116 * MiB, WS_Z = 118 * MiB, WS_XBC = 182 * MiB,
                 WS_SGA = 310 * MiB, WS_SGB = 342 * MiB, WS_QN = 374 * MiB, WS_QR = 406 * MiB, WS_KN = 422 * MiB, WS_VT = 454 * MiB, WS_CC = 486 * MiB,
                 WS_BC = 518 * MiB, WS_BT = 550 * MiB, WS_XT = 582 * MiB, WS_ATT = 646 * MiB, WS_ST = 678 * MiB, WS_HP = 806 * MiB, WS_SSM = 870 * MiB,
                 WS_END = 934 * MiB;
constexpr size_t WS_FF1 = WS_XBC, WS_MA = WS_QN, WS_MERGED = WS_KN, WS_MIX = WS_VT, WS_FF = WS_ATT;

__device__ const double ROPE_INV[32] = {1.0, 0.7498942093324559, 0.5623413251903491, 0.4216965034285822, 0.31622776601683794, 0.23713737056616552, 0.1778279410038923, 0.1333521432163324, 0.1, 0.07498942093324558, 0.05623413251903491, 0.042169650342858224, 0.03162277660168379, 0.023713737056616554, 0.01778279410038923, 0.01333521432163324, 0.01, 0.007498942093324558, 0.005623413251903491, 0.004216965034285823, 0.0031622776601683794, 0.0023713737056616554, 0.0017782794100389228, 0.001333521432163324, 0.001, 0.0007498942093324559, 0.0005623413251903491, 0.00042169650342858224, 0.00031622776601683794, 0.00023713737056616554, 0.00017782794100389227, 0.0001333521432163324};

__device__ __forceinline__ unsigned pk2(float lo, float hi) { return pg8::cvt_pk_bf16(lo, hi); }
__device__ __forceinline__ float bflo(unsigned w) { return __builtin_bit_cast(float, w << 16); }
__device__ __forceinline__ float bfhi(unsigned w) { return __builtin_bit_cast(float, w & 0xffff0000u); }
__device__ __forceinline__ float wave_sum(float v) {
#pragma unroll
    for (int o = 1; o < 64; o <<= 1) v += __shfl_xor(v, o);
    return v;
}
__device__ __forceinline__ void st8(bf16_t* p, f32x4 a, f32x4 b) { u32x4 w; w.x = pk2(a[0], a[1]); w.y = pk2(a[2], a[3]); w.z = pk2(b[0], b[1]); w.w = pk2(b[2], b[3]); *(u32x4*)p = w; }
__device__ __forceinline__ void ld8(const bf16_t* p, f32x4& a, f32x4& b) { const u32x4 w = *(const u32x4*)p; a[0] = bflo(w.x); a[1] = bfhi(w.x); a[2] = bflo(w.y); a[3] = bfhi(w.y); b[0] = bflo(w.z); b[1] = bfhi(w.z); b[2] = bflo(w.w); b[3] = bfhi(w.w); }
__device__ __forceinline__ float sigm(float x) { return 1.f / (1.f + __expf(-x)); }
__device__ __forceinline__ float silu(float x) { return x / (1.f + __expf(-x)); }
__device__ __forceinline__ float softplus(float x) {
    const float e = __expf(-fabsf(x));
    const float l = e < 0.03125f ? e * (1.f - e * (0.5f - e * (0.33333334f - 0.25f * e))) : __logf(1.f + e);
    return fmaxf(x, 0.f) + l;
}
__device__ __forceinline__ float dot4(f32x4 a) { return (a[0] * a[0] + a[1] * a[1]) + (a[2] * a[2] + a[3] * a[3]); }
#define LDS_WAIT() asm volatile("s_waitcnt lgkmcnt(0)" ::: "memory")

__device__ __forceinline__ int srcmap(int map, int r) {
    if (map == 0) return r;
    if (map == 1) {
        if (r < 512) return r;
        if (r < 6656) return r + 64;
        if (r < 8704) return r + 96;
        if (r < 8768) { const int j = r - 8704, g8 = j >> 3, e = j & 7; return 512 + (e < 4 ? 4 * g8 + e : 32 + 4 * g8 + (e - 4)); }
        if (r < 8800) return 6720 + (r - 8768);
        return -1;
    }
    if (map == 2) {
        if (r < 1024) return (r >> 7) * 192 + (r & 127);
        const int rr = r - 1024, h = rr >> 6, j = rr & 63, g8 = j >> 3, e = j & 7;
        return h * 192 + 128 + (e < 4 ? 4 * g8 + e : 32 + 4 * g8 + (e - 4));
    }
    if (map == 3) return (r >> 7) * 256 + (r & 127);
    return (r >> 7) * 256 + 128 + (r & 127);
}
__device__ __forceinline__ void transpose_item(const float* W, int K, int N, bf16_t* WT, int map, const float* ks, int nblk, LAS float* scr, int item, int lane) {
    const int kb = item / nblk, nb = item % nblk, k0 = 64 * kb, n0 = 32 * nb;
    const int src = srcmap(map, n0 + (lane & 31));
#pragma unroll 8
    for (int i = 0; i < 32; ++i) { const int kk = 2 * i + (lane >> 5); float v = src >= 0 ? W[(size_t)(k0 + kk) * N + src] : 0.f; if (ks) v *= ks[k0 + kk]; scr[kk * 33 + (lane & 31)] = v; }
    LDS_WAIT(); asm volatile("" ::: "memory");
    const int c = lane & 7;
#pragma unroll
    for (int j = 0; j < 4; ++j) { const int n = (lane >> 3) + 8 * j; const LAS float* s = scr + (8 * c) * 33 + n;
        u32x4 o; o.x = pk2(s[0 * 33], s[1 * 33]); o.y = pk2(s[2 * 33], s[3 * 33]); o.z = pk2(s[4 * 33], s[5 * 33]); o.w = pk2(s[6 * 33], s[7 * 33]);
        *(u32x4*)(WT + (size_t)(n0 + n) * K + k0 + 8 * c) = o; }
    LDS_WAIT(); asm volatile("" ::: "memory");
}

#define ACC_T const f32x4 (&acc)[2][2][4][2]
struct EpiProj {
    static constexpr bool PERM = true, AFTER_DRAIN = false;
    bf16_t *QL, *KVL, *KR, *Z, *XBC, *SGA, *SGB; float* DT; float *ssq_q, *ssq_kv; const float* rope; const float* dt_bias; int tbase;
    __device__ __forceinline__ void operator()(ACC_T, const pg8::Unit& u, int wr, int wc, int fr, int fq) const {
        const int pn = u.pn, row0 = u.pm * 256 + wr * 64 + fr, cw = wc * 32 + 8 * fq;
        if (pn < 2) {
            bf16_t* O = pn == 0 ? QL : KVL; float* sq = (pn == 0 ? ssq_q : ssq_kv) + tbase;
#pragma unroll
            for (int ai = 0; ai < 2; ++ai)
#pragma unroll
                for (int m = 0; m < 4; ++m) { const int row = row0 + ai * 128 + m * 16; float s = 0.f;
#pragma unroll
                    for (int bj = 0; bj < 2; ++bj) { const f32x4 v0 = acc[ai][bj][m][0], v1 = acc[ai][bj][m][1]; st8(O + (unsigned)row * 256u + cw + bj * 128, v0, v1); s += dot4(v0) + dot4(v1); }
                    s += __shfl_xor(s, 16); s += __shfl_xor(s, 32);
                    if (fq == 0) unsafeAtomicAdd(sq + row, s); }
        } else if (pn < 26) {
            bf16_t* O; int ld, c0; if (pn < 10) { O = Z; ld = 2048; c0 = (pn - 2) * 256; } else { O = XBC; ld = 4096; c0 = (pn - 10) * 256; }
#pragma unroll
            for (int ai = 0; ai < 2; ++ai)
#pragma unroll
                for (int m = 0; m < 4; ++m) { const int row = row0 + ai * 128 + m * 16;
#pragma unroll
                    for (int bj = 0; bj < 2; ++bj) st8(O + (unsigned)row * (unsigned)ld + c0 + cw + bj * 128, acc[ai][bj][m][0], acc[ai][bj][m][1]); }
        } else if (pn < 34) {
            bf16_t* O = pn < 30 ? SGA : SGB; const int c0 = ((pn - 26) & 3) * 256;
#pragma unroll
            for (int ai = 0; ai < 2; ++ai)
#pragma unroll
                for (int m = 0; m < 4; ++m) { const int row = row0 + ai * 128 + m * 16;
#pragma unroll
                    for (int bj = 0; bj < 2; ++bj) { f32x4 v0 = acc[ai][bj][m][0], v1 = acc[ai][bj][m][1];
#pragma unroll
                        for (int e = 0; e < 4; ++e) { v0[e] = sigm(v0[e]); v1[e] = sigm(v1[e]); }
                        st8(O + (unsigned)row * 1024u + c0 + cw + bj * 128, v0, v1); }
                    asm volatile("" ::: "memory"); }
        } else {
            if (wc < 2) {
                const int g8 = wc * 4 + fq;
#pragma unroll
                for (int ai = 0; ai < 2; ++ai)
#pragma unroll
                    for (int m = 0; m < 4; ++m) { const int row = row0 + ai * 128 + m * 16; const f32x4 v0 = acc[ai][0][m][0], v1 = acc[ai][0][m][1];
                        const f32x4* rp = (const f32x4*)(rope + (unsigned)((tbase + row) * 64 + 8 * g8)); const f32x4 c01 = rp[0], c23 = rp[1];
                        f32x4 o1, o2;
                        o1[0] = v0[0] * c01[0] - v1[0] * c01[1]; o2[0] = v0[0] * c01[1] + v1[0] * c01[0];
                        o1[1] = v0[1] * c01[2] - v1[1] * c01[3]; o2[1] = v0[1] * c01[3] + v1[1] * c01[2];
                        o1[2] = v0[2] * c23[0] - v1[2] * c23[1]; o2[2] = v0[2] * c23[1] + v1[2] * c23[0];
                        o1[3] = v0[3] * c23[2] - v1[3] * c23[3]; o2[3] = v0[3] * c23[3] + v1[3] * c23[2];
                        st8(KR + (unsigned)row * 64u + 8 * g8, o1, o2); asm volatile("" ::: "memory"); }
            } else if (wc == 2) {
                const int i0 = 8 * fq; const f32x4 b0 = *(const f32x4*)(dt_bias + i0), b1 = *(const f32x4*)(dt_bias + i0 + 4);
#pragma unroll
                for (int ai = 0; ai < 2; ++ai)
#pragma unroll
                    for (int m = 0; m < 4; ++m) { const int row = row0 + ai * 128 + m * 16; f32x4 v0 = acc[ai][0][m][0] + b0, v1 = acc[ai][0][m][1] + b1;
#pragma unroll
                        for (int e = 0; e < 4; ++e) { v0[e] = softplus(v0[e]); v1[e] = softplus(v1[e]); }
                        *(f32x4*)(DT + (unsigned)row * 32u + i0) = v0; *(f32x4*)(DT + (unsigned)row * 32u + i0 + 4) = v1; asm volatile("" ::: "memory"); }
            }
        }
    }
};
struct EpiQ {
    static constexpr bool PERM = true, AFTER_DRAIN = false;
    bf16_t *QN, *QR; const float* ssq; const float* rope; int tbase; float c2;
    __device__ __forceinline__ void operator()(ACC_T, const pg8::Unit& u, int wr, int wc, int fr, int fq) const {
        const int pn = u.pn, row0 = u.pm * 256 + wr * 64 + fr, cw = wc * 32 + 8 * fq;
#pragma unroll
        for (int ai = 0; ai < 2; ++ai)
#pragma unroll
            for (int m = 0; m < 4; ++m) { const int row = row0 + ai * 128 + m * 16; const float rs = rsqrtf(ssq[tbase + row] * (1.f / 256.f) + EPS) * c2;
#pragma unroll
                for (int bj = 0; bj < 2; ++bj) { const f32x4 v0 = acc[ai][bj][m][0] * rs, v1 = acc[ai][bj][m][1] * rs;
                    if (pn < 4) st8(QN + (unsigned)row * 1024u + pn * 256 + cw + bj * 128, v0, v1);
                    else { const int colr = (pn - 4) * 256 + cw + bj * 128, g8 = (colr & 63) >> 3;
                        const f32x4* rp = (const f32x4*)(rope + (unsigned)((tbase + row) * 64 + 8 * g8)); const f32x4 c01 = rp[0], c23 = rp[1];
                        f32x4 o1, o2;
                        o1[0] = v0[0] * c01[0] - v1[0] * c01[1]; o2[0] = v0[0] * c01[1] + v1[0] * c01[0];
                        o1[1] = v0[1] * c01[2] - v1[1] * c01[3]; o2[1] = v0[1] * c01[3] + v1[1] * c01[2];
                        o1[2] = v0[2] * c23[0] - v1[2] * c23[1]; o2[2] = v0[2] * c23[1] + v1[2] * c23[0];
                        o1[3] = v0[3] * c23[2] - v1[3] * c23[3]; o2[3] = v0[3] * c23[3] + v1[3] * c23[2];
                        st8(QR + (unsigned)row * 512u + colr, o1, o2); } }
                asm volatile("" ::: "memory"); }
    }
};
struct EpiRowScale {
    static constexpr bool PERM = true, AFTER_DRAIN = false;
    bf16_t* O; int ldc; const float* ssq; int tbase;
    __device__ __forceinline__ void operator()(ACC_T, const pg8::Unit& u, int wr, int wc, int fr, int fq) const {
        const int row0 = u.pm * 256 + wr * 64 + fr, col0 = u.pn * 256 + wc * 32 + 8 * fq;
#pragma unroll
        for (int ai = 0; ai < 2; ++ai)
#pragma unroll
            for (int m = 0; m < 4; ++m) { const int row = row0 + ai * 128 + m * 16; const float rs = rsqrtf(ssq[tbase + row] * (1.f / 256.f) + EPS);
#pragma unroll
                for (int bj = 0; bj < 2; ++bj) st8(O + (unsigned)row * (unsigned)ldc + col0 + bj * 128, acc[ai][bj][m][0] * rs, acc[ai][bj][m][1] * rs);
                asm volatile("" ::: "memory"); }
    }
};
struct EpiColScale {
    static constexpr bool PERM = true, AFTER_DRAIN = false;
    bf16_t* O; int ldc; const float* ssq; int tbase;
    __device__ __forceinline__ void operator()(ACC_T, const pg8::Unit& u, int wr, int wc, int fr, int fq) const {
        const int row0 = u.pm * 256 + wr * 64 + fr, col0 = u.pn * 256 + wc * 32 + 8 * fq;
#pragma unroll
        for (int bj = 0; bj < 2; ++bj) {
            f32x4 r0 = *(const f32x4*)(ssq + tbase + col0 + bj * 128), r1 = *(const f32x4*)(ssq + tbase + col0 + bj * 128 + 4);
#pragma unroll
            for (int e = 0; e < 4; ++e) { r0[e] = rsqrtf(r0[e] * (1.f / 256.f) + EPS); r1[e] = rsqrtf(r1[e] * (1.f / 256.f) + EPS); }
#pragma unroll
            for (int ai = 0; ai < 2; ++ai)
#pragma unroll
                for (int m = 0; m < 4; ++m) { const int row = row0 + ai * 128 + m * 16; st8(O + (unsigned)row * (unsigned)ldc + col0 + bj * 128, acc[ai][bj][m][0] * r0, acc[ai][bj][m][1] * r1); }
            asm volatile("" ::: "memory");
        }
    }
};
template <int MODE> struct EpiGate {
    static constexpr bool PERM = true, AFTER_DRAIN = false;
    bf16_t* O; const bf16_t* G; const bf16_t* P;
    __device__ __forceinline__ void operator()(ACC_T, const pg8::Unit& u, int wr, int wc, int fr, int fq) const {
        const int row0 = u.pm * 256 + wr * 64 + fr, col0 = u.pn * 256 + wc * 32 + 8 * fq;
#pragma unroll
        for (int ai = 0; ai < 2; ++ai)
#pragma unroll
            for (int m = 0; m < 4; ++m) { const int row = row0 + ai * 128 + m * 16;
#pragma unroll
                for (int bj = 0; bj < 2; ++bj) { const unsigned off = (unsigned)row * 1024u + col0 + bj * 128; f32x4 g0, g1; ld8(G + off, g0, g1);
                    f32x4 v0 = acc[ai][bj][m][0] * g0, v1 = acc[ai][bj][m][1] * g1;
                    if (MODE == 1) { f32x4 p0, p1; ld8(P + off, p0, p1); v0 += p0; v1 += p1; }
                    st8(O + off, v0, v1); }
                asm volatile("" ::: "memory"); }
    }
};
struct EpiSsq {
    static constexpr bool PERM = true, AFTER_DRAIN = false;
    bf16_t* O; int ldc; float* ssq; int tbase;
    __device__ __forceinline__ void operator()(ACC_T, const pg8::Unit& u, int wr, int wc, int fr, int fq) const {
        const int row0 = u.pm * 256 + wr * 64 + fr, col0 = u.pn * 256 + wc * 32 + 8 * fq;
#pragma unroll
        for (int ai = 0; ai < 2; ++ai)
#pragma unroll
            for (int m = 0; m < 4; ++m) { const int row = row0 + ai * 128 + m * 16; float s = 0.f;
#pragma unroll
                for (int bj = 0; bj < 2; ++bj) { const f32x4 v0 = acc[ai][bj][m][0], v1 = acc[ai][bj][m][1]; st8(O + (unsigned)row * (unsigned)ldc + col0 + bj * 128, v0, v1); s += dot4(v0) + dot4(v1); }
                s += __shfl_xor(s, 16); s += __shfl_xor(s, 32);
                if (fq == 0) unsafeAtomicAdd(ssq + tbase + row, s); }
    }
};
struct EpiRelu2 {
    static constexpr bool PERM = true, AFTER_DRAIN = false;
    bf16_t* O; int ldc;
    __device__ __forceinline__ void operator()(ACC_T, const pg8::Unit& u, int wr, int wc, int fr, int fq) const {
        const int row0 = u.pm * 256 + wr * 64 + fr, col0 = u.pn * 256 + wc * 32 + 8 * fq;
#pragma unroll
        for (int ai = 0; ai < 2; ++ai)
#pragma unroll
            for (int m = 0; m < 4; ++m) { const int row = row0 + ai * 128 + m * 16;
#pragma unroll
                for (int bj = 0; bj < 2; ++bj) { f32x4 v0 = acc[ai][bj][m][0], v1 = acc[ai][bj][m][1];
#pragma unroll
                    for (int e = 0; e < 4; ++e) { const float a = fmaxf(v0[e], 0.f), b = fmaxf(v1[e], 0.f); v0[e] = a * a; v1[e] = b * b; }
                    st8(O + (unsigned)row * (unsigned)ldc + col0 + bj * 128, v0, v1); } }
    }
};

constexpr int ATT_KB = 24576, ATT_BUF = 40960;
__device__ __forceinline__ void attn_unit(LAS unsigned char* lds, const bf16_t* QN, const bf16_t* QR, const bf16_t* KN, const bf16_t* KR, const bf16_t* VT, bf16_t* ATT, int b, int h, int qb) {
    const int tid = ltid(), wid = __builtin_amdgcn_readfirstlane(tid >> 6), lane = tid & 63, r32 = lane & 31, hf = lane >> 5;
    const int tb = b * SEQ, q0w = qb * 256 + wid * 32;
    bf16x8 qf[12];
    { const unsigned t = (unsigned)(tb + q0w + r32);
#pragma unroll
      for (int ks = 0; ks < 8; ++ks) qf[ks] = *(const bf16x8*)(QN + t * 1024u + h * 128 + ks * 16 + hf * 8);
#pragma unroll
      for (int ks = 0; ks < 4; ++ks) qf[8 + ks] = *(const bf16x8*)(QR + t * 512u + h * 64 + ks * 16 + hf * 8); }
    f32x16 o[4];
#pragma unroll
    for (int i = 0; i < 4; ++i)
#pragma unroll
        for (int r = 0; r < 16; ++r) o[i][r] = 0.f;
    float m_i = -INFINITY, l_i = 0.f;
    const int nkt = 4 * (qb + 1);
    unsigned ksrc[3]; unsigned vsrc[2];
#pragma unroll
    for (int i = 0; i < 3; ++i) { const int pid = (wid + 8 * i) * 64 + lane, row = pid / 24, cp = pid % 24, c = (cp & ~7) | ((cp ^ row) & 7);
        ksrc[i] = c < 16 ? (unsigned)((tb + row) * 1024 + h * 128 + c * 8) : (0x80000000u | (unsigned)((tb + row) * 64 + (c - 16) * 8)); }
#pragma unroll
    for (int i = 0; i < 2; ++i) { const int pid = (wid + 8 * i) * 64 + lane, dv = pid >> 3, cp = pid & 7, c = cp ^ (dv & 7);
        vsrc[i] = (unsigned)((h * 128 + dv) * TG + tb + c * 8); }
#define ATT_DMA(kt, buf) do { \
    _Pragma("unroll") for (int i = 0; i < 3; ++i) { const bf16_t* src = (ksrc[i] & 0x80000000u) ? KR + ((ksrc[i] & 0x7fffffffu) + (unsigned)(kt) * 4096u) : KN + (ksrc[i] + (unsigned)(kt) * 65536u); \
        __builtin_amdgcn_global_load_lds((const unsigned*)src, (LAS unsigned*)(lds + (buf) * ATT_BUF + (wid + 8 * i) * 1024), 16, 0, 0); } \
    _Pragma("unroll") for (int i = 0; i < 2; ++i) \
        __builtin_amdgcn_global_load_lds((const unsigned*)(VT + (vsrc[i] + (unsigned)(kt) * 64u)), (LAS unsigned*)(lds + (buf) * ATT_BUF + ATT_KB + (wid + 8 * i) * 1024), 16, 0, 0); } while (0)
    __syncthreads();
    ATT_DMA(0, 0);
    const int tx = hf ^ (r32 & 7);
    for (int kt = 0; kt < nkt; ++kt) {
        asm volatile("s_waitcnt vmcnt(0)" ::: "memory");
        __syncthreads();
        if (kt + 1 < nkt) ATT_DMA(kt + 1, (kt + 1) & 1);
        const LAS unsigned char* kbuf = lds + (kt & 1) * ATT_BUF; const LAS unsigned char* vbuf = kbuf + ATT_KB;
        const int key0 = kt * 64;
        if (key0 <= q0w + 31) {
            f32x16 s[2];
#pragma unroll
            for (int kb = 0; kb < 2; ++kb) {
#pragma unroll
                for (int r = 0; r < 16; ++r) s[kb][r] = 0.f;
                const LAS unsigned char* krow = kbuf + (kb * 32 + r32) * 384;
#pragma unroll
                for (int ks = 0; ks < 12; ++ks) { const bf16x8 a = *(const LAS bf16x8*)(krow + (((2 * ks) & ~7) + (((2 * ks) & 7) ^ tx)) * 16);
                    s[kb] = __builtin_amdgcn_mfma_f32_32x32x16_bf16(a, qf[ks], s[kb], 0, 0, 0);
                    if ((ks & 3) == 3) __builtin_amdgcn_sched_barrier(0); }
            }
            if (key0 + 63 > q0w) {
                const int qi = q0w + r32;
#pragma unroll
                for (int kb = 0; kb < 2; ++kb)
#pragma unroll
                    for (int r = 0; r < 16; ++r) { const int key = key0 + kb * 32 + (r & 3) + 8 * (r >> 2) + 4 * hf; if (key > qi) s[kb][r] = -INFINITY; }
            }
            float mx = s[0][0];
#pragma unroll
            for (int kb = 0; kb < 2; ++kb)
#pragma unroll
                for (int r = 0; r < 16; ++r) mx = fmaxf(mx, s[kb][r]);
            mx = fmaxf(mx, __shfl_xor(mx, 32));
            const float m_new = fmaxf(m_i, mx), alpha = __builtin_amdgcn_exp2f(m_i - m_new);
            float ps = 0.f;
#pragma unroll
            for (int kb = 0; kb < 2; ++kb)
#pragma unroll
                for (int r = 0; r < 16; ++r) { const float p = __builtin_amdgcn_exp2f(s[kb][r] - m_new); s[kb][r] = p; ps += p; }
            l_i = l_i * alpha + ps; m_i = m_new;
#pragma unroll
            for (int i = 0; i < 4; ++i)
#pragma unroll
                for (int r = 0; r < 16; ++r) o[i][r] *= alpha;
            bf16x8 pb[2][2];
#pragma unroll
            for (int kb = 0; kb < 2; ++kb)
#pragma unroll
                for (int s2 = 0; s2 < 2; ++s2) { u32x4 w; w.x = pk2(s[kb][8 * s2 + 0], s[kb][8 * s2 + 1]); w.y = pk2(s[kb][8 * s2 + 2], s[kb][8 * s2 + 3]);
                    w.z = pk2(s[kb][8 * s2 + 4], s[kb][8 * s2 + 5]); w.w = pk2(s[kb][8 * s2 + 6], s[kb][8 * s2 + 7]); pb[kb][s2] = __builtin_bit_cast(bf16x8, w); }
            const int vx = r32 & 7;
#pragma unroll
            for (int dvb = 0; dvb < 4; ++dvb) {
                const LAS unsigned char* vrow = vbuf + (dvb * 32 + r32) * 128 + hf * 8;
#pragma unroll
                for (int kb = 0; kb < 2; ++kb)
#pragma unroll
                    for (int s2 = 0; s2 < 2; ++s2) { const int c = kb * 4 + s2 * 2;
                        const u32x2 lo = *(const LAS u32x2*)(vrow + ((c ^ vx) * 16)), hi = *(const LAS u32x2*)(vrow + (((c + 1) ^ vx) * 16)); u32x4 w; w.x = lo.x; w.y = lo.y; w.z = hi.x; w.w = hi.y;
                        o[dvb] = __builtin_amdgcn_mfma_f32_32x32x16_bf16(__builtin_bit_cast(bf16x8, w), pb[kb][s2], o[dvb], 0, 0, 0); }
                __builtin_amdgcn_sched_barrier(0);
            }
        }
    }
#undef ATT_DMA
    l_i += __shfl_xor(l_i, 32);
    const float inv = 1.f / l_i;
    bf16_t* orow = ATT + (unsigned)(tb + q0w + r32) * 1024u + h * 128;
#pragma unroll
    for (int dvb = 0; dvb < 4; ++dvb)
#pragma unroll
        for (int rg = 0; rg < 4; ++rg) { u32x2 w; w.x = pk2(o[dvb][4 * rg] * inv, o[dvb][4 * rg + 1] * inv); w.y = pk2(o[dvb][4 * rg + 2] * inv, o[dvb][4 * rg + 3] * inv);
            *(u32x2*)(orow + dvb * 32 + 8 * rg + 4 * hf) = w; }
}

constexpr int SP = 272;
__device__ __forceinline__ void ld_tile(LAS unsigned char* dst, const bf16_t* src, int rows) {
    for (int p = ltid(); p < rows * 16; p += 512) { const int r = p >> 4, c = p & 15; *(LAS u32x4*)(dst + r * SP + c * 16) = *(const u32x4*)(src + r * 128 + c * 8); }
}
__device__ __forceinline__ void chunk_prep(LAS float* dts, LAS float* acs, const float* DT, int trow0, int g, const float* a_log) {
    const int tid = ltid(), wid = tid >> 6, lane = tid & 63;
    if (wid < 4) {
        const float A = -__expf(a_log[g * 4 + wid]);
        const float d0 = DT[(size_t)(trow0 + 2 * lane) * 32 + g * 4 + wid], d1 = DT[(size_t)(trow0 + 2 * lane + 1) * 32 + g * 4 + wid];
        const float x0 = d0 * A, x1 = x0 + d1 * A;
        float incl = x1;
#pragma unroll
        for (int o = 1; o < 64; o <<= 1) { const float v = __shfl_up(incl, o); if (lane >= o) incl += v; }
        const float excl = incl - x1;
        acs[wid * 128 + 2 * lane] = excl + x0; acs[wid * 128 + 2 * lane + 1] = excl + x1;
        dts[wid * 128 + 2 * lane] = d0; dts[wid * 128 + 2 * lane + 1] = d1;
    }
    __syncthreads();
}
__device__ __forceinline__ bf16x8 ldsfrag(const LAS unsigned char* base, int row, int k0) { return *(const LAS bf16x8*)(base + row * SP + k0 * 2); }

#define XB_TMO      128
#define XB_XCNT(j)  (256  + 64 * (j))
#define XB_XSUB(j)  (1280 + 64 * (j))
#define XB_XGEN(j)  (2304 + 64 * (j))
#define XB_TOP      3328
#define XB_TOPGEN   3392
#define XCD_BAR_WORDS 3456
#define XB_SPIN_CAP (1u << 18)

__device__ __forceinline__ unsigned xb_ld(unsigned* p)              { return __hip_atomic_load(p, __ATOMIC_RELAXED, __HIP_MEMORY_SCOPE_AGENT); }
__device__ __forceinline__ unsigned xb_add(unsigned* p, unsigned v) { return __hip_atomic_fetch_add(p, v, __ATOMIC_RELAXED, __HIP_MEMORY_SCOPE_AGENT); }
__device__ __forceinline__ unsigned xb_xcc_id() { return (unsigned)__builtin_amdgcn_s_getreg((3 << 11) | 20) & 0xFu; }
#define XB_SPIN(cond, bar) do { unsigned _sp = 0; while (cond) { __builtin_amdgcn_s_sleep(1); \
    if ((++_sp & 255u) == 0u) { if (xb_ld(&(bar)[XB_TMO])) break; if (_sp > XB_SPIN_CAP) { atomicAdd(&(bar)[XB_TMO], 1u); break; } } } } while (0)

struct XcdBarrier {
    unsigned* bar; unsigned x;
    volatile LAS unsigned* st;
};

__device__ __forceinline__ XcdBarrier xcd_barrier_post(unsigned* bar, volatile LAS unsigned* st) {
    XcdBarrier b; b.bar = bar; b.x = xb_xcc_id(); b.st = st;
    if (threadIdx.x == 0) (void)xb_add(&bar[XB_XCNT(b.x)], 1u);
    return b;
}
__device__ __forceinline__ void xcd_barrier_complete(unsigned* bar, unsigned x, unsigned& nloc, unsigned& nx) {
    const unsigned G = gridDim.x * gridDim.y * gridDim.z;
    unsigned sum, cnt, mine, sp = 0u;
    for (;;) {
        sum = 0u; cnt = 0u; mine = 0u;
#pragma unroll
        for (unsigned j = 0; j < 16; ++j) { const unsigned c = xb_ld(&bar[XB_XCNT(j)]); sum += c; cnt += (c > 0u) ? 1u : 0u; mine = (j == x) ? c : mine; }
        if (sum == G) break;
        __builtin_amdgcn_s_sleep(1);
        if ((++sp & 255u) == 0u) { if (xb_ld(&bar[XB_TMO])) break; if (sp > XB_SPIN_CAP) { atomicAdd(&bar[XB_TMO], 1u); break; } }
    }
    nloc = mine > 0u ? mine : 1u; nx = cnt > 0u ? cnt : 1u;
}

__device__ __forceinline__ void xcd_barrier(const XcdBarrier& b) {
    asm volatile("s_waitcnt vmcnt(0)" ::: "memory");
    __syncthreads();
    if (threadIdx.x == 0) {
        unsigned* bar = b.bar;
        __builtin_amdgcn_s_waitcnt(0);
        unsigned nloc = b.st[0], nx = b.st[1];
        if (nloc == 0u) { xcd_barrier_complete(bar, b.x, nloc, nx); b.st[0] = nloc; b.st[1] = nx; }
        const unsigned old = xb_add(&bar[XB_XSUB(b.x)], 1u);
        const unsigned gen = old / nloc;
        if (old + 1u == (gen + 1u) * nloc) {
            __builtin_amdgcn_fence(__ATOMIC_RELEASE, "agent");
            asm volatile("s_waitcnt vmcnt(0)" ::: "memory");
            const unsigned og = xb_add(&bar[XB_TOP], 1u);
            const unsigned tg = og / nx;
            if (og + 1u == (tg + 1u) * nx) xb_add(&bar[XB_TOPGEN], 1u);
            else XB_SPIN(xb_ld(&bar[XB_TOPGEN]) == tg, bar);
            __builtin_amdgcn_fence(__ATOMIC_ACQUIRE, "agent");
            xb_add(&bar[XB_XGEN(b.x)], 1u);
            asm volatile("s_waitcnt vmcnt(0)" ::: "memory");
        } else {
            XB_SPIN(xb_ld(&bar[XB_XGEN(b.x)]) == gen, bar);
            __builtin_amdgcn_fence(__ATOMIC_ACQUIRE, "agent");
            asm volatile("s_waitcnt vmcnt(0)" ::: "memory");
        }
    }
    __syncthreads();
}

struct Args { const void* in[25]; float* out; unsigned char* ws; };
__device__ __forceinline__ const void* in_ptr(int i) {
    int off = i * 8; asm volatile("" : "+s"(off));
    const __attribute__((address_space(4))) char* kp = (const __attribute__((address_space(4))) char*)__builtin_amdgcn_kernarg_segment_ptr();
    return *(const void* const __attribute__((address_space(4)))*)(kp + off);
}
#define INF(i) ((const float*)in_ptr(i))
#define WSB() ((unsigned char*)in_ptr(26))
#define OUTP() ((float*)in_ptr(25))

__device__ __forceinline__ void ph_mod(LAS unsigned char* lds) {
    const int tid = ltid(), lane = tid & 63, wid = __builtin_amdgcn_readfirstlane(tid >> 6), G = lgrid(), bx = lbid();
    float* MOD = (float*)(WSB() + WS_MOD);
    const float* cvec = INF(1); const float* w_ada = INF(3); const float* b_ada = INF(4);
    for (int item = bx; item < 96; item += G) {
        LAS float* sc = (LAS float*)lds;
        LAS float* red = (LAS float*)(lds + 65536);
        for (int i = tid; i < 16384; i += 512) { const int b = i >> 10, k = i & 1023; sc[k * 16 + b] = silu(cvec[i]); }
        __syncthreads();
        const int kg = tid >> 4, cl = tid & 15, j0 = item * 64 + cl * 4;
        f32x4 ac[16];
#pragma unroll
        for (int b = 0; b < 16; ++b) ac[b] = (f32x4){0.f, 0.f, 0.f, 0.f};
#pragma unroll 2
        for (int i = 0; i < 32; ++i) { const int k = kg + 32 * i; const f32x4 w = *(const f32x4*)(w_ada + (size_t)k * 6144 + j0);
            const LAS f32x4* sp = (const LAS f32x4*)(sc + k * 16);
#pragma unroll
            for (int q = 0; q < 4; ++q) { const f32x4 s4 = sp[q];
#pragma unroll
                for (int e = 0; e < 4; ++e) ac[q * 4 + e] += w * s4[e]; } }
#pragma unroll
        for (int b = 0; b < 16; ++b)
#pragma unroll
            for (int e = 0; e < 4; ++e) { float v = ac[b][e]; v += __shfl_xor(v, 16); v += __shfl_xor(v, 32); ac[b][e] = v; }
        if (lane < 16) {
#pragma unroll
            for (int b = 0; b < 16; ++b) *(LAS f32x4*)(red + (wid * 16 + b) * 64 + cl * 4) = ac[b];
        }
        __syncthreads();
        for (int i = tid; i < 1024; i += 512) { const int b = i >> 6, cc = i & 63; float s = b_ada[item * 64 + cc];
#pragma unroll
            for (int w = 0; w < 8; ++w) s += red[(w * 16 + b) * 64 + cc];
            MOD[b * 6144 + item * 64 + cc] = s; }
        __syncthreads();
    }
}
__device__ __forceinline__ void ph_wcopy(LAS unsigned char* lds) {
    const int tid = ltid(), lane = tid & 63, wid = __builtin_amdgcn_readfirstlane(tid >> 6), G = lgrid(), bx = lbid();
    const int gw = bx * 8 + wid, NGW = G * 8;
    unsigned char* ws = WSB();
    LAS float* scr = (LAS float*)(lds + wid * 8448);
    constexpr int I0 = 16 * 280, I1 = 4 * 48, I2 = 4 * 32, I3 = 4 * 32, I4 = 16 * 32, I5 = 32 * 32, I6 = 16 * 32, I7 = 16 * 128, I8 = 64 * 32;
    constexpr int NIT = I0 + I1 + I2 + I3 + I4 + I5 + I6 + I7 + I8;
    for (int it = gw; it < NIT; it += NGW) {
        int r = it;
        if (r < I0) { transpose_item(INF(7), 1024, 8800, (bf16_t*)(ws + WS_WIN), 1, nullptr, 280, scr, r, lane); continue; } r -= I0;
        if (r < I1) { transpose_item(INF(10), 256, 1536, (bf16_t*)(ws + WS_WUQ), 2, INF(8), 48, scr, r, lane); continue; } r -= I1;
        if (r < I2) { transpose_item(INF(11), 256, 2048, (bf16_t*)(ws + WS_WUKN), 3, INF(9), 32, scr, r, lane); continue; } r -= I2;
        if (r < I3) { transpose_item(INF(11), 256, 2048, (bf16_t*)(ws + WS_WUV), 4, INF(9), 32, scr, r, lane); continue; } r -= I3;
        if (r < I4) { transpose_item(INF(12), 1024, 1024, (bf16_t*)(ws + WS_WOA), 0, nullptr, 32, scr, r, lane); continue; } r -= I4;
        if (r < I5) { transpose_item(INF(19), 2048, 1024, (bf16_t*)(ws + WS_WOB), 0, nullptr, 32, scr, r, lane); continue; } r -= I5;
        if (r < I6) { transpose_item(INF(20), 1024, 1024, (bf16_t*)(ws + WS_WOUT), 0, nullptr, 32, scr, r, lane); continue; } r -= I6;
        if (r < I7) { transpose_item(INF(23), 1024, 4096, (bf16_t*)(ws + WS_WFF1), 0, nullptr, 128, scr, r, lane); continue; } r -= I7;
        transpose_item(INF(24), 4096, 1024, (bf16_t*)(ws + WS_WFF2), 0, nullptr, 32, scr, r, lane);
    }
}
__device__ __forceinline__ void ph_rope_zero() {
    const int tid = ltid(), G = lgrid(), bx = lbid();
    unsigned char* ws = WSB(); float* ROPE = (float*)(ws + WS_ROPE); float* SSQ = (float*)(ws + WS_SSQ); const int* positions = (const int*)in_ptr(2);
    for (int idx = bx * 512 + tid; idx < TT * 32; idx += G * 512) {
        const int t = idx >> 5, i = idx & 31;
        const double ang = (double)positions[t] * ROPE_INV[i];
        const double n = __builtin_rint(ang * 0.15915494309189535);
        const double r = ang - n * 6.283185307179586476925, x2 = r * r;
        double ts = r, s = r, tc = 1.0, c = 1.0;
#pragma unroll
        for (int k = 1; k <= 13; ++k) { ts *= -x2 * (1.0 / (double)((2 * k) * (2 * k + 1))); s += ts; tc *= -x2 * (1.0 / (double)((2 * k - 1) * (2 * k))); c += tc; }
        *(f32x2*)(ROPE + (size_t)idx * 2) = (f32x2){(float)c, (float)s};
    }
    for (int idx = bx * 512 + tid; idx < 4 * TT; idx += G * 512) SSQ[idx] = 0.f;
}
__device__ __forceinline__ void ph_final_rows(int pb) {
    const int tid = ltid(), lane = tid & 63, wid = __builtin_amdgcn_readfirstlane(tid >> 6), G = lgrid(), bx = lbid();
    const int gw = bx * 8 + wid, NGW = G * 8;
    unsigned char* ws = WSB(); const float* SSQ_FF = (const float*)(ws + WS_SSQ) + 3 * TT; const float* MOD = (const float*)(ws + WS_MOD); const bf16_t* FF = (const bf16_t*)(ws + WS_FF);
    const float* g_post_mlp = INF(22); float* out = OUTP();
    for (int m = gw; m < TG; m += NGW) { const int t = pb + m, b = t >> 12;
        const float rs = rsqrtf(SSQ_FF[t] * (1.f / 1024.f) + EPS); const float* gate2 = MOD + b * 6144 + 5120;
#pragma unroll
        for (int j = 0; j < 4; ++j) { const int c0 = 4 * lane + 256 * j; const u32x2 w = *(const u32x2*)(FF + (size_t)m * 1024 + c0);
            f32x4 f = {bflo(w.x), bfhi(w.x), bflo(w.y), bfhi(w.y)}; const f32x4 g = *(const f32x4*)(g_post_mlp + c0), ga = *(const f32x4*)(gate2 + c0);
            f32x4* op = (f32x4*)(out + (size_t)t * 1024 + c0); *op = *op + ga * (f * rs * g); } }
}
__device__ __forceinline__ void ph_hrows(int tbase) {
    const int tid = ltid(), lane = tid & 63, wid = __builtin_amdgcn_readfirstlane(tid >> 6), G = lgrid(), bx = lbid();
    const int gw = bx * 8 + wid, NGW = G * 8;
    unsigned char* ws = WSB(); const float* MOD = (const float*)(ws + WS_MOD); bf16_t* H = (bf16_t*)(ws + WS_H);
    const float* x = INF(0); const float* g_pre_mix = INF(5);
    for (int m = gw; m < TG; m += NGW) { const int t = tbase + m, b = t >> 12;
        const f32x4* xr = (const f32x4*)(x + (size_t)t * 1024) + lane; f32x4 v[4]; float s = 0.f;
#pragma unroll
        for (int j = 0; j < 4; ++j) { v[j] = xr[64 * j]; s += dot4(v[j]); }
        const float rs = rsqrtf(wave_sum(s) * (1.f / 1024.f) + EPS); const float* shift = MOD + b * 6144; const float* scale = shift + 1024;
#pragma unroll
        for (int j = 0; j < 4; ++j) { const int c0 = 4 * lane + 256 * j; const f32x4 g = *(const f32x4*)(g_pre_mix + c0), sc = *(const f32x4*)(scale + c0), sh = *(const f32x4*)(shift + c0);
            const f32x4 hv = v[j] * rs * g * (sc + 1.f) + sh; u32x2 w; w.x = pk2(hv[0], hv[1]); w.y = pk2(hv[2], hv[3]); *(u32x2*)(H + (size_t)m * 1024 + c0) = w; } }
}
__device__ __forceinline__ void ph_proj(LAS unsigned char* lds, int tbase) {
    unsigned char* ws = WSB(); const int G = lgrid(), bx = lbid();
    pg8::Gemm g{(const bf16_t*)(ws + WS_H), (const bf16_t*)(ws + WS_WIN), TG, NPROJ, 1024}; pg8::StaticOrder S; S.init(TG, NPROJ, G, bx);
    float* SSQ = (float*)(ws + WS_SSQ);
    EpiProj E{(bf16_t*)(ws + WS_QL), (bf16_t*)(ws + WS_KVL), (bf16_t*)(ws + WS_KR), (bf16_t*)(ws + WS_Z), (bf16_t*)(ws + WS_XBC), (bf16_t*)(ws + WS_SGA), (bf16_t*)(ws + WS_SGB),
              (float*)(ws + WS_DT), SSQ, SSQ + TT, (const float*)(ws + WS_ROPE), INF(15), tbase};
    pg8::gemm_phase<EpiProj, pg8::StaticOrder, true, true>(lds, g, S, E);
}
__device__ __forceinline__ void ph_upq(LAS unsigned char* lds, int tbase) {
    unsigned char* ws = WSB(); const int G = lgrid(), bx = lbid();
    pg8::Gemm g{(const bf16_t*)(ws + WS_QL), (const bf16_t*)(ws + WS_WUQ), TG, 1536, 256}; pg8::StaticOrder S; S.init(TG, 1536, G, bx);
    EpiQ E{(bf16_t*)(ws + WS_QN), (bf16_t*)(ws + WS_QR), (const float*)(ws + WS_SSQ), (const float*)(ws + WS_ROPE), tbase, 0.07216878364870322f * 1.4426950408889634f};
    pg8::gemm_phase<EpiQ, pg8::StaticOrder, true, true>(lds, g, S, E);
}
__device__ __forceinline__ void ph_upk(LAS unsigned char* lds, int tbase) {
    unsigned char* ws = WSB(); const int G = lgrid(), bx = lbid();
    pg8::Gemm g{(const bf16_t*)(ws + WS_KVL), (const bf16_t*)(ws + WS_WUKN), TG, 1024, 256}; pg8::StaticOrder S; S.init(TG, 1024, G, bx);
    EpiRowScale E{(bf16_t*)(ws + WS_KN), 1024, (const float*)(ws + WS_SSQ) + TT, tbase};
    pg8::gemm_phase<EpiRowScale, pg8::StaticOrder, true, true>(lds, g, S, E);
}
__device__ __forceinline__ void ph_upv(LAS unsigned char* lds, int tbase) {
    unsigned char* ws = WSB(); const int G = lgrid(), bx = lbid();
    pg8::Gemm g{(const bf16_t*)(ws + WS_WUV), (const bf16_t*)(ws + WS_KVL), 1024, TG, 256}; pg8::StaticOrder S; S.init(1024, TG, G, bx);
    EpiColScale E{(bf16_t*)(ws + WS_VT), TG, (const float*)(ws + WS_SSQ) + TT, tbase};
    pg8::gemm_phase<EpiColScale, pg8::StaticOrder, true, true>(lds, g, S, E);
}
__device__ __forceinline__ void ph_conv(LAS unsigned char* lds) {
    const int tid = ltid(), G = lgrid(), bx = lbid();
    unsigned char* ws = WSB(); const bf16_t* XBC = (const bf16_t*)(ws + WS_XBC);
    const float* conv_w = INF(13); const float* conv_b = INF(14);
    for (int item = bx; item < NB * 32 * 64; item += G) {
        const int slab = item & 63, c = (item >> 6) & 31, b = item >> 11;
        LAS unsigned char* tile = lds;
        for (int p = tid; p < 131 * 8; p += 512) { const int r = p >> 3, cc = p & 7; const int trow = c * 128 + r - 3;
            u32x4 v = {0u, 0u, 0u, 0u}; if (trow >= 0) v = *(const u32x4*)(XBC + (size_t)(b * SEQ + trow) * 4096 + slab * 64 + cc * 8);
            *(LAS u32x4*)(tile + r * 144 + cc * 16) = v; }
        __syncthreads();
        const int ch0 = slab * 64;
        if (slab < 48) {
            bf16_t* dst;
            if (slab < 32) { const int bl = (b * 32 + c) * 8 + (slab >> 2); dst = (bf16_t*)(ws + WS_XT) + ((size_t)(bl * 4 + (slab & 3)) * 64) * 128; }
            else { const int bl = (b * 32 + c) * 8 + ((slab - 32) >> 1); dst = (bf16_t*)(ws + WS_BT) + ((size_t)bl * 128 + ((slab - 32) & 1) * 64) * 128; }
#pragma unroll 1
            for (int q = 0; q < 2; ++q) { const int task = tid + 512 * q, ch = task & 63, l0 = (task >> 6) * 8;
                const float w0 = conv_w[ch0 + ch], w1 = conv_w[4096 + ch0 + ch], w2 = conv_w[8192 + ch0 + ch], w3 = conv_w[12288 + ch0 + ch], bb = conv_b[ch0 + ch];
                float uu[11];
#pragma unroll
                for (int i = 0; i < 11; ++i) uu[i] = __builtin_bit_cast(float, (unsigned)(*(const LAS unsigned short*)(tile + (l0 + i) * 144 + ch * 2)) << 16);
                float ov[8];
#pragma unroll
                for (int j = 0; j < 8; ++j) ov[j] = silu(bb + w0 * uu[j] + w1 * uu[j + 1] + w2 * uu[j + 2] + w3 * uu[j + 3]);
                u32x4 w; w.x = pk2(ov[0], ov[1]); w.y = pk2(ov[2], ov[3]); w.z = pk2(ov[4], ov[5]); w.w = pk2(ov[6], ov[7]);
                *(u32x4*)(dst + (size_t)ch * 128 + l0) = w; }
        }
        if (slab >= 32) {
            const int s2 = slab - (slab < 48 ? 32 : 48); const int bl = (b * 32 + c) * 8 + (s2 >> 1);
            bf16_t* dst = (bf16_t*)(ws + (slab < 48 ? WS_BC : WS_CC)) + (size_t)bl * 128 * 128 + (s2 & 1) * 64;
#pragma unroll 1
            for (int q = 0; q < 2; ++q) { const int task = tid + 512 * q, cgp = task & 7, l = task >> 3; const int chb = ch0 + cgp * 8;
                f32x4 a0 = *(const f32x4*)(conv_b + chb), a1 = *(const f32x4*)(conv_b + chb + 4);
#pragma unroll
                for (int k = 0; k < 4; ++k) { const u32x4 uw = *(const LAS u32x4*)(tile + (l + k) * 144 + cgp * 16);
                    const f32x4 wa = *(const f32x4*)(conv_w + k * 4096 + chb), wb = *(const f32x4*)(conv_w + k * 4096 + chb + 4);
                    const f32x4 u0 = {bflo(uw.x), bfhi(uw.x), bflo(uw.y), bfhi(uw.y)}, u1 = {bflo(uw.z), bfhi(uw.z), bflo(uw.w), bfhi(uw.w)};
                    a0 += wa * u0; a1 += wb * u1; }
#pragma unroll
                for (int e = 0; e < 4; ++e) { a0[e] = silu(a0[e]); a1[e] = silu(a1[e]); }
                st8(dst + (size_t)l * 128 + cgp * 8, a0, a1); }
        }
        __syncthreads();
    }
}
__device__ __forceinline__ void ph_states(LAS unsigned char* lds) {
    const int tid = ltid(), lane = tid & 63, wid = __builtin_amdgcn_readfirstlane(tid >> 6), G = lgrid(), bx = lbid();
    unsigned char* ws = WSB(); const float* DT = (const float*)(ws + WS_DT); float* DEC = (float*)(ws + WS_DEC); const float* a_log = INF(16);
    for (int item = bx; item < NB * 32 * 8; item += G) {
        const int bl = item, g = item & 7, c = (item >> 3) & 31, b = item >> 8;
        LAS unsigned char* XTs = lds; LAS unsigned char* BTs = lds + 256 * SP;
        LAS float* dts = (LAS float*)(lds + 384 * SP); LAS float* acs = dts + 512; LAS float* wsc = acs + 512;
        ld_tile(XTs, (const bf16_t*)(ws + WS_XT) + (size_t)bl * 4 * 8192, 256); ld_tile(BTs, (const bf16_t*)(ws + WS_BT) + (size_t)bl * 16384, 128);
        chunk_prep(dts, acs, DT, b * SEQ + c * 128, g, a_log);
        { const int hh = tid >> 7; wsc[tid] = dts[tid] * __expf(acs[hh * 128 + 127] - acs[tid]); }
        if (tid < 4) DEC[(b * 32 + c) * 32 + g * 4 + tid] = __expf(acs[tid * 128 + 127]);
        __syncthreads();
        const int r32 = lane & 31, hf = lane >> 5, pb = wid >> 2, nb = wid & 3;
#pragma unroll 1
        for (int hh = 0; hh < 4; ++hh) {
            f32x16 acc;
#pragma unroll
            for (int r = 0; r < 16; ++r) acc[r] = 0.f;
#pragma unroll 2
            for (int ks = 0; ks < 8; ++ks) {
                const u32x4 xa = *(const LAS u32x4*)(XTs + (hh * 64 + pb * 32 + r32) * SP + (ks * 16 + hf * 8) * 2);
                const LAS f32x4* wp = (const LAS f32x4*)(wsc + hh * 128 + ks * 16 + hf * 8); const f32x4 w0 = wp[0], w1 = wp[1];
                u32x4 xs; xs.x = pk2(bflo(xa.x) * w0[0], bfhi(xa.x) * w0[1]); xs.y = pk2(bflo(xa.y) * w0[2], bfhi(xa.y) * w0[3]);
                xs.z = pk2(bflo(xa.z) * w1[0], bfhi(xa.z) * w1[1]); xs.w = pk2(bflo(xa.w) * w1[2], bfhi(xa.w) * w1[3]);
                const bf16x8 bb = ldsfrag(BTs, nb * 32 + r32, ks * 16 + hf * 8);
                acc = __builtin_amdgcn_mfma_f32_32x32x16_bf16(__builtin_bit_cast(bf16x8, xs), bb, acc, 0, 0, 0);
            }
            float* sp = (float*)(ws + WS_ST) + ((size_t)bl * 4 + hh) * 8192 + nb * 32 + r32;
#pragma unroll
            for (int r = 0; r < 16; ++r) sp[(pb * 32 + (r & 3) + 8 * (r >> 2) + 4 * hf) * 128] = acc[r];
        }
        __syncthreads();
    }
}
__device__ __forceinline__ void ph_scan() {
    const int tid = ltid(), G = lgrid(), bx = lbid();
    unsigned char* ws = WSB(); const float* ST = (const float*)(ws + WS_ST); bf16_t* HP = (bf16_t*)(ws + WS_HP); const float* DEC = (const float*)(ws + WS_DEC);
    for (int e = bx * 512 + tid; e < NB * 32 * 2048; e += G * 512) {
        const int bgh = e >> 11, pn4 = e & 2047, b = bgh >> 5, gh = bgh & 31;
        f32x4 st = {0.f, 0.f, 0.f, 0.f};
#pragma unroll 4
        for (int c = 0; c < 32; ++c) { const size_t off = ((size_t)((b * 32 + c) * 32 + gh)) * 8192 + pn4 * 4;
            const f32x4 s = *(const f32x4*)(ST + off); u32x2 w; w.x = pk2(st[0], st[1]); w.y = pk2(st[2], st[3]); *(u32x2*)(HP + off) = w;
            st = st * DEC[(b * 32 + c) * 32 + gh] + s; }
    }
}
__device__ __forceinline__ void ph_attn(LAS unsigned char* lds) {
    const int G = lgrid(), bx = lbid();
    unsigned char* ws = WSB();
    const bf16_t* QN = (const bf16_t*)(ws + WS_QN); const bf16_t* QR = (const bf16_t*)(ws + WS_QR); const bf16_t* KN = (const bf16_t*)(ws + WS_KN);
    const bf16_t* KR = (const bf16_t*)(ws + WS_KR); const bf16_t* VT = (const bf16_t*)(ws + WS_VT); bf16_t* ATT = (bf16_t*)(ws + WS_ATT);
    for (int pi = bx; pi < NB * 64; pi += G) { const int b = pi >> 6, h = (pi >> 3) & 7, j = pi & 7;
#pragma unroll 1
        for (int k = 0; k < 2; ++k) attn_unit(lds, QN, QR, KN, KR, VT, ATT, b, h, k ? j : 15 - j); }
    __syncthreads();
}
__device__ __forceinline__ void ph_ssdc(LAS unsigned char* lds) {
    const int tid = ltid(), lane = tid & 63, wid = __builtin_amdgcn_readfirstlane(tid >> 6), G = lgrid(), bx = lbid();
    unsigned char* ws = WSB(); const float* DT = (const float*)(ws + WS_DT); const float* a_log = INF(16);
    for (int item = bx; item < NB * 32 * 8; item += G) {
        const int bl = item, g = item & 7, c = (item >> 3) & 31, b = item >> 8;
        const int trow0 = b * SEQ + c * 128;
        LAS unsigned char* Cs = lds; LAS unsigned char* Bs = lds + 128 * SP; LAS unsigned char* Ms = lds + 256 * SP;
        LAS unsigned char* XTs = Bs; LAS unsigned char* HPs = Bs + 64 * SP;
        LAS float* dts = (LAS float*)(lds + 384 * SP); LAS float* acs = dts + 512; LAS float* rowp = acs + 512;
        ld_tile(Cs, (const bf16_t*)(ws + WS_CC) + (size_t)bl * 16384, 128); ld_tile(Bs, (const bf16_t*)(ws + WS_BC) + (size_t)bl * 16384, 128);
        chunk_prep(dts, acs, DT, trow0, g, a_log);
        const int r32 = lane & 31, hf = lane >> 5;
        const int lb = wid >> 1, sb0 = (wid & 1) * 2;
        f32x16 cb[2];
#pragma unroll
        for (int j = 0; j < 2; ++j) {
#pragma unroll
            for (int r = 0; r < 16; ++r) cb[j][r] = 0.f;
#pragma unroll 2
            for (int ks = 0; ks < 8; ++ks) cb[j] = __builtin_amdgcn_mfma_f32_32x32x16_bf16(ldsfrag(Cs, lb * 32 + r32, ks * 16 + hf * 8), ldsfrag(Bs, (sb0 + j) * 32 + r32, ks * 16 + hf * 8), cb[j], 0, 0, 0);
        }
        __syncthreads();
        const int pb = wid & 1, lq = wid >> 1;
        float ssq = 0.f;
        bf16_t* op = (bf16_t*)(ws + WS_SSM) + (size_t)(trow0 + lq * 32 + r32) * 2048 + g * 256 + pb * 32 + 4 * hf;
#pragma unroll 1
        for (int hh = 0; hh < 4; ++hh) {
            ld_tile(XTs, (const bf16_t*)(ws + WS_XT) + ((size_t)bl * 4 + hh) * 8192, 64); ld_tile(HPs, (const bf16_t*)(ws + WS_HP) + ((size_t)bl * 4 + hh) * 8192, 64);
            const float dsk = INF(17)[g * 4 + hh];
#pragma unroll
            for (int j = 0; j < 2; ++j) { const int s = (sb0 + j) * 32 + r32; const float as = acs[hh * 128 + s], ds = dts[hh * 128 + s];
#pragma unroll
                for (int r = 0; r < 16; ++r) { const int l = lb * 32 + (r & 3) + 8 * (r >> 2) + 4 * hf;
                    const float al = acs[hh * 128 + l];
                    float val = cb[j][r] * __expf(fminf(al - as, 0.f)) * ds;
                    if (s == l) val += dsk;
                    if (s > l) val = 0.f;
                    *(LAS unsigned short*)(Ms + l * SP + s * 2) = (unsigned short)(pk2(val, 0.f) & 0xffffu); } }
            __syncthreads();
            f32x16 yd;
#pragma unroll
            for (int r = 0; r < 16; ++r) yd[r] = 0.f;
#pragma unroll 2
            for (int ks = 0; ks < 8; ++ks) yd = __builtin_amdgcn_mfma_f32_32x32x16_bf16(ldsfrag(HPs, pb * 32 + r32, ks * 16 + hf * 8), ldsfrag(Cs, lq * 32 + r32, ks * 16 + hf * 8), yd, 0, 0, 0);
            const float ea = __expf(acs[hh * 128 + lq * 32 + r32]);
#pragma unroll
            for (int r = 0; r < 16; ++r) yd[r] *= ea;
#pragma unroll 2
            for (int ks = 0; ks < 8; ++ks) yd = __builtin_amdgcn_mfma_f32_32x32x16_bf16(ldsfrag(XTs, pb * 32 + r32, ks * 16 + hf * 8), ldsfrag(Ms, lq * 32 + r32, ks * 16 + hf * 8), yd, 0, 0, 0);
            const bf16_t* zp = (const bf16_t*)(ws + WS_Z) + (size_t)(trow0 + lq * 32 + r32) * 2048 + g * 256 + hh * 64 + pb * 32 + 4 * hf;
#pragma unroll
            for (int rg = 0; rg < 4; ++rg) { const u32x2 zw = *(const u32x2*)(zp + 8 * rg); const float zz[4] = {bflo(zw.x), bfhi(zw.x), bflo(zw.y), bfhi(zw.y)};
                float v[4];
#pragma unroll
                for (int e = 0; e < 4; ++e) { v[e] = yd[4 * rg + e] * silu(zz[e]); ssq += v[e] * v[e]; }
                u32x2 w; w.x = pk2(v[0], v[1]); w.y = pk2(v[2], v[3]); *(u32x2*)(op + hh * 64 + 8 * rg) = w; }
            __syncthreads();
        }
        asm volatile("s_waitcnt vmcnt(0)" ::: "memory");
        rowp[(pb * 2 + hf) * 128 + lq * 32 + r32] = ssq;
        __syncthreads();
        { const int l = lq * 32 + r32; const float rs = rsqrtf((rowp[l] + rowp[128 + l] + rowp[256 + l] + rowp[384 + l]) * (1.f / 256.f) + EPS);
          const float* gp = INF(18) + g * 256 + pb * 32 + 4 * hf;
#pragma unroll 1
          for (int hh = 0; hh < 4; ++hh)
#pragma unroll
              for (int rg = 0; rg < 4; ++rg) { const f32x4 gs = *(const f32x4*)(gp + hh * 64 + 8 * rg);
                  const unsigned long long yraw = __hip_atomic_load((const unsigned long long*)(op + hh * 64 + 8 * rg), __ATOMIC_RELAXED, __HIP_MEMORY_SCOPE_AGENT);
                  u32x2 yw; yw.x = (unsigned)yraw; yw.y = (unsigned)(yraw >> 32);
                  u32x2 w; w.x = pk2(bflo(yw.x) * rs * gs[0], bfhi(yw.x) * rs * gs[1]); w.y = pk2(bflo(yw.y) * rs * gs[2], bfhi(yw.y) * rs * gs[3]);
                  *(u32x2*)(op + hh * 64 + 8 * rg) = w; } }
        __syncthreads();
    }
}
__device__ __forceinline__ void ph_merge_a(LAS unsigned char* lds) {
    unsigned char* ws = WSB(); const int G = lgrid(), bx = lbid();
    pg8::Gemm g{(const bf16_t*)(ws + WS_ATT), (const bf16_t*)(ws + WS_WOA), TG, 1024, 1024}; pg8::StaticOrder S; S.init(TG, 1024, G, bx);
    EpiGate<0> E{(bf16_t*)(ws + WS_MA), (const bf16_t*)(ws + WS_SGA), nullptr};
    pg8::gemm_phase<EpiGate<0>, pg8::StaticOrder, true, true>(lds, g, S, E);
    asm volatile("s_waitcnt vmcnt(0)" ::: "memory");
}
__device__ __forceinline__ void ph_merge_b(LAS unsigned char* lds) {
    unsigned char* ws = WSB(); const int G = lgrid(), bx = lbid();
    pg8::Gemm g{(const bf16_t*)(ws + WS_SSM), (const bf16_t*)(ws + WS_WOB), TG, 1024, 2048}; pg8::StaticOrder S; S.init(TG, 1024, G, bx);
    EpiGate<1> E{(bf16_t*)(ws + WS_MERGED), (const bf16_t*)(ws + WS_SGB), (const bf16_t*)(ws + WS_MA)};
    pg8::gemm_phase<EpiGate<1>, pg8::StaticOrder, true, true>(lds, g, S, E);
}
__device__ __forceinline__ void ph_mix(LAS unsigned char* lds, int tbase) {
    unsigned char* ws = WSB(); const int G = lgrid(), bx = lbid();
    pg8::Gemm g{(const bf16_t*)(ws + WS_MERGED), (const bf16_t*)(ws + WS_WOUT), TG, 1024, 1024}; pg8::StaticOrder S; S.init(TG, 1024, G, bx);
    EpiSsq E{(bf16_t*)(ws + WS_MIX), 1024, (float*)(ws + WS_SSQ) + 2 * TT, tbase};
    pg8::gemm_phase<EpiSsq, pg8::StaticOrder, true, true>(lds, g, S, E);
}
__device__ __forceinline__ void ph_x1rows(int tbase) {
    const int tid = ltid(), lane = tid & 63, wid = __builtin_amdgcn_readfirstlane(tid >> 6), G = lgrid(), bx = lbid();
    const int gw = bx * 8 + wid, NGW = G * 8;
    unsigned char* ws = WSB(); const float* SSQ_MIX = (const float*)(ws + WS_SSQ) + 2 * TT; const float* MOD = (const float*)(ws + WS_MOD);
    const bf16_t* MIX = (const bf16_t*)(ws + WS_MIX); bf16_t* H = (bf16_t*)(ws + WS_H);
    const float* x = INF(0); const float* g_post_mix = INF(6); const float* g_pre_mlp = INF(21); float* out = OUTP();
    for (int m = gw; m < TG; m += NGW) { const int t = tbase + m, b = t >> 12;
        const float rs1 = rsqrtf(SSQ_MIX[t] * (1.f / 1024.f) + EPS); const float* mod = MOD + b * 6144;
        f32x4 v[4]; float s = 0.f;
#pragma unroll
        for (int j = 0; j < 4; ++j) { const int c0 = 4 * lane + 256 * j; const u32x2 w = *(const u32x2*)(MIX + (size_t)m * 1024 + c0);
            const f32x4 f = {bflo(w.x), bfhi(w.x), bflo(w.y), bfhi(w.y)}; const f32x4 g = *(const f32x4*)(g_post_mix + c0), ga = *(const f32x4*)(mod + 2048 + c0);
            v[j] = *(const f32x4*)(x + (size_t)t * 1024 + c0) + ga * (f * rs1 * g); *(f32x4*)(out + (size_t)t * 1024 + c0) = v[j]; s += dot4(v[j]); }
        const float rs2 = rsqrtf(wave_sum(s) * (1.f / 1024.f) + EPS);
#pragma unroll
        for (int j = 0; j < 4; ++j) { const int c0 = 4 * lane + 256 * j; const f32x4 g = *(const f32x4*)(g_pre_mlp + c0), sc = *(const f32x4*)(mod + 4096 + c0), sh = *(const f32x4*)(mod + 3072 + c0);
            const f32x4 hv = v[j] * rs2 * g * (sc + 1.f) + sh; u32x2 w; w.x = pk2(hv[0], hv[1]); w.y = pk2(hv[2], hv[3]); *(u32x2*)(H + (size_t)m * 1024 + c0) = w; } }
}
__device__ __forceinline__ void ph_ff1(LAS unsigned char* lds) {
    unsigned char* ws = WSB(); const int G = lgrid(), bx = lbid();
    pg8::Gemm g{(const bf16_t*)(ws + WS_H), (const bf16_t*)(ws + WS_WFF1), TG, 4096, 1024}; pg8::StaticOrder S; S.init(TG, 4096, G, bx);
    EpiRelu2 E{(bf16_t*)(ws + WS_FF1), 4096};
    pg8::gemm_phase<EpiRelu2, pg8::StaticOrder, true, true>(lds, g, S, E);
}
__device__ __forceinline__ void ph_ff2(LAS unsigned char* lds, int tbase) {
    unsigned char* ws = WSB(); const int G = lgrid(), bx = lbid();
    pg8::Gemm g{(const bf16_t*)(ws + WS_FF1), (const bf16_t*)(ws + WS_WFF2), TG, 1024, 4096}; pg8::StaticOrder S; S.init(TG, 1024, G, bx);
    EpiSsq E{(bf16_t*)(ws + WS_FF), 1024, (float*)(ws + WS_SSQ) + 3 * TT, tbase};
    pg8::gemm_phase<EpiSsq, pg8::StaticOrder, true, true>(lds, g, S, E);
}

__global__ void __launch_bounds__(512, 2) mega(Args a) {
    extern __shared__ __attribute__((aligned(16))) unsigned char lds_raw[];
    LAS unsigned char* lds = (LAS unsigned char*)lds_raw;
    cg::grid_group grid = cg::this_grid();
    volatile LAS unsigned* bst = (volatile LAS unsigned*)(lds + LDS_BYTES - 64);
    if (threadIdx.x < 2) bst[threadIdx.x] = 0u;
    __syncthreads();
    XcdBarrier xbar = xcd_barrier_post((unsigned*)a.ws, bst);
#ifndef NO_MOD
    ph_mod(lds);
#endif
#ifndef NO_WCP
    ph_wcopy(lds);
#endif
    ph_rope_zero();
    grid.sync();
#pragma unroll 1
    for (int rd = 0; rd < NROUND; ++rd) {
        const int tbase = rd * TG;
        if (rd > 0) ph_final_rows(tbase - TG);
        ph_hrows(tbase);
        GSYNC();
#ifndef NO_GB
        ph_proj(lds, tbase);
#endif
        GSYNC();
#ifndef NO_GC
        ph_upq(lds, tbase); ph_upk(lds, tbase); ph_upv(lds, tbase);
#endif
#ifndef NO_CONV
        ph_conv(lds);
        if (DUP_CONV) ph_conv(lds);
#endif
        GSYNC();
#ifndef NO_PD
        ph_states(lds);
#endif
        GSYNC();
        ph_scan();
        GSYNC();
#ifndef NO_ATT
        ph_attn(lds);
        if (DUP_ATT) ph_attn(lds);
#endif
#ifndef NO_SSDC
        ph_ssdc(lds);
        if (DUP_SSDC) ph_ssdc(lds);
#endif
        GSYNC();
#ifndef NO_GG
        ph_merge_a(lds); ph_merge_b(lds);
#endif
        GSYNC();
#ifndef NO_GH
        ph_mix(lds, tbase);
#endif
        GSYNC();
        ph_x1rows(tbase);
        GSYNC();
#ifndef NO_GJ
        ph_ff1(lds);
#endif
        GSYNC();
#ifndef NO_GK
        ph_ff2(lds, tbase);
#endif
        GSYNC();
    }
    ph_final_rows(TT - TG);
}


extern "C" void kernel_launch(void* const* d_in, const int* in_sizes, int n_in, void* d_out, int out_size, void* d_ws, size_t ws_size, hipStream_t stream) {
    static int grid = 0;
    if (grid == 0) {
        if (n_in != 25 || out_size != TT * DM || ws_size < WS_END) { fprintf(stderr, "kernel_launch: unexpected problem (n_in %d out %d ws %zu)\n", n_in, out_size, ws_size); grid = -1; return; }
        int dev = 0, cus = 0, per_cu = 0;
        hipGetDevice(&dev); hipDeviceGetAttribute(&cus, hipDeviceAttributeMultiprocessorCount, dev);
        hipFuncSetAttribute((const void*)mega, hipFuncAttributeMaxDynamicSharedMemorySize, LDS_BYTES);
        hipOccupancyMaxActiveBlocksPerMultiprocessor(&per_cu, (const void*)mega, 512, LDS_BYTES);
        (void)hipGetLastError();
        if (per_cu < 1) per_cu = 1;
        grid = cus;
    }
    if (grid < 0) return;
    if (hipMemsetAsync(d_ws, 0, 65536, stream) != hipSuccess) { fprintf(stderr, "memset failed\n"); return; }
    Args a{};
    for (int i = 0; i < 25; ++i) a.in[i] = d_in[i];
    a.out = (float*)d_out; a.ws = (unsigned char*)d_ws;
    void* args[] = {&a};
    hipError_t e = hipLaunchCooperativeKernel((const void*)mega, dim3(grid), dim3(512), args, LDS_BYTES, stream);
    if (e != hipSuccess) fprintf(stderr, "cooperative launch failed: %s (grid %d)\n", hipGetErrorString(e), grid);
}
```

```cpp
#include <hip/hip_runtime.h>
#include <hip/hip_cooperative_groups.h>
#include <cstdio>
#include <cstdint>
namespace cg = cooperative_groups;
#ifndef DUP_ATT
#define DUP_ATT 0
#endif
#ifndef DUP_P0
#define DUP_P0 0
#endif
#ifndef DUP_SS
#define DUP_SS 0
#endif
#ifndef DUP_ROWS
#define DUP_ROWS 0
#endif
#ifndef DUP_SYNC
#define DUP_SYNC 0
#endif
#ifndef DUP_CONV
#define DUP_CONV 0
#endif
#ifndef DUP_SSDC
#define DUP_SSDC 0
#endif
#define GSYNC() do { xcd_barrier(xbar); if (DUP_SYNC) xcd_barrier(xbar); } while (0)

#define LAS __attribute__((address_space(3)))
typedef unsigned short bf16_t;
typedef short bf16x8 __attribute__((ext_vector_type(8)));
typedef float f32x4 __attribute__((ext_vector_type(4)));
typedef float f32x2 __attribute__((ext_vector_type(2)));
typedef float f32x16 __attribute__((ext_vector_type(16)));
typedef unsigned u32x4 __attribute__((ext_vector_type(4)));
typedef unsigned u32x2 __attribute__((ext_vector_type(2)));

__device__ __forceinline__ int ltid() { int t = threadIdx.x; asm volatile("" : "+v"(t)); return t; }
__device__ __forceinline__ int lbid() { int b = blockIdx.x; asm volatile("" : "+s"(b)); return b; }
__device__ __forceinline__ int lgrid() { int g = gridDim.x; asm volatile("" : "+s"(g)); return g; }

namespace pg8 {
#define PG8_LAS __attribute__((address_space(3)))
constexpr int BM = 256, BK = 64, HALF = 128, HTB = HALF * BK * 2, STAGE_BYTES = 8 * HTB, NXCD = 8, WGM = 8;
__host__ __device__ __forceinline__ int lds_byte(int r, int c) { const int st = (r >> 4) * 2 + (c >> 5), rr = r & 15, cc = c & 31, ob = rr * 64 + cc * 2; return st * 1024 + (ob ^ (((ob >> 9) & 1) << 5)); }
__host__ __device__ __forceinline__ void stage_rc(int b, int& R, int& C) { const int st = b / 1024, sb = b % 1024, swz = sb ^ (((sb >> 9) & 1) << 5); R = (st >> 1) * 16 + swz / 64; C = (st & 1) * 32 + (swz % 64) / 2; }
__host__ __device__ __forceinline__ int perm32(int rho) { const int n = rho >> 4, i = rho & 15; return 8 * (i >> 2) + 4 * n + (i & 3); }
struct Unit { int pm, pn; };
struct Gemm { const bf16_t* A; const bf16_t* Bt; int M, N, K; };
struct StaticOrder {
    int nM, nN, nwg, G, c;
    __host__ __device__ void init(int M, int N, int G_, int c_) { nM = M / BM; nN = N / BM; nwg = nM * nN; G = G_; c = c_; }
    __host__ __device__ bool next(int i, Unit& u) const {
        const long L = (long)i * G + c; if (L >= nwg) return false;
        int wgid = (int)L; { const int q = nwg / NXCD, r = nwg % NXCD, xcd = wgid % NXCD, off = wgid / NXCD; wgid = (xcd < r ? xcd * (q + 1) : r * (q + 1) + (xcd - r) * q) + off; }
        const int nig = WGM * nN, gid = wgid / nig, fm = gid * WGM, gsz = (nM - fm) < WGM ? (nM - fm) : WGM;
        u.pm = fm + ((wgid % nig) % gsz); u.pn = (wgid % nig) / gsz; return true;
    }
    __device__ __forceinline__ void a_ready(const Unit&) const {}
    __device__ __forceinline__ void done(const Unit&) const {}
};
__device__ __forceinline__ unsigned cvt_pk_bf16(float lo, float hi) { unsigned r; asm volatile("v_cvt_pk_bf16_f32 %0, %1, %2" : "=v"(r) : "v"(lo), "v"(hi)); return r; }

template <class Epi, class Sched, bool ALIGN_EPI = false, bool SP2 = false>
__device__ __forceinline__ void gemm_phase(PG8_LAS unsigned char* lds, const Gemm g, const Sched& S, const Epi& E) {
    const int tid = ltid(), wid = __builtin_amdgcn_readfirstlane(tid >> 6), lane = tid & 63, wr = wid >> 2, wc = wid & 3, fr = lane & 15, fq = lane >> 4;
    const int K = g.K, nt = K / BK;
    unsigned voffA[2], voffB[2];
#pragma unroll
    for (int i = 0; i < 2; ++i) { int R, C; stage_rc(tid * 16 + i * 8192, R, C); const int Rb = Epi::PERM ? ((R & ~31) + perm32(R & 31)) : R;
        voffA[i] = (unsigned)(R * K + C) * 2u; voffB[i] = (unsigned)(Rb * K + C) * 2u; }
    const size_t kstep = (size_t)(BK * 2);
    const size_t hstep = (size_t)HALF * K * 2;
    const size_t tstep = 2 * hstep;
    const unsigned ldsw = (unsigned)wid * 1024u;
    const int aoff = lds_byte(wr * 64 + fr, fq * 8), boff = lds_byte(wc * 32 + fr, fq * 8);
#define PG8_SA(b, h) (((b) * 2 + (h)) * HTB)
#define PG8_SB(b, h) ((4 + (b) * 2 + (h)) * HTB)
#define PG8_STAGE(bufoff, gbase, voff) do { _Pragma("unroll") for (int _i = 0; _i < 2; ++_i) \
        __builtin_amdgcn_global_load_lds((const unsigned*)((const char*)(gbase) + (voff)[_i]), (PG8_LAS unsigned*)(lds + (bufoff) + ldsw + _i * 8192), 16, 0, 0); } while (0)
#define PG8_LDA(dst, b, h) do { _Pragma("unroll") for (int m = 0; m < 4; ++m) _Pragma("unroll") for (int k = 0; k < 2; ++k) dst[m][k] = *(const PG8_LAS bf16x8*)(lds + PG8_SA(b, h) + aoff + m * 2048 + k * 1024); } while (0)
#define PG8_LDB(dst, b, h) do { _Pragma("unroll") for (int n = 0; n < 2; ++n) _Pragma("unroll") for (int k = 0; k < 2; ++k) dst[n][k] = *(const PG8_LAS bf16x8*)(lds + PG8_SB(b, h) + boff + n * 2048 + k * 1024); } while (0)
#define PG8_MMA(ai, bj, At, Bt) do { __builtin_amdgcn_s_setprio(1); _Pragma("unroll") for (int m = 0; m < 4; ++m) _Pragma("unroll") for (int n = 0; n < 2; ++n) _Pragma("unroll") for (int k = 0; k < 2; ++k) \
        acc[ai][bj][m][n] = __builtin_amdgcn_mfma_f32_16x16x32_bf16(Bt[n][k], At[m][k], acc[ai][bj][m][n], 0, 0, 0); __builtin_amdgcn_s_setprio(0); } while (0)
#define PG8_WAIT_V(n) asm volatile("s_waitcnt vmcnt(" #n ")" ::: "memory")
#define PG8_WAIT_L(n) asm volatile("s_waitcnt lgkmcnt(" #n ")" ::: "memory")
#define PG8_BAR __builtin_amdgcn_s_barrier()
#define PG8_SCHED __builtin_amdgcn_sched_barrier(0)
    Unit cur, nxt; int ui = 0;
    if (!S.next(0, cur)) return;
    f32x4 acc[2][2][4][2];
#pragma unroll
    for (int a = 0; a < 2; ++a)
#pragma unroll
        for (int b = 0; b < 2; ++b)
#pragma unroll
            for (int m = 0; m < 4; ++m)
#pragma unroll
                for (int n = 0; n < 2; ++n) acc[a][b][m][n] = (f32x4){0.f, 0.f, 0.f, 0.f};
    bf16x8 At[4][2], B0[2][2], B1[2][2];
    const char* cA = (const char*)g.A + (size_t)cur.pm * tstep; const char* cB = (const char*)g.Bt + (size_t)cur.pn * tstep;
    S.a_ready(cur);
    if constexpr (SP2) {
        PG8_STAGE(PG8_SB(0, 0), cB, voffB); PG8_STAGE(PG8_SB(0, 1), cB + hstep, voffB); PG8_STAGE(PG8_SA(0, 0), cA, voffA); PG8_STAGE(PG8_SA(0, 1), cA + hstep, voffA);
        if (wr == 1) PG8_BAR;
        PG8_WAIT_V(2); PG8_BAR;
        PG8_STAGE(PG8_SB(1, 0), cB + kstep, voffB); PG8_STAGE(PG8_SA(1, 0), cA + kstep, voffA); PG8_STAGE(PG8_SB(1, 1), cB + hstep + kstep, voffB);
        PG8_WAIT_V(6); PG8_BAR;
    } else {
        PG8_STAGE(PG8_SB(0, 0), cB, voffB); PG8_STAGE(PG8_SA(0, 0), cA, voffA); PG8_STAGE(PG8_SB(0, 1), cB + hstep, voffB); PG8_STAGE(PG8_SA(0, 1), cA + hstep, voffA);
        if (wr == 1) PG8_BAR;
        PG8_WAIT_V(4); PG8_BAR;
        PG8_STAGE(PG8_SB(1, 0), cB + kstep, voffB); PG8_STAGE(PG8_SA(1, 0), cA + kstep, voffA); PG8_STAGE(PG8_SB(1, 1), cB + hstep + kstep, voffB);
        PG8_WAIT_V(6); PG8_BAR;
    }
    for (;;) {
        const bool has_next = S.next(ui + 1, nxt);
        const char* nA = has_next ? (const char*)g.A + (size_t)nxt.pm * tstep : cA; const char* nB = has_next ? (const char*)g.Bt + (size_t)nxt.pn * tstep : cB;
#pragma unroll 1
        for (int t = 0; t < nt; t += 2) {
            const bool last = (t == nt - 2);
            const char* a1 = cA + (size_t)(t + 1) * kstep;
            const char* a2 = last ? nA : cA + (size_t)(t + 2) * kstep; const char* b2 = last ? nB : cB + (size_t)(t + 2) * kstep;
            const char* a3 = a2 + kstep; const char* b3 = b2 + kstep;
            if (last && has_next) S.a_ready(nxt);
            if constexpr (SP2) {
            PG8_LDB(B0, 0, 0); PG8_LDB(B1, 0, 1); PG8_SCHED; PG8_LDA(At, 0, 0); PG8_STAGE(PG8_SA(1, 1), a1 + hstep, voffA);
            PG8_WAIT_V(8); PG8_WAIT_L(0); PG8_BAR; PG8_MMA(0, 0, At, B0); PG8_MMA(0, 1, At, B1); PG8_BAR; PG8_SCHED;
            PG8_LDA(At, 0, 1); PG8_STAGE(PG8_SB(0, 0), b2, voffB); PG8_STAGE(PG8_SB(0, 1), b2 + hstep, voffB); PG8_STAGE(PG8_SA(0, 0), a2, voffA);
            PG8_WAIT_V(8); PG8_WAIT_L(0); PG8_BAR; PG8_MMA(1, 0, At, B0); PG8_MMA(1, 1, At, B1); PG8_BAR; PG8_SCHED;
            PG8_LDB(B0, 1, 0); PG8_LDB(B1, 1, 1); PG8_SCHED; PG8_LDA(At, 1, 0); PG8_STAGE(PG8_SA(0, 1), a2 + hstep, voffA);
            PG8_WAIT_V(8); PG8_WAIT_L(0); PG8_BAR; PG8_MMA(0, 0, At, B0); PG8_MMA(0, 1, At, B1); PG8_BAR; PG8_SCHED;
            PG8_LDA(At, 1, 1); PG8_STAGE(PG8_SB(1, 0), b3, voffB); PG8_STAGE(PG8_SB(1, 1), b3 + hstep, voffB); PG8_STAGE(PG8_SA(1, 0), a3, voffA);
            PG8_WAIT_V(8); PG8_WAIT_L(0); PG8_BAR; PG8_MMA(1, 0, At, B0); PG8_MMA(1, 1, At, B1); PG8_BAR; PG8_SCHED;
            } else {
            PG8_LDB(B0, 0, 0); PG8_SCHED; PG8_LDA(At, 0, 0); PG8_STAGE(PG8_SA(1, 1), a1 + hstep, voffA);
            PG8_WAIT_L(8); PG8_BAR; PG8_WAIT_L(0); PG8_MMA(0, 0, At, B0); PG8_BAR; PG8_SCHED;
            PG8_LDB(B1, 0, 1); PG8_STAGE(PG8_SB(0, 0), b2, voffB);
            PG8_BAR; PG8_WAIT_L(0); PG8_MMA(0, 1, At, B1); PG8_BAR;
            PG8_LDA(At, 0, 1); PG8_STAGE(PG8_SA(0, 0), a2, voffA);
            PG8_BAR; PG8_WAIT_L(0); PG8_MMA(1, 0, At, B0); PG8_BAR; PG8_SCHED;
            PG8_STAGE(PG8_SB(0, 1), b2 + hstep, voffB);
            PG8_WAIT_V(6); PG8_BAR; PG8_MMA(1, 1, At, B1); PG8_BAR;
            PG8_LDB(B0, 1, 0); PG8_SCHED; PG8_LDA(At, 1, 0); PG8_STAGE(PG8_SA(0, 1), a2 + hstep, voffA);
            PG8_WAIT_L(8); PG8_BAR; PG8_WAIT_L(0); PG8_MMA(0, 0, At, B0); PG8_BAR; PG8_SCHED;
            PG8_LDB(B1, 1, 1); PG8_STAGE(PG8_SB(1, 0), b3, voffB);
            PG8_BAR; PG8_WAIT_L(0); PG8_MMA(0, 1, At, B1); PG8_BAR;
            PG8_LDA(At, 1, 1); PG8_STAGE(PG8_SA(1, 0), a3, voffA);
            PG8_BAR; PG8_WAIT_L(0); PG8_MMA(1, 0, At, B0); PG8_BAR; PG8_SCHED;
            PG8_STAGE(PG8_SB(1, 1), b3 + hstep, voffB);
            PG8_WAIT_V(6); PG8_BAR; PG8_MMA(1, 1, At, B1); PG8_BAR;
            }
        }
        if constexpr (ALIGN_EPI) { if (wr == 0) PG8_BAR; }
        if constexpr (!Epi::AFTER_DRAIN) { PG8_SCHED; int fr_l = fr, fq_l = fq; asm volatile("" : "+v"(fr_l), "+v"(fq_l) :: "memory"); E(acc, cur, wr, wc, fr_l, fq_l); asm volatile("" ::: "memory"); PG8_SCHED; S.done(cur); }
        if (!has_next) break;
#pragma unroll
        for (int a = 0; a < 2; ++a)
#pragma unroll
            for (int b = 0; b < 2; ++b)
#pragma unroll
                for (int m = 0; m < 4; ++m)
#pragma unroll
                    for (int n = 0; n < 2; ++n) acc[a][b][m][n] = (f32x4){0.f, 0.f, 0.f, 0.f};
        cur = nxt; cA = nA; cB = nB; ++ui;
        if constexpr (ALIGN_EPI) { if (wr == 1) PG8_BAR; }
    }
    PG8_WAIT_V(0);
    if constexpr (!ALIGN_EPI) { if (wr == 0) PG8_BAR; }
    PG8_BAR;
#undef PG8_SA
#undef PG8_SB
#undef PG8_STAGE
#undef PG8_LDA
#undef PG8_LDB
#undef PG8_MMA
#undef PG8_WAIT_V
#undef PG8_WAIT_L
#undef PG8_BAR
#undef PG8_SCHED
}
}

constexpr int BATCH = 16, SEQ = 4096, DM = 1024, TT = BATCH * SEQ;
constexpr int NB = 4, TG = NB * SEQ, NROUND = BATCH / NB;
constexpr int NPROJ = 8960;
constexpr float EPS = 1e-6f;
constexpr int LDS_BYTES = 147456;
constexpr size_t MiB = 1u << 20;
constexpr size_t WS_MOD = 1 * MiB, WS_WIN = 2 * MiB, WS_WUQ = 20 * MiB, WS_WUKN = 21 * MiB, WS_WUV = 22 * MiB, WS_WOA = 23 * MiB, WS_WOB = 25 * MiB,
                 WS_WOUT = 29 * MiB, WS_WFF1 = 31 * MiB, WS_WFF2 = 39 * MiB, WS_ROPE = 48 * MiB, WS_SSQ = 64 * MiB, WS_DEC = 65 * MiB;
constexpr size_t WS_H = 66 * MiB, WS_QL = 98 * MiB, WS_KVL = 106 * MiB, WS_KR = 114 * MiB, WS_DT = 116 * MiB, WS_Z = 118 * MiB, WS_XBC = 182 * MiB,
                 WS_SGA = 310 * MiB, WS_SGB = 342 * MiB, WS_QN = 374 * MiB, WS_QR = 406 * MiB, WS_KN = 422 * MiB, WS_VT = 454 * MiB, WS_CC = 486 * MiB,
                 WS_BC = 518 * MiB, WS_BT = 550 * MiB, WS_XT = 582 * MiB, WS_ATT = 646 * MiB, WS_ST = 678 * MiB, WS_HP = 806 * MiB, WS_SSM = 870 * MiB,
                 WS_END = 934 * MiB;
constexpr size_t WS_FF1 = WS_XBC, WS_MA = WS_QN, WS_MERGED = WS_KN, WS_MIX = WS_VT, WS_FF = WS_ATT;

__device__ const double ROPE_INV[32] = {1.0, 0.7498942093324559, 0.5623413251903491, 0.4216965034285822, 0.31622776601683794, 0.23713737056616552, 0.1778279410038923, 0.1333521432163324, 0.1, 0.07498942093324558, 0.05623413251903491, 0.042169650342858224, 0.03162277660168379, 0.023713737056616554, 0.01778279410038923, 0.01333521432163324, 0.01, 0.007498942093324558, 0.005623413251903491, 0.004216965034285823, 0.0031622776601683794, 0.0023713737056616554, 0.0017782794100389228, 0.001333521432163324, 0.001, 0.0007498942093324559, 0.0005623413251903491, 0.00042169650342858224, 0.00031622776601683794, 0.00023713737056616554, 0.00017782794100389227, 0.0001333521432163324};

__device__ __forceinline__ unsigned pk2(float lo, float hi) { return pg8::cvt_pk_bf16(lo, hi); }
__device__ __forceinline__ float bflo(unsigned w) { return __builtin_bit_cast(float, w << 16); }
__device__ __forceinline__ float bfhi(unsigned w) { return __builtin_bit_cast(float, w & 0xffff0000u); }
__device__ __forceinline__ float wave_sum(float v) {
#pragma unroll
    for (int o = 1; o < 64; o <<= 1) v += __shfl_xor(v, o);
    return v;
}
__device__ __forceinline__ void st8(bf16_t* p, f32x4 a, f32x4 b) { u32x4 w; w.x = pk2(a[0], a[1]); w.y = pk2(a[2], a[3]); w.z = pk2(b[0], b[1]); w.w = pk2(b[2], b[3]); *(u32x4*)p = w; }
__device__ __forceinline__ void ld8(const bf16_t* p, f32x4& a, f32x4& b) { const u32x4 w = *(const u32x4*)p; a[0] = bflo(w.x); a[1] = bfhi(w.x); a[2] = bflo(w.y); a[3] = bfhi(w.y); b[0] = bflo(w.z); b[1] = bfhi(w.z); b[2] = bflo(w.w); b[3] = bfhi(w.w); }
__device__ __forceinline__ float sigm(float x) { return 1.f / (1.f + __expf(-x)); }
__device__ __forceinline__ float silu(float x) { return x / (1.f + __expf(-x)); }
__device__ __forceinline__ float softplus(float x) {
    const float e = __expf(-fabsf(x));
    const float l = e < 0.03125f ? e * (1.f - e * (0.5f - e * (0.33333334f - 0.25f * e))) : __logf(1.f + e);
    return fmaxf(x, 0.f) + l;
}
__device__ __forceinline__ float bf2f_lds(const LAS unsigned char* p) { return __builtin_bit_cast(float, (unsigned)(*(const LAS unsigned short*)p) << 16); }
__device__ __forceinline__ float dot4(f32x4 a) { return (a[0] * a[0] + a[1] * a[1]) + (a[2] * a[2] + a[3] * a[3]); }
#define LDS_WAIT() asm volatile("s_waitcnt lgkmcnt(0)" ::: "memory")

__device__ __forceinline__ int srcmap(int map, int r) {
    if (map == 0) return r;
    if (map == 1) {
        if (r < 512) return r;
        if (r < 6656) return r + 64;
        if (r < 8704) return r + 96;
        if (r < 8768) { const int j = r - 8704, g8 = j >> 3, e = j & 7; return 512 + (e < 4 ? 4 * g8 + e : 32 + 4 * g8 + (e - 4)); }
        if (r < 8800) return 6720 + (r - 8768);
        return -1;
    }
    if (map == 2) {
        if (r < 1024) return (r >> 7) * 192 + (r & 127);
        const int rr = r - 1024, h = rr >> 6, j = rr & 63, g8 = j >> 3, e = j & 7;
        return h * 192 + 128 + (e < 4 ? 4 * g8 + e : 32 + 4 * g8 + (e - 4));
    }
    if (map == 3) return (r >> 7) * 256 + (r & 127);
    return (r >> 7) * 256 + 128 + (r & 127);
}
__device__ __forceinline__ void transpose_item(const float* W, int K, int N, bf16_t* WT, int map, const float* ks, int nblk, LAS float* scr, int item, int lane) {
    const int kb = item / nblk, nb = item % nblk, k0 = 64 * kb, n0 = 32 * nb;
    const int src = srcmap(map, n0 + (lane & 31));
#pragma unroll 8
    for (int i = 0; i < 32; ++i) { const int kk = 2 * i + (lane >> 5); float v = src >= 0 ? W[(size_t)(k0 + kk) * N + src] : 0.f; if (ks) v *= ks[k0 + kk]; scr[kk * 33 + (lane & 31)] = v; }
    LDS_WAIT(); asm volatile("" ::: "memory");
    const int c = lane & 7;
#pragma unroll
    for (int j = 0; j < 4; ++j) { const int n = (lane >> 3) + 8 * j; const LAS float* s = scr + (8 * c) * 33 + n;
        u32x4 o; o.x = pk2(s[0 * 33], s[1 * 33]); o.y = pk2(s[2 * 33], s[3 * 33]); o.z = pk2(s[4 * 33], s[5 * 33]); o.w = pk2(s[6 * 33], s[7 * 33]);
        *(u32x4*)(WT + (size_t)(n0 + n) * K + k0 + 8 * c) = o; }
    LDS_WAIT(); asm volatile("" ::: "memory");
}

#define ACC_T const f32x4 (&acc)[2][2][4][2]
struct EpiProj {
    static constexpr bool PERM = true, AFTER_DRAIN = false;
    bf16_t *QL, *KVL, *KR, *Z, *XBC, *SGA, *SGB; float* DT; float *ssq_q, *ssq_kv; const float* rope; const float* dt_bias; int tbase;
    __device__ __forceinline__ void operator()(ACC_T, const pg8::Unit& u, int wr, int wc, int fr, int fq) const {
        const int pn = u.pn, row0 = u.pm * 256 + wr * 64 + fr, cw = wc * 32 + 8 * fq;
        if (pn < 2) {
            bf16_t* O = pn == 0 ? QL : KVL; float* sq = (pn == 0 ? ssq_q : ssq_kv) + tbase;
#pragma unroll
            for (int ai = 0; ai < 2; ++ai)
#pragma unroll
                for (int m = 0; m < 4; ++m) { const int row = row0 + ai * 128 + m * 16; float s = 0.f;
#pragma unroll
                    for (int bj = 0; bj < 2; ++bj) { const f32x4 v0 = acc[ai][bj][m][0], v1 = acc[ai][bj][m][1]; st8(O + (unsigned)row * 256u + cw + bj * 128, v0, v1); s += dot4(v0) + dot4(v1); }
                    s += __shfl_xor(s, 16); s += __shfl_xor(s, 32);
                    if (fq == 0) unsafeAtomicAdd(sq + row, s); }
        } else if (pn < 26) {
            bf16_t* O; int ld, c0; if (pn < 10) { O = Z; ld = 2048; c0 = (pn - 2) * 256; } else { O = XBC; ld = 4096; c0 = (pn - 10) * 256; }
#pragma unroll
            for (int ai = 0; ai < 2; ++ai)
#pragma unroll
                for (int m = 0; m < 4; ++m) { const int row = row0 + ai * 128 + m * 16;
#pragma unroll
                    for (int bj = 0; bj < 2; ++bj) st8(O + (unsigned)row * (unsigned)ld + c0 + cw + bj * 128, acc[ai][bj][m][0], acc[ai][bj][m][1]); }
        } else if (pn < 34) {
            bf16_t* O = pn < 30 ? SGA : SGB; const int c0 = ((pn - 26) & 3) * 256;
#pragma unroll
            for (int ai = 0; ai < 2; ++ai)
#pragma unroll
                for (int m = 0; m < 4; ++m) { const int row = row0 + ai * 128 + m * 16;
#pragma unroll
                    for (int bj = 0; bj < 2; ++bj) { f32x4 v0 = acc[ai][bj][m][0], v1 = acc[ai][bj][m][1];
#pragma unroll
                        for (int e = 0; e < 4; ++e) { v0[e] = sigm(v0[e]); v1[e] = sigm(v1[e]); }
                        st8(O + (unsigned)row * 1024u + c0 + cw + bj * 128, v0, v1); }
                    asm volatile("" ::: "memory"); }
        } else {
            if (wc < 2) {
                const int g8 = wc * 4 + fq;
#pragma unroll
                for (int ai = 0; ai < 2; ++ai)
#pragma unroll
                    for (int m = 0; m < 4; ++m) { const int row = row0 + ai * 128 + m * 16; const f32x4 v0 = acc[ai][0][m][0], v1 = acc[ai][0][m][1];
                        const f32x4* rp = (const f32x4*)(rope + (unsigned)((tbase + row) * 64 + 8 * g8)); const f32x4 c01 = rp[0], c23 = rp[1];
                        f32x4 o1, o2;
                        o1[0] = v0[0] * c01[0] - v1[0] * c01[1]; o2[0] = v0[0] * c01[1] + v1[0] * c01[0];
                        o1[1] = v0[1] * c01[2] - v1[1] * c01[3]; o2[1] = v0[1] * c01[3] + v1[1] * c01[2];
                        o1[2] = v0[2] * c23[0] - v1[2] * c23[1]; o2[2] = v0[2] * c23[1] + v1[2] * c23[0];
                        o1[3] = v0[3] * c23[2] - v1[3] * c23[3]; o2[3] = v0[3] * c23[3] + v1[3] * c23[2];
                        st8(KR + (unsigned)row * 64u + 8 * g8, o1, o2); asm volatile("" ::: "memory"); }
            } else if (wc == 2) {
                const int i0 = 8 * fq; const f32x4 b0 = *(const f32x4*)(dt_bias + i0), b1 = *(const f32x4*)(dt_bias + i0 + 4);
#pragma unroll
                for (int ai = 0; ai < 2; ++ai)
#pragma unroll
                    for (int m = 0; m < 4; ++m) { const int row = row0 + ai * 128 + m * 16; f32x4 v0 = acc[ai][0][m][0] + b0, v1 = acc[ai][0][m][1] + b1;
#pragma unroll
                        for (int e = 0; e < 4; ++e) { v0[e] = softplus(v0[e]); v1[e] = softplus(v1[e]); }
                        *(f32x4*)(DT + (unsigned)row * 32u + i0) = v0; *(f32x4*)(DT + (unsigned)row * 32u + i0 + 4) = v1; asm volatile("" ::: "memory"); }
            }
        }
    }
};
struct EpiQ {
    static constexpr bool PERM = true, AFTER_DRAIN = false;
    bf16_t *QN, *QR; const float* ssq; const float* rope; int tbase; float c2;
    __device__ __forceinline__ void operator()(ACC_T, const pg8::Unit& u, int wr, int wc, int fr, int fq) const {
        const int pn = u.pn, row0 = u.pm * 256 + wr * 64 + fr, cw = wc * 32 + 8 * fq;
#pragma unroll
        for (int ai = 0; ai < 2; ++ai)
#pragma unroll
            for (int m = 0; m < 4; ++m) { const int row = row0 + ai * 128 + m * 16; const float rs = rsqrtf(ssq[tbase + row] * (1.f / 256.f) + EPS) * c2;
#pragma unroll
                for (int bj = 0; bj < 2; ++bj) { const f32x4 v0 = acc[ai][bj][m][0] * rs, v1 = acc[ai][bj][m][1] * rs;
                    if (pn < 4) st8(QN + (unsigned)row * 1024u + pn * 256 + cw + bj * 128, v0, v1);
                    else { const int colr = (pn - 4) * 256 + cw + bj * 128, g8 = (colr & 63) >> 3;
                        const f32x4* rp = (const f32x4*)(rope + (unsigned)((tbase + row) * 64 + 8 * g8)); const f32x4 c01 = rp[0], c23 = rp[1];
                        f32x4 o1, o2;
                        o1[0] = v0[0] * c01[0] - v1[0] * c01[1]; o2[0] = v0[0] * c01[1] + v1[0] * c01[0];
                        o1[1] = v0[1] * c01[2] - v1[1] * c01[3]; o2[1] = v0[1] * c01[3] + v1[1] * c01[2];
                        o1[2] = v0[2] * c23[0] - v1[2] * c23[1]; o2[2] = v0[2] * c23[1] + v1[2] * c23[0];
                        o1[3] = v0[3] * c23[2] - v1[3] * c23[3]; o2[3] = v0[3] * c23[3] + v1[3] * c23[2];
                        st8(QR + (unsigned)row * 512u + colr, o1, o2); } }
                asm volatile("" ::: "memory"); }
    }
};
struct EpiRowScale {
    static constexpr bool PERM = true, AFTER_DRAIN = false;
    bf16_t* O; int ldc; const float* ssq; int tbase;
    __device__ __forceinline__ void operator()(ACC_T, const pg8::Unit& u, int wr, int wc, int fr, int fq) const {
        const int row0 = u.pm * 256 + wr * 64 + fr, col0 = u.pn * 256 + wc * 32 + 8 * fq;
#pragma unroll
        for (int ai = 0; ai < 2; ++ai)
#pragma unroll
            for (int m = 0; m < 4; ++m) { const int row = row0 + ai * 128 + m * 16; const float rs = rsqrtf(ssq[tbase + row] * (1.f / 256.f) + EPS);
#pragma unroll
                for (int bj = 0; bj < 2; ++bj) st8(O + (unsigned)row * (unsigned)ldc + col0 + bj * 128, acc[ai][bj][m][0] * rs, acc[ai][bj][m][1] * rs);
                asm volatile("" ::: "memory"); }
    }
};
struct EpiColScale {
    static constexpr bool PERM = true, AFTER_DRAIN = false;
    bf16_t* O; int ldc; const float* ssq; int tbase;
    __device__ __forceinline__ void operator()(ACC_T, const pg8::Unit& u, int wr, int wc, int fr, int fq) const {
        const int row0 = u.pm * 256 + wr * 64 + fr, col0 = u.pn * 256 + wc * 32 + 8 * fq;
#pragma unroll
        for (int bj = 0; bj < 2; ++bj) {
            f32x4 r0 = *(const f32x4*)(ssq + tbase + col0 + bj * 128), r1 = *(const f32x4*)(ssq + tbase + col0 + bj * 128 + 4);
#pragma unroll
            for (int e = 0; e < 4; ++e) { r0[e] = rsqrtf(r0[e] * (1.f / 256.f) + EPS); r1[e] = rsqrtf(r1[e] * (1.f / 256.f) + EPS); }
#pragma unroll
            for (int ai = 0; ai < 2; ++ai)
#pragma unroll
                for (int m = 0; m < 4; ++m) { const int row = row0 + ai * 128 + m * 16; st8(O + (unsigned)row * (unsigned)ldc + col0 + bj * 128, acc[ai][bj][m][0] * r0, acc[ai][bj][m][1] * r1); }
            asm volatile("" ::: "memory");
        }
    }
};
template <int MODE> struct EpiGate {
    static constexpr bool PERM = true, AFTER_DRAIN = false;
    bf16_t* O; const bf16_t* G; const bf16_t* P;
    __device__ __forceinline__ void operator()(ACC_T, const pg8::Unit& u, int wr, int wc, int fr, int fq) const {
        const int row0 = u.pm * 256 + wr * 64 + fr, col0 = u.pn * 256 + wc * 32 + 8 * fq;
#pragma unroll
        for (int ai = 0; ai < 2; ++ai)
#pragma unroll
            for (int m = 0; m < 4; ++m) { const int row = row0 + ai * 128 + m * 16;
#pragma unroll
                for (int bj = 0; bj < 2; ++bj) { const unsigned off = (unsigned)row * 1024u + col0 + bj * 128; f32x4 g0, g1; ld8(G + off, g0, g1);
                    f32x4 v0 = acc[ai][bj][m][0] * g0, v1 = acc[ai][bj][m][1] * g1;
                    if (MODE == 1) { f32x4 p0, p1; ld8(P + off, p0, p1); v0 += p0; v1 += p1; }
                    st8(O + off, v0, v1); }
                asm volatile("" ::: "memory"); }
    }
};
struct EpiSsq {
    static constexpr bool PERM = true, AFTER_DRAIN = false;
    bf16_t* O; int ldc; float* ssq; int tbase;
    __device__ __forceinline__ void operator()(ACC_T, const pg8::Unit& u, int wr, int wc, int fr, int fq) const {
        const int row0 = u.pm * 256 + wr * 64 + fr, col0 = u.pn * 256 + wc * 32 + 8 * fq;
#pragma unroll
        for (int ai = 0; ai < 2; ++ai)
#pragma unroll
            for (int m = 0; m < 4; ++m) { const int row = row0 + ai * 128 + m * 16; float s = 0.f;
#pragma unroll
                for (int bj = 0; bj < 2; ++bj) { const f32x4 v0 = acc[ai][bj][m][0], v1 = acc[ai][bj][m][1]; st8(O + (unsigned)row * (unsigned)ldc + col0 + bj * 128, v0, v1); s += dot4(v0) + dot4(v1); }
                s += __shfl_xor(s, 16); s += __shfl_xor(s, 32);
                if (fq == 0) unsafeAtomicAdd(ssq + tbase + row, s); }
    }
};
struct EpiRelu2 {
    static constexpr bool PERM = true, AFTER_DRAIN = false;
    bf16_t* O; int ldc;
    __device__ __forceinline__ void operator()(ACC_T, const pg8::Unit& u, int wr, int wc, int fr, int fq) const {
        const int row0 = u.pm * 256 + wr * 64 + fr, col0 = u.pn * 256 + wc * 32 + 8 * fq;
#pragma unroll
        for (int ai = 0; ai < 2; ++ai)
#pragma unroll
            for (int m = 0; m < 4; ++m) { const int row = row0 + ai * 128 + m * 16;
#pragma unroll
                for (int bj = 0; bj < 2; ++bj) { f32x4 v0 = acc[ai][bj][m][0], v1 = acc[ai][bj][m][1];
#pragma unroll
                    for (int e = 0; e < 4; ++e) { const float a = fmaxf(v0[e], 0.f), b = fmaxf(v1[e], 0.f); v0[e] = a * a; v1[e] = b * b; }
                    st8(O + (unsigned)row * (unsigned)ldc + col0 + bj * 128, v0, v1); } }
    }
};

constexpr int ATT_KB = 24576, ATT_BUF = 40960;
__device__ __forceinline__ void attn_unit(LAS unsigned char* lds, const bf16_t* QN, const bf16_t* QR, const bf16_t* KN, const bf16_t* KR, const bf16_t* VT, bf16_t* ATT, int b, int h, int qb) {
    const int tid = ltid(), wid = __builtin_amdgcn_readfirstlane(tid >> 6), lane = tid & 63, r32 = lane & 31, hf = lane >> 5;
    const int tb = b * SEQ, q0w = qb * 256 + wid * 32;
    bf16x8 qf[12];
    { const unsigned t = (unsigned)(tb + q0w + r32);
#pragma unroll
      for (int ks = 0; ks < 8; ++ks) qf[ks] = *(const bf16x8*)(QN + t * 1024u + h * 128 + ks * 16 + hf * 8);
#pragma unroll
      for (int ks = 0; ks < 4; ++ks) qf[8 + ks] = *(const bf16x8*)(QR + t * 512u + h * 64 + ks * 16 + hf * 8); }
    f32x16 o[4];
#pragma unroll
    for (int i = 0; i < 4; ++i)
#pragma unroll
        for (int r = 0; r < 16; ++r) o[i][r] = 0.f;
    float m_i = -INFINITY, l_i = 0.f;
    const int nkt = 4 * (qb + 1);
    unsigned ksrc[3]; unsigned vsrc[2];
#pragma unroll
    for (int i = 0; i < 3; ++i) { const int pid = (wid + 8 * i) * 64 + lane, row = pid / 24, cp = pid % 24, c = (cp & ~7) | ((cp ^ row) & 7);
        ksrc[i] = c < 16 ? (unsigned)((tb + row) * 1024 + h * 128 + c * 8) : (0x80000000u | (unsigned)((tb + row) * 64 + (c - 16) * 8)); }
#pragma unroll
    for (int i = 0; i < 2; ++i) { const int pid = (wid + 8 * i) * 64 + lane, dv = pid >> 3, cp = pid & 7, c = cp ^ (dv & 7);
        vsrc[i] = (unsigned)((h * 128 + dv) * TG + tb + c * 8); }
#define ATT_DMA(kt, buf) do { \
    _Pragma("unroll") for (int i = 0; i < 3; ++i) { const bf16_t* src = (ksrc[i] & 0x80000000u) ? KR + ((ksrc[i] & 0x7fffffffu) + (unsigned)(kt) * 4096u) : KN + (ksrc[i] + (unsigned)(kt) * 65536u); \
        __builtin_amdgcn_global_load_lds((const unsigned*)src, (LAS unsigned*)(lds + (buf) * ATT_BUF + (wid + 8 * i) * 1024), 16, 0, 0); } \
    _Pragma("unroll") for (int i = 0; i < 2; ++i) \
        __builtin_amdgcn_global_load_lds((const unsigned*)(VT + (vsrc[i] + (unsigned)(kt) * 64u)), (LAS unsigned*)(lds + (buf) * ATT_BUF + ATT_KB + (wid + 8 * i) * 1024), 16, 0, 0); } while (0)
    __syncthreads();
    ATT_DMA(0, 0);
    const int tx = hf ^ (r32 & 7);
    for (int kt = 0; kt < nkt; ++kt) {
        asm volatile("s_waitcnt vmcnt(0)" ::: "memory");
        __syncthreads();
        if (kt + 1 < nkt) ATT_DMA(kt + 1, (kt + 1) & 1);
        const LAS unsigned char* kbuf = lds + (kt & 1) * ATT_BUF; const LAS unsigned char* vbuf = kbuf + ATT_KB;
        const int key0 = kt * 64;
        if (key0 <= q0w + 31) {
            f32x16 s[2];
#pragma unroll
            for (int kb = 0; kb < 2; ++kb) {
#pragma unroll
                for (int r = 0; r < 16; ++r) s[kb][r] = 0.f;
                const LAS unsigned char* krow = kbuf + (kb * 32 + r32) * 384;
#pragma unroll
                for (int ks = 0; ks < 12; ++ks) { const bf16x8 a = *(const LAS bf16x8*)(krow + (((2 * ks) & ~7) + (((2 * ks) & 7) ^ tx)) * 16);
                    s[kb] = __builtin_amdgcn_mfma_f32_32x32x16_bf16(a, qf[ks], s[kb], 0, 0, 0);
                    if ((ks & 3) == 3) __builtin_amdgcn_sched_barrier(0); }
            }
            if (key0 + 63 > q0w) {
                const int qi = q0w + r32;
#pragma unroll
                for (int kb = 0; kb < 2; ++kb)
#pragma unroll
                    for (int r = 0; r < 16; ++r) { const int key = key0 + kb * 32 + (r & 3) + 8 * (r >> 2) + 4 * hf; if (key > qi) s[kb][r] = -INFINITY; }
            }
            float mx = s[0][0];
#pragma unroll
            for (int kb = 0; kb < 2; ++kb)
#pragma unroll
                for (int r = 0; r < 16; ++r) mx = fmaxf(mx, s[kb][r]);
            mx = fmaxf(mx, __shfl_xor(mx, 32));
            const float m_new = fmaxf(m_i, mx), alpha = __builtin_amdgcn_exp2f(m_i - m_new);
            float ps = 0.f;
#pragma unroll
            for (int kb = 0; kb < 2; ++kb)
#pragma unroll
                for (int r = 0; r < 16; ++r) { const float p = __builtin_amdgcn_exp2f(s[kb][r] - m_new); s[kb][r] = p; ps += p; }
            l_i = l_i * alpha + ps; m_i = m_new;
#pragma unroll
            for (int i = 0; i < 4; ++i)
#pragma unroll
                for (int r = 0; r < 16; ++r) o[i][r] *= alpha;
            bf16x8 pb[2][2];
#pragma unroll
            for (int kb = 0; kb < 2; ++kb)
#pragma unroll
                for (int s2 = 0; s2 < 2; ++s2) { u32x4 w; w.x = pk2(s[kb][8 * s2 + 0], s[kb][8 * s2 + 1]); w.y = pk2(s[kb][8 * s2 + 2], s[kb][8 * s2 + 3]);
                    w.z = pk2(s[kb][8 * s2 + 4], s[kb][8 * s2 + 5]); w.w = pk2(s[kb][8 * s2 + 6], s[kb][8 * s2 + 7]); pb[kb][s2] = __builtin_bit_cast(bf16x8, w); }
            const int vx = r32 & 7;
#pragma unroll
            for (int dvb = 0; dvb < 4; ++dvb) {
                const LAS unsigned char* vrow = vbuf + (dvb * 32 + r32) * 128 + hf * 8;
#pragma unroll
                for (int kb = 0; kb < 2; ++kb)
#pragma unroll
                    for (int s2 = 0; s2 < 2; ++s2) { const int c = kb * 4 + s2 * 2;
                        const u32x2 lo = *(const LAS u32x2*)(vrow + ((c ^ vx) * 16)), hi = *(const LAS u32x2*)(vrow + (((c + 1) ^ vx) * 16)); u32x4 w; w.x = lo.x; w.y = lo.y; w.z = hi.x; w.w = hi.y;
                        o[dvb] = __builtin_amdgcn_mfma_f32_32x32x16_bf16(__builtin_bit_cast(bf16x8, w), pb[kb][s2], o[dvb], 0, 0, 0); }
                __builtin_amdgcn_sched_barrier(0);
            }
        }
    }
#undef ATT_DMA
    l_i += __shfl_xor(l_i, 32);
    const float inv = 1.f / l_i;
    bf16_t* orow = ATT + (unsigned)(tb + q0w + r32) * 1024u + h * 128;
#pragma unroll
    for (int dvb = 0; dvb < 4; ++dvb)
#pragma unroll
        for (int rg = 0; rg < 4; ++rg) { u32x2 w; w.x = pk2(o[dvb][4 * rg] * inv, o[dvb][4 * rg + 1] * inv); w.y = pk2(o[dvb][4 * rg + 2] * inv, o[dvb][4 * rg + 3] * inv);
            *(u32x2*)(orow + dvb * 32 + 8 * rg + 4 * hf) = w; }
}

constexpr int SP = 272;
__device__ __forceinline__ void ld_tile(LAS unsigned char* dst, const bf16_t* src, int rows) {
    for (int p = ltid(); p < rows * 16; p += 512) { const int r = p >> 4, c = p & 15; *(LAS u32x4*)(dst + r * SP + c * 16) = *(const u32x4*)(src + r * 128 + c * 8); }
}
__device__ __forceinline__ void chunk_prep(LAS float* dts, LAS float* acs, const float* DT, int trow0, int g, const float* a_log) {
    const int tid = ltid(), wid = tid >> 6, lane = tid & 63;
    if (wid < 4) {
        const float A = -__expf(a_log[g * 4 + wid]);
        const float d0 = DT[(size_t)(trow0 + 2 * lane) * 32 + g * 4 + wid], d1 = DT[(size_t)(trow0 + 2 * lane + 1) * 32 + g * 4 + wid];
        const float x0 = d0 * A, x1 = x0 + d1 * A;
        float incl = x1;
#pragma unroll
        for (int o = 1; o < 64; o <<= 1) { const float v = __shfl_up(incl, o); if (lane >= o) incl += v; }
        const float excl = incl - x1;
        acs[wid * 128 + 2 * lane] = excl + x0; acs[wid * 128 + 2 * lane + 1] = excl + x1;
        dts[wid * 128 + 2 * lane] = d0; dts[wid * 128 + 2 * lane + 1] = d1;
    }
    __syncthreads();
}
__device__ __forceinline__ bf16x8 ldsfrag(const LAS unsigned char* base, int row, int k0) { return *(const LAS bf16x8*)(base + row * SP + k0 * 2); }

#define XB_TMO      128
#define XB_XCNT(j)  (256  + 64 * (j))
#define XB_XSUB(j)  (1280 + 64 * (j))
#define XB_XGEN(j)  (2304 + 64 * (j))
#define XB_TOP      3328
#define XB_TOPGEN   3392
#define XCD_BAR_WORDS 3456
#define XB_SPIN_CAP (1u << 18)

__device__ __forceinline__ unsigned xb_ld(unsigned* p)              { return __hip_atomic_load(p, __ATOMIC_RELAXED, __HIP_MEMORY_SCOPE_AGENT); }
__device__ __forceinline__ unsigned xb_add(unsigned* p, unsigned v) { return __hip_atomic_fetch_add(p, v, __ATOMIC_RELAXED, __HIP_MEMORY_SCOPE_AGENT); }
__device__ __forceinline__ unsigned xb_xcc_id() { return (unsigned)__builtin_amdgcn_s_getreg((3 << 11) | 20) & 0xFu; }
#define XB_SPIN(cond, bar) do { unsigned _sp = 0; while (cond) { __builtin_amdgcn_s_sleep(1); \
    if ((++_sp & 255u) == 0u) { if (xb_ld(&(bar)[XB_TMO])) break; if (_sp > XB_SPIN_CAP) { atomicAdd(&(bar)[XB_TMO], 1u); break; } } } } while (0)

struct XcdBarrier {
    unsigned* bar; unsigned x;
    volatile LAS unsigned* st;
};

__device__ __forceinline__ XcdBarrier xcd_barrier_post(unsigned* bar, volatile LAS unsigned* st) {
    XcdBarrier b; b.bar = bar; b.x = xb_xcc_id(); b.st = st;
    if (threadIdx.x == 0) (void)xb_add(&bar[XB_XCNT(b.x)], 1u);
    return b;
}
__device__ __forceinline__ void xcd_barrier_complete(unsigned* bar, unsigned x, unsigned& nloc, unsigned& nx) {
    const unsigned G = gridDim.x * gridDim.y * gridDim.z;
    unsigned sum, cnt, mine, sp = 0u;
    for (;;) {
        sum = 0u; cnt = 0u; mine = 0u;
#pragma unroll
        for (unsigned j = 0; j < 16; ++j) { const unsigned c = xb_ld(&bar[XB_XCNT(j)]); sum += c; cnt += (c > 0u) ? 1u : 0u; mine = (j == x) ? c : mine; }
        if (sum == G) break;
        __builtin_amdgcn_s_sleep(1);
        if ((++sp & 255u) == 0u) { if (xb_ld(&bar[XB_TMO])) break; if (sp > XB_SPIN_CAP) { atomicAdd(&bar[XB_TMO], 1u); break; } }
    }
    nloc = mine > 0u ? mine : 1u; nx = cnt > 0u ? cnt : 1u;
}

__device__ __forceinline__ void xcd_barrier(const XcdBarrier& b) {
    asm volatile("s_waitcnt vmcnt(0)" ::: "memory");
    __syncthreads();
    if (threadIdx.x == 0) {
        unsigned* bar = b.bar;
        __builtin_amdgcn_s_waitcnt(0);
        unsigned nloc = b.st[0], nx = b.st[1];
        if (nloc == 0u) { xcd_barrier_complete(bar, b.x, nloc, nx); b.st[0] = nloc; b.st[1] = nx; }
        const unsigned old = xb_add(&bar[XB_XSUB(b.x)], 1u);
        const unsigned gen = old / nloc;
        if (old + 1u == (gen + 1u) * nloc) {
            __builtin_amdgcn_fence(__ATOMIC_RELEASE, "agent");
            asm volatile("s_waitcnt vmcnt(0)" ::: "memory");
            const unsigned og = xb_add(&bar[XB_TOP], 1u);
            const unsigned tg = og / nx;
            if (og + 1u == (tg + 1u) * nx) xb_add(&bar[XB_TOPGEN], 1u);
            else XB_SPIN(xb_ld(&bar[XB_TOPGEN]) == tg, bar);
            __builtin_amdgcn_fence(__ATOMIC_ACQUIRE, "agent");
            xb_add(&bar[XB_XGEN(b.x)], 1u);
            asm volatile("s_waitcnt vmcnt(0)" ::: "memory");
        } else {
            XB_SPIN(xb_ld(&bar[XB_XGEN(b.x)]) == gen, bar);
            __builtin_amdgcn_fence(__ATOMIC_ACQUIRE, "agent");
            asm volatile("s_waitcnt vmcnt(0)" ::: "memory");
        }
    }
    __syncthreads();
}

struct Args { const void* in[25]; float* out; unsigned char* ws; };
__device__ __forceinline__ const void* in_ptr(int i) {
    int off = i * 8; asm volatile("" : "+s"(off));
    const __attribute__((address_space(4))) char* kp = (const __attribute__((address_space(4))) char*)__builtin_amdgcn_kernarg_segment_ptr();
    return *(const void* const __attribute__((address_space(4)))*)(kp + off);
}
#define INF(i) ((const float*)in_ptr(i))
#define WSB() ((unsigned char*)in_ptr(26))
#define OUTP() ((float*)in_ptr(25))

__device__ __forceinline__ void ph_mod(LAS unsigned char* lds) {
    const int tid = ltid(), lane = tid & 63, wid = __builtin_amdgcn_readfirstlane(tid >> 6), G = lgrid(), bx = lbid();
    float* MOD = (float*)(WSB() + WS_MOD);
    const float* cvec = INF(1); const float* w_ada = INF(3); const float* b_ada = INF(4);
    for (int item = bx; item < 96; item += G) {
        LAS float* sc = (LAS float*)lds;
        LAS float* red = (LAS float*)(lds + 65536);
        for (int i = tid; i < 16384; i += 512) { const int b = i >> 10, k = i & 1023; sc[k * 16 + b] = silu(cvec[i]); }
        __syncthreads();
        const int kg = tid >> 4, cl = tid & 15, j0 = item * 64 + cl * 4;
        f32x4 ac[16];
#pragma unroll
        for (int b = 0; b < 16; ++b) ac[b] = (f32x4){0.f, 0.f, 0.f, 0.f};
#pragma unroll 2
        for (int i = 0; i < 32; ++i) { const int k = kg + 32 * i; const f32x4 w = *(const f32x4*)(w_ada + (size_t)k * 6144 + j0);
            const LAS f32x4* sp = (const LAS f32x4*)(sc + k * 16);
#pragma unroll
            for (int q = 0; q < 4; ++q) { const f32x4 s4 = sp[q];
#pragma unroll
                for (int e = 0; e < 4; ++e) ac[q * 4 + e] += w * s4[e]; } }
#pragma unroll
        for (int b = 0; b < 16; ++b)
#pragma unroll
            for (int e = 0; e < 4; ++e) { float v = ac[b][e]; v += __shfl_xor(v, 16); v += __shfl_xor(v, 32); ac[b][e] = v; }
        if (lane < 16) {
#pragma unroll
            for (int b = 0; b < 16; ++b) *(LAS f32x4*)(red + (wid * 16 + b) * 64 + cl * 4) = ac[b];
        }
        __syncthreads();
        for (int i = tid; i < 1024; i += 512) { const int b = i >> 6, cc = i & 63; float s = b_ada[item * 64 + cc];
#pragma unroll
            for (int w = 0; w < 8; ++w) s += red[(w * 16 + b) * 64 + cc];
            MOD[b * 6144 + item * 64 + cc] = s; }
        __syncthreads();
    }
}
__device__ __forceinline__ void ph_wcopy(LAS unsigned char* lds) {
    const int tid = ltid(), lane = tid & 63, wid = __builtin_amdgcn_readfirstlane(tid >> 6), G = lgrid(), bx = lbid();
    const int gw = bx * 8 + wid, NGW = G * 8;
    unsigned char* ws = WSB();
    LAS float* scr = (LAS float*)(lds + wid * 8448);
    constexpr int I0 = 16 * 280, I1 = 4 * 48, I2 = 4 * 32, I3 = 4 * 32, I4 = 16 * 32, I5 = 32 * 32, I6 = 16 * 32, I7 = 16 * 128, I8 = 64 * 32;
    constexpr int NIT = I0 + I1 + I2 + I3 + I4 + I5 + I6 + I7 + I8;
    for (int it = gw; it < NIT; it += NGW) {
        int r = it;
        if (r < I0) { transpose_item(INF(7), 1024, 8800, (bf16_t*)(ws + WS_WIN), 1, nullptr, 280, scr, r, lane); continue; } r -= I0;
        if (r < I1) { transpose_item(INF(10), 256, 1536, (bf16_t*)(ws + WS_WUQ), 2, INF(8), 48, scr, r, lane); continue; } r -= I1;
        if (r < I2) { transpose_item(INF(11), 256, 2048, (bf16_t*)(ws + WS_WUKN), 3, INF(9), 32, scr, r, lane); continue; } r -= I2;
        if (r < I3) { transpose_item(INF(11), 256, 2048, (bf16_t*)(ws + WS_WUV), 4, INF(9), 32, scr, r, lane); continue; } r -= I3;
        if (r < I4) { transpose_item(INF(12), 1024, 1024, (bf16_t*)(ws + WS_WOA), 0, nullptr, 32, scr, r, lane); continue; } r -= I4;
        if (r < I5) { transpose_item(INF(19), 2048, 1024, (bf16_t*)(ws + WS_WOB), 0, nullptr, 32, scr, r, lane); continue; } r -= I5;
        if (r < I6) { transpose_item(INF(20), 1024, 1024, (bf16_t*)(ws + WS_WOUT), 0, nullptr, 32, scr, r, lane); continue; } r -= I6;
        if (r < I7) { transpose_item(INF(23), 1024, 4096, (bf16_t*)(ws + WS_WFF1), 0, nullptr, 128, scr, r, lane); continue; } r -= I7;
        transpose_item(INF(24), 4096, 1024, (bf16_t*)(ws + WS_WFF2), 0, nullptr, 32, scr, r, lane);
    }
}
__device__ __forceinline__ void ph_rope_zero() {
    const int tid = ltid(), G = lgrid(), bx = lbid();
    unsigned char* ws = WSB(); float* ROPE = (float*)(ws + WS_ROPE); float* SSQ = (float*)(ws + WS_SSQ); const int* positions = (const int*)in_ptr(2);
    for (int idx = bx * 512 + tid; idx < TT * 32; idx += G * 512) {
        const int t = idx >> 5, i = idx & 31;
        const double ang = (double)positions[t] * ROPE_INV[i];
        const double n = __builtin_rint(ang * 0.15915494309189535);
        const double r = ang - n * 6.283185307179586476925, x2 = r * r;
        double ts = r, s = r, tc = 1.0, c = 1.0;
#pragma unroll
        for (int k = 1; k <= 13; ++k) { ts *= -x2 * (1.0 / (double)((2 * k) * (2 * k + 1))); s += ts; tc *= -x2 * (1.0 / (double)((2 * k - 1) * (2 * k))); c += tc; }
        *(f32x2*)(ROPE + (size_t)idx * 2) = (f32x2){(float)c, (float)s};
    }
    for (int idx = bx * 512 + tid; idx < 4 * TT; idx += G * 512) SSQ[idx] = 0.f;
}
__device__ __forceinline__ void ph_final_rows(int pb) {
    const int tid = ltid(), lane = tid & 63, wid = __builtin_amdgcn_readfirstlane(tid >> 6), G = lgrid(), bx = lbid();
    const int gw = bx * 8 + wid, NGW = G * 8;
    unsigned char* ws = WSB(); const float* SSQ_FF = (const float*)(ws + WS_SSQ) + 3 * TT; const float* MOD = (const float*)(ws + WS_MOD); const bf16_t* FF = (const bf16_t*)(ws + WS_FF);
    const float* g_post_mlp = INF(22); float* out = OUTP();
    for (int m = gw; m < TG; m += NGW) { const int t = pb + m, b = t >> 12;
        const float rs = rsqrtf(SSQ_FF[t] * (1.f / 1024.f) + EPS); const float* gate2 = MOD + b * 6144 + 5120;
#pragma unroll
        for (int j = 0; j < 4; ++j) { const int c0 = 4 * lane + 256 * j; const u32x2 w = *(const u32x2*)(FF + (size_t)m * 1024 + c0);
            f32x4 f = {bflo(w.x), bfhi(w.x), bflo(w.y), bfhi(w.y)}; const f32x4 g = *(const f32x4*)(g_post_mlp + c0), ga = *(const f32x4*)(gate2 + c0);
            f32x4* op = (f32x4*)(out + (size_t)t * 1024 + c0); *op = *op + ga * (f * rs * g); } }
}
__device__ __forceinline__ void ph_hrows(int tbase) {
    const int tid = ltid(), lane = tid & 63, wid = __builtin_amdgcn_readfirstlane(tid >> 6), G = lgrid(), bx = lbid();
    const int gw = bx * 8 + wid, NGW = G * 8;
    unsigned char* ws = WSB(); const float* MOD = (const float*)(ws + WS_MOD); bf16_t* H = (bf16_t*)(ws + WS_H);
    const float* x = INF(0); const float* g_pre_mix = INF(5);
    for (int m = gw; m < TG; m += NGW) { const int t = tbase + m, b = t >> 12;
        const f32x4* xr = (const f32x4*)(x + (size_t)t * 1024) + lane; f32x4 v[4]; float s = 0.f;
#pragma unroll
        for (int j = 0; j < 4; ++j) { v[j] = xr[64 * j]; s += dot4(v[j]); }
        const float rs = rsqrtf(wave_sum(s) * (1.f / 1024.f) + EPS); const float* shift = MOD + b * 6144; const float* scale = shift + 1024;
#pragma unroll
        for (int j = 0; j < 4; ++j) { const int c0 = 4 * lane + 256 * j; const f32x4 g = *(const f32x4*)(g_pre_mix + c0), sc = *(const f32x4*)(scale + c0), sh = *(const f32x4*)(shift + c0);
            const f32x4 hv = v[j] * rs * g * (sc + 1.f) + sh; u32x2 w; w.x = pk2(hv[0], hv[1]); w.y = pk2(hv[2], hv[3]); *(u32x2*)(H + (size_t)m * 1024 + c0) = w; } }
}
__device__ __forceinline__ void ph_proj(LAS unsigned char* lds, int tbase) {
    unsigned char* ws = WSB(); const int G = lgrid(), bx = lbid();
    pg8::Gemm g{(const bf16_t*)(ws + WS_H), (const bf16_t*)(ws + WS_WIN), TG, NPROJ, 1024}; pg8::StaticOrder S; S.init(TG, NPROJ, G, bx);
    float* SSQ = (float*)(ws + WS_SSQ);
    EpiProj E{(bf16_t*)(ws + WS_QL), (bf16_t*)(ws + WS_KVL), (bf16_t*)(ws + WS_KR), (bf16_t*)(ws + WS_Z), (bf16_t*)(ws + WS_XBC), (bf16_t*)(ws + WS_SGA), (bf16_t*)(ws + WS_SGB),
              (float*)(ws + WS_DT), SSQ, SSQ + TT, (const float*)(ws + WS_ROPE), INF(15), tbase};
    pg8::gemm_phase<EpiProj, pg8::StaticOrder, true, true>(lds, g, S, E);
}
__device__ __forceinline__ void ph_upq(LAS unsigned char* lds, int tbase) {
    unsigned char* ws = WSB(); const int G = lgrid(), bx = lbid();
    pg8::Gemm g{(const bf16_t*)(ws + WS_QL), (const bf16_t*)(ws + WS_WUQ), TG, 1536, 256}; pg8::StaticOrder S; S.init(TG, 1536, G, bx);
    EpiQ E{(bf16_t*)(ws + WS_QN), (bf16_t*)(ws + WS_QR), (const float*)(ws + WS_SSQ), (const float*)(ws + WS_ROPE), tbase, 0.07216878364870322f * 1.4426950408889634f};
    pg8::gemm_phase<EpiQ, pg8::StaticOrder, true, true>(lds, g, S, E);
}
__device__ __forceinline__ void ph_upk(LAS unsigned char* lds, int tbase) {
    unsigned char* ws = WSB(); const int G = lgrid(), bx = lbid();
    pg8::Gemm g{(const bf16_t*)(ws + WS_KVL), (const bf16_t*)(ws + WS_WUKN), TG, 1024, 256}; pg8::StaticOrder S; S.init(TG, 1024, G, bx);
    EpiRowScale E{(bf16_t*)(ws + WS_KN), 1024, (const float*)(ws + WS_SSQ) + TT, tbase};
    pg8::gemm_phase<EpiRowScale, pg8::StaticOrder, true, true>(lds, g, S, E);
}
__device__ __forceinline__ void ph_upv(LAS unsigned char* lds, int tbase) {
    unsigned char* ws = WSB(); const int G = lgrid(), bx = lbid();
    pg8::Gemm g{(const bf16_t*)(ws + WS_WUV), (const bf16_t*)(ws + WS_KVL), 1024, TG, 256}; pg8::StaticOrder S; S.init(1024, TG, G, bx);
    EpiColScale E{(bf16_t*)(ws + WS_VT), TG, (const float*)(ws + WS_SSQ) + TT, tbase};
    pg8::gemm_phase<EpiColScale, pg8::StaticOrder, true, true>(lds, g, S, E);
}
__device__ __forceinline__ void ph_conv(LAS unsigned char* lds) {
    const int tid = ltid(), lane = tid & 63, wid = __builtin_amdgcn_readfirstlane(tid >> 6), G = lgrid(), bx = lbid();
    const int gw = bx * 8 + wid, NGW = G * 8;
    unsigned char* ws = WSB(); const bf16_t* XBC = (const bf16_t*)(ws + WS_XBC);
    const float* conv_w = INF(13); const float* conv_b = INF(14);
    LAS unsigned char* tile = lds + wid * 16768;
    for (int item = gw; item < NB * 32 * 64; item += NGW) {
        const int slab = item & 63, c = (item >> 6) & 31, b = item >> 11;
        const int ch0 = slab * 64;
        {
            u32x4 v[16];
            const bf16_t* src = XBC + (unsigned)((b * SEQ + c * 128) * 4096 + ch0);
#pragma unroll
            for (int i = 0; i < 16; ++i) { const int p = i * 64 + lane; v[i] = *(const u32x4*)(src + (unsigned)((p >> 3) * 4096 + (p & 7) * 8)); }
            u32x4 hv = {0u, 0u, 0u, 0u};
            if (lane < 24 && c > 0) hv = *(const u32x4*)(XBC + (unsigned)((b * SEQ + c * 128 - 3 + (lane >> 3)) * 4096 + ch0 + (lane & 7) * 8));
#pragma unroll
            for (int i = 0; i < 16; ++i) { const int p = i * 64 + lane; *(LAS u32x4*)(tile + (3 + (p >> 3)) * 128 + (p & 7) * 16) = v[i]; }
            if (lane < 24) *(LAS u32x4*)(tile + (lane >> 3) * 128 + (lane & 7) * 16) = hv;
        }
        LDS_WAIT(); __builtin_amdgcn_wave_barrier();
        if (slab < 48) {
            bf16_t* dst;
            if (slab < 32) { const int bl = (b * 32 + c) * 8 + (slab >> 2); dst = (bf16_t*)(ws + WS_XT) + ((size_t)(bl * 4 + (slab & 3)) * 64) * 128; }
            else { const int bl = (b * 32 + c) * 8 + ((slab - 32) >> 1); dst = (bf16_t*)(ws + WS_BT) + ((size_t)bl * 128 + ((slab - 32) & 1) * 64) * 128; }
            const int ch = lane;
            const float w0 = conv_w[ch0 + ch], w1 = conv_w[4096 + ch0 + ch], w2 = conv_w[8192 + ch0 + ch], w3 = conv_w[12288 + ch0 + ch], bb = conv_b[ch0 + ch];
            const LAS unsigned char* tp = tile + ch * 2;
            float u0 = bf2f_lds(tp), u1 = bf2f_lds(tp + 128), u2 = bf2f_lds(tp + 256);
#pragma unroll 2
            for (int q = 0; q < 16; ++q) {
                float uu[11]; uu[0] = u0; uu[1] = u1; uu[2] = u2;
#pragma unroll
                for (int i = 0; i < 8; ++i) uu[3 + i] = bf2f_lds(tp + (q * 8 + 3 + i) * 128);
                float ov[8];
#pragma unroll
                for (int j = 0; j < 8; ++j) ov[j] = silu(bb + w0 * uu[j] + w1 * uu[j + 1] + w2 * uu[j + 2] + w3 * uu[j + 3]);
                u32x4 w; w.x = pk2(ov[0], ov[1]); w.y = pk2(ov[2], ov[3]); w.z = pk2(ov[4], ov[5]); w.w = pk2(ov[6], ov[7]);
                *(u32x4*)(dst + (unsigned)(ch * 128 + q * 8)) = w;
                u0 = uu[8]; u1 = uu[9]; u2 = uu[10];
            }
        }
        if (slab >= 32) {
            const int s2 = slab - (slab < 48 ? 32 : 48); const int bl = (b * 32 + c) * 8 + (s2 >> 1);
            bf16_t* dst = (bf16_t*)(ws + (slab < 48 ? WS_BC : WS_CC)) + (size_t)bl * 128 * 128 + (s2 & 1) * 64;
            const int cgp = lane & 7, lr = lane >> 3, chb = ch0 + cgp * 8;
            f32x4 wa[4], wb[4];
#pragma unroll
            for (int k = 0; k < 4; ++k) { wa[k] = *(const f32x4*)(conv_w + k * 4096 + chb); wb[k] = *(const f32x4*)(conv_w + k * 4096 + chb + 4); }
            const f32x4 b0 = *(const f32x4*)(conv_b + chb), b1 = *(const f32x4*)(conv_b + chb + 4);
#pragma unroll 2
            for (int q = 0; q < 16; ++q) { const int l = q * 8 + lr;
                f32x4 a0 = b0, a1 = b1;
#pragma unroll
                for (int k = 0; k < 4; ++k) { const u32x4 uw = *(const LAS u32x4*)(tile + (l + k) * 128 + cgp * 16);
                    const f32x4 x0 = {bflo(uw.x), bfhi(uw.x), bflo(uw.y), bfhi(uw.y)}, x1 = {bflo(uw.z), bfhi(uw.z), bflo(uw.w), bfhi(uw.w)};
                    a0 += wa[k] * x0; a1 += wb[k] * x1; }
#pragma unroll
                for (int e = 0; e < 4; ++e) { a0[e] = silu(a0[e]); a1[e] = silu(a1[e]); }
                st8(dst + (unsigned)(l * 128 + cgp * 8), a0, a1); }
        }
        LDS_WAIT(); __builtin_amdgcn_wave_barrier();
    }
    __syncthreads();
}
__device__ __forceinline__ void ph_states(LAS unsigned char* lds) {
    const int tid = ltid(), lane = tid & 63, wid = __builtin_amdgcn_readfirstlane(tid >> 6), G = lgrid(), bx = lbid();
    unsigned char* ws = WSB(); const float* DT = (const float*)(ws + WS_DT); float* DEC = (float*)(ws + WS_DEC); const float* a_log = INF(16);
    for (int item = bx; item < NB * 32 * 8; item += G) {
        const int bl = item, g = item & 7, c = (item >> 3) & 31, b = item >> 8;
        LAS unsigned char* XTs = lds; LAS unsigned char* BTs = lds + 256 * SP;
        LAS float* dts = (LAS float*)(lds + 384 * SP); LAS float* acs = dts + 512; LAS float* wsc = acs + 512;
        ld_tile(XTs, (const bf16_t*)(ws + WS_XT) + (size_t)bl * 4 * 8192, 256); ld_tile(BTs, (const bf16_t*)(ws + WS_BT) + (size_t)bl * 16384, 128);
        chunk_prep(dts, acs, DT, b * SEQ + c * 128, g, a_log);
        { const int hh = tid >> 7; wsc[tid] = dts[tid] * __expf(acs[hh * 128 + 127] - acs[tid]); }
        if (tid < 4) DEC[(b * 32 + c) * 32 + g * 4 + tid] = __expf(acs[tid * 128 + 127]);
        __syncthreads();
        const int r32 = lane & 31, hf = lane >> 5, pb = wid >> 2, nb = wid & 3;
#pragma unroll 1
        for (int hh = 0; hh < 4; ++hh) {
            f32x16 acc;
#pragma unroll
            for (int r = 0; r < 16; ++r) acc[r] = 0.f;
#pragma unroll 2
            for (int ks = 0; ks < 8; ++ks) {
                const u32x4 xa = *(const LAS u32x4*)(XTs + (hh * 64 + pb * 32 + r32) * SP + (ks * 16 + hf * 8) * 2);
                const LAS f32x4* wp = (const LAS f32x4*)(wsc + hh * 128 + ks * 16 + hf * 8); const f32x4 w0 = wp[0], w1 = wp[1];
                u32x4 xs; xs.x = pk2(bflo(xa.x) * w0[0], bfhi(xa.x) * w0[1]); xs.y = pk2(bflo(xa.y) * w0[2], bfhi(xa.y) * w0[3]);
                xs.z = pk2(bflo(xa.z) * w1[0], bfhi(xa.z) * w1[1]); xs.w = pk2(bflo(xa.w) * w1[2], bfhi(xa.w) * w1[3]);
                const bf16x8 bb = ldsfrag(BTs, nb * 32 + r32, ks * 16 + hf * 8);
                acc = __builtin_amdgcn_mfma_f32_32x32x16_bf16(__builtin_bit_cast(bf16x8, xs), bb, acc, 0, 0, 0);
            }
            float* sp = (float*)(ws + WS_ST) + ((size_t)bl * 4 + hh) * 8192 + nb * 32 + r32;
#pragma unroll
            for (int r = 0; r < 16; ++r) sp[(pb * 32 + (r & 3) + 8 * (r >> 2) + 4 * hf) * 128] = acc[r];
        }
        __syncthreads();
    }
}
__device__ __forceinline__ void ph_scan() {
    const int tid = ltid(), G = lgrid(), bx = lbid();
    unsigned char* ws = WSB(); const float* ST = (const float*)(ws + WS_ST); bf16_t* HP = (bf16_t*)(ws + WS_HP); const float* DEC = (const float*)(ws + WS_DEC);
    for (int e = bx * 512 + tid; e < NB * 32 * 2048; e += G * 512) {
        const int bgh = e >> 11, pn4 = e & 2047, b = bgh >> 5, gh = bgh & 31;
        f32x4 st = {0.f, 0.f, 0.f, 0.f};
#pragma unroll 4
        for (int c = 0; c < 32; ++c) { const size_t off = ((size_t)((b * 32 + c) * 32 + gh)) * 8192 + pn4 * 4;
            const f32x4 s = *(const f32x4*)(ST + off); u32x2 w; w.x = pk2(st[0], st[1]); w.y = pk2(st[2], st[3]); *(u32x2*)(HP + off) = w;
            st = st * DEC[(b * 32 + c) * 32 + gh] + s; }
    }
}
__device__ __forceinline__ void ph_attn(LAS unsigned char* lds) {
    const int G = lgrid(), bx = lbid();
    unsigned char* ws = WSB();
    const bf16_t* QN = (const bf16_t*)(ws + WS_QN); const bf16_t* QR = (const bf16_t*)(ws + WS_QR); const bf16_t* KN = (const bf16_t*)(ws + WS_KN);
    const bf16_t* KR = (const bf16_t*)(ws + WS_KR); const bf16_t* VT = (const bf16_t*)(ws + WS_VT); bf16_t* ATT = (bf16_t*)(ws + WS_ATT);
    for (int pi = bx; pi < NB * 64; pi += G) { const int b = pi >> 6, h = (pi >> 3) & 7, j = pi & 7;
#pragma unroll 1
        for (int k = 0; k < 2; ++k) attn_unit(lds, QN, QR, KN, KR, VT, ATT, b, h, k ? j : 15 - j); }
    __syncthreads();
}
__device__ __forceinline__ void ph_ssdc(LAS unsigned char* lds) {
    const int tid = ltid(), lane = tid & 63, wid = __builtin_amdgcn_readfirstlane(tid >> 6), G = lgrid(), bx = lbid();
    unsigned char* ws = WSB(); const float* DT = (const float*)(ws + WS_DT); const float* a_log = INF(16);
    LAS unsigned char* Cs = lds; LAS unsigned char* Bs = lds + 32768; LAS unsigned char* XTs = lds + 65536;
    LAS float* dts = (LAS float*)(lds + 131072); LAS float* acs = dts + 512; LAS float* rowp = acs + 512;
    const int r32 = lane & 31, hf = lane >> 5, h = wid >> 1, wl = wid & 1;
    for (int item = bx; item < NB * 32 * 8; item += G) {
        const int bl = item, g = item & 7, c = (item >> 3) & 31, b = item >> 8;
        const int trow0 = b * SEQ + c * 128;
        {
            int tid = ltid(); const int lane = tid & 63;
            const bf16_t* cc = (const bf16_t*)(ws + WS_CC) + (size_t)bl * 16384; const bf16_t* bc = (const bf16_t*)(ws + WS_BC) + (size_t)bl * 16384; const bf16_t* xt = (const bf16_t*)(ws + WS_XT) + (size_t)bl * 32768;
            {
                u32x4 v[8];
#pragma unroll
                for (int i = 0; i < 4; ++i) { v[i] = *(const u32x4*)(cc + (unsigned)((tid + 512 * i) * 8)); v[4 + i] = *(const u32x4*)(bc + (unsigned)((tid + 512 * i) * 8)); }
#pragma unroll
                for (int i = 0; i < 4; ++i) { const int p = tid + 512 * i, r = p >> 4, cp = (p & 15) ^ (r & 15);
                    *(LAS u32x4*)(Cs + r * 256 + cp * 16) = v[i]; *(LAS u32x4*)(Bs + r * 256 + cp * 16) = v[4 + i]; }
            }
            asm volatile("" ::: "memory");
            {
                u32x4 v[8];
#pragma unroll
                for (int i = 0; i < 8; ++i) v[i] = *(const u32x4*)(xt + (unsigned)((tid + 512 * i) * 8));
#pragma unroll
                for (int i = 0; i < 8; ++i) { const int p = tid + 512 * i, r = p >> 4, cp = (p & 15) ^ (r & 15); *(LAS u32x4*)(XTs + r * 256 + cp * 16) = v[i]; }
            }
            if (wid < 4) {
                const float A = -__expf(a_log[g * 4 + wid]);
                const float d0 = DT[(unsigned)((trow0 + 2 * lane) * 32 + g * 4 + wid)], d1 = DT[(unsigned)((trow0 + 2 * lane + 1) * 32 + g * 4 + wid)];
                const float x0 = d0 * A, x1 = x0 + d1 * A;
                float incl = x1;
#pragma unroll
                for (int o = 1; o < 64; o <<= 1) { const float t = __shfl_up(incl, o); if (lane >= o) incl += t; }
                const float excl = incl - x1;
                acs[wid * 128 + 2 * lane] = excl + x0; acs[wid * 128 + 2 * lane + 1] = excl + x1;
                dts[wid * 128 + 2 * lane] = d0; dts[wid * 128 + 2 * lane + 1] = d1;
            }
        }
        __syncthreads();
        f32x16 yacc[2][2];
#pragma unroll
        for (int li = 0; li < 2; ++li)
#pragma unroll
            for (int pb = 0; pb < 2; ++pb)
#pragma unroll
                for (int r = 0; r < 16; ++r) yacc[li][pb][r] = 0.f;
        const int sw = r32 & 15;
#pragma unroll
        for (int pb = 0; pb < 2; ++pb) {
            const bf16_t* hp = (const bf16_t*)(ws + WS_HP) + ((size_t)bl * 4 + h) * 8192 + (unsigned)((pb * 32 + r32) * 128 + hf * 8);
            bf16x8 hpf[8];
#pragma unroll
            for (int ks = 0; ks < 8; ++ks) hpf[ks] = *(const bf16x8*)(hp + ks * 16);
#pragma unroll
            for (int li = 0; li < 2; ++li) { const int lb = li == 0 ? (wl ? 1 : 0) : (wl ? 2 : 3);
                const LAS unsigned char* crow = Cs + (lb * 32 + r32) * 256;
#pragma unroll
                for (int ks = 0; ks < 8; ++ks) yacc[li][pb] = __builtin_amdgcn_mfma_f32_32x32x16_bf16(hpf[ks], *(const LAS bf16x8*)(crow + (((2 * ks + hf) ^ sw) * 16)), yacc[li][pb], 0, 0, 0);
            }
        }
        const float dsk = INF(17)[g * 4 + h];
#pragma unroll
        for (int li = 0; li < 2; ++li) {
            const int lb = li == 0 ? (wl ? 1 : 0) : (wl ? 2 : 3);
            const int l = lb * 32 + r32;
            const float al = acs[h * 128 + l];
            { const float ea = __expf(al);
#pragma unroll
              for (int pb = 0; pb < 2; ++pb)
#pragma unroll
                  for (int r = 0; r < 16; ++r) yacc[li][pb][r] *= ea; }
            const LAS unsigned char* crow = Cs + (lb * 32 + r32) * 256;
#pragma unroll 1
            for (int sb = 0; sb <= lb; ++sb) {
                f32x16 cbt;
#pragma unroll
                for (int r = 0; r < 16; ++r) cbt[r] = 0.f;
                const LAS unsigned char* brow = Bs + (sb * 32 + r32) * 256;
#pragma unroll
                for (int ks = 0; ks < 8; ++ks) cbt = __builtin_amdgcn_mfma_f32_32x32x16_bf16(*(const LAS bf16x8*)(brow + (((2 * ks + hf) ^ sw) * 16)), *(const LAS bf16x8*)(crow + (((2 * ks + hf) ^ sw) * 16)), cbt, 0, 0, 0);
                bf16x8 mt[2];
                { unsigned pk[8];
#pragma unroll
                  for (int rg = 0; rg < 4; ++rg) { const int s0 = sb * 32 + 8 * rg + 4 * hf;
                      const f32x4 as4 = *(const LAS f32x4*)(acs + h * 128 + s0), ds4 = *(const LAS f32x4*)(dts + h * 128 + s0);
                      float mv[4];
#pragma unroll
                      for (int e = 0; e < 4; ++e) { const int s = s0 + e; float val = cbt[4 * rg + e] * __expf(fminf(al - as4[e], 0.f)) * ds4[e];
                          if (s == l) val += dsk;
                          if (s > l) val = 0.f;
                          mv[e] = val; }
                      pk[2 * rg] = pk2(mv[0], mv[1]); pk[2 * rg + 1] = pk2(mv[2], mv[3]); }
                  u32x4 w0 = {pk[0], pk[1], pk[2], pk[3]}, w1 = {pk[4], pk[5], pk[6], pk[7]};
                  mt[0] = __builtin_bit_cast(bf16x8, w0); mt[1] = __builtin_bit_cast(bf16x8, w1); }
#pragma unroll
                for (int pb = 0; pb < 2; ++pb) { const LAS unsigned char* xrow = XTs + (h * 64 + pb * 32 + r32) * 256 + hf * 8;
#pragma unroll
                    for (int s2 = 0; s2 < 2; ++s2) { const int cpi = sb * 4 + s2 * 2;
                        const u32x2 lo = *(const LAS u32x2*)(xrow + ((cpi ^ sw) * 16)), hi = *(const LAS u32x2*)(xrow + (((cpi + 1) ^ sw) * 16));
                        u32x4 w = {lo.x, lo.y, hi.x, hi.y};
                        yacc[li][pb] = __builtin_amdgcn_mfma_f32_32x32x16_bf16(__builtin_bit_cast(bf16x8, w), mt[s2], yacc[li][pb], 0, 0, 0); } }
            }
        }
#pragma unroll
        for (int li = 0; li < 2; ++li) { const int lb = li == 0 ? (wl ? 1 : 0) : (wl ? 2 : 3); const int l = lb * 32 + r32;
            const bf16_t* zp = (const bf16_t*)(ws + WS_Z) + (unsigned)((trow0 + l) * 2048 + g * 256 + h * 64 + 4 * hf);
            float ssq = 0.f;
#pragma unroll
            for (int pb = 0; pb < 2; ++pb)
#pragma unroll
                for (int rg = 0; rg < 4; ++rg) { const u32x2 zw = *(const u32x2*)(zp + pb * 32 + 8 * rg); const float zz[4] = {bflo(zw.x), bfhi(zw.x), bflo(zw.y), bfhi(zw.y)};
#pragma unroll
                    for (int e = 0; e < 4; ++e) { const float v = yacc[li][pb][4 * rg + e] * silu(zz[e]); yacc[li][pb][4 * rg + e] = v; ssq += v * v; } }
            ssq += __shfl_xor(ssq, 32);
            if (hf == 0) rowp[h * 128 + l] = ssq; }
        __syncthreads();
#pragma unroll
        for (int li = 0; li < 2; ++li) { const int lb = li == 0 ? (wl ? 1 : 0) : (wl ? 2 : 3); const int l = lb * 32 + r32;
            const float rs = rsqrtf((rowp[l] + rowp[128 + l] + rowp[256 + l] + rowp[384 + l]) * (1.f / 256.f) + EPS);
            bf16_t* op = (bf16_t*)(ws + WS_SSM) + (unsigned)((trow0 + l) * 2048 + g * 256 + h * 64 + 4 * hf); const float* gp = INF(18) + g * 256 + h * 64 + 4 * hf;
#pragma unroll
            for (int pb = 0; pb < 2; ++pb)
#pragma unroll
                for (int rg = 0; rg < 4; ++rg) { const f32x4 gs = *(const f32x4*)(gp + pb * 32 + 8 * rg);
                    u32x2 w; w.x = pk2(yacc[li][pb][4 * rg] * rs * gs[0], yacc[li][pb][4 * rg + 1] * rs * gs[1]); w.y = pk2(yacc[li][pb][4 * rg + 2] * rs * gs[2], yacc[li][pb][4 * rg + 3] * rs * gs[3]);
                    *(u32x2*)(op + pb * 32 + 8 * rg) = w; } }
    }
    __syncthreads();
}
__device__ __forceinline__ void ph_merge_a(LAS unsigned char* lds) {
    unsigned char* ws = WSB(); const int G = lgrid(), bx = lbid();
    pg8::Gemm g{(const bf16_t*)(ws + WS_ATT), (const bf16_t*)(ws + WS_WOA), TG, 1024, 1024}; pg8::StaticOrder S; S.init(TG, 1024, G, bx);
    EpiGate<0> E{(bf16_t*)(ws + WS_MA), (const bf16_t*)(ws + WS_SGA), nullptr};
    pg8::gemm_phase<EpiGate<0>, pg8::StaticOrder, true, true>(lds, g, S, E);
    asm volatile("s_waitcnt vmcnt(0)" ::: "memory");
}
__device__ __forceinline__ void ph_merge_b(LAS unsigned char* lds) {
    unsigned char* ws = WSB(); const int G = lgrid(), bx = lbid();
    pg8::Gemm g{(const bf16_t*)(ws + WS_SSM), (const bf16_t*)(ws + WS_WOB), TG, 1024, 2048}; pg8::StaticOrder S; S.init(TG, 1024, G, bx);
    EpiGate<1> E{(bf16_t*)(ws + WS_MERGED), (const bf16_t*)(ws + WS_SGB), (const bf16_t*)(ws + WS_MA)};
    pg8::gemm_phase<EpiGate<1>, pg8::StaticOrder, true, true>(lds, g, S, E);
}
__device__ __forceinline__ void ph_mix(LAS unsigned char* lds, int tbase) {
    unsigned char* ws = WSB(); const int G = lgrid(), bx = lbid();
    pg8::Gemm g{(const bf16_t*)(ws + WS_MERGED), (const bf16_t*)(ws + WS_WOUT), TG, 1024, 1024}; pg8::StaticOrder S; S.init(TG, 1024, G, bx);
    EpiSsq E{(bf16_t*)(ws + WS_MIX), 1024, (float*)(ws + WS_SSQ) + 2 * TT, tbase};
    pg8::gemm_phase<EpiSsq, pg8::StaticOrder, true, true>(lds, g, S, E);
}
__device__ __forceinline__ void ph_x1rows(int tbase) {
    const int tid = ltid(), lane = tid & 63, wid = __builtin_amdgcn_readfirstlane(tid >> 6), G = lgrid(), bx = lbid();
    const int gw = bx * 8 + wid, NGW = G * 8;
    unsigned char* ws = WSB(); const float* SSQ_MIX = (const float*)(ws + WS_SSQ) + 2 * TT; const float* MOD = (const float*)(ws + WS_MOD);
    const bf16_t* MIX = (const bf16_t*)(ws + WS_MIX); bf16_t* H = (bf16_t*)(ws + WS_H);
    const float* x = INF(0); const float* g_post_mix = INF(6); const float* g_pre_mlp = INF(21); float* out = OUTP();
    for (int m = gw; m < TG; m += NGW) { const int t = tbase + m, b = t >> 12;
        const float rs1 = rsqrtf(SSQ_MIX[t] * (1.f / 1024.f) + EPS); const float* mod = MOD + b * 6144;
        f32x4 v[4]; float s = 0.f;
#pragma unroll
        for (int j = 0; j < 4; ++j) { const int c0 = 4 * lane + 256 * j; const u32x2 w = *(const u32x2*)(MIX + (size_t)m * 1024 + c0);
            const f32x4 f = {bflo(w.x), bfhi(w.x), bflo(w.y), bfhi(w.y)}; const f32x4 g = *(const f32x4*)(g_post_mix + c0), ga = *(const f32x4*)(mod + 2048 + c0);
            v[j] = *(const f32x4*)(x + (size_t)t * 1024 + c0) + ga * (f * rs1 * g); *(f32x4*)(out + (size_t)t * 1024 + c0) = v[j]; s += dot4(v[j]); }
        const float rs2 = rsqrtf(wave_sum(s) * (1.f / 1024.f) + EPS);
#pragma unroll
        for (int j = 0; j < 4; ++j) { const int c0 = 4 * lane + 256 * j; const f32x4 g = *(const f32x4*)(g_pre_mlp + c0), sc = *(const f32x4*)(mod + 4096 + c0), sh = *(const f32x4*)(mod + 3072 + c0);
            const f32x4 hv = v[j] * rs2 * g * (sc + 1.f) + sh; u32x2 w; w.x = pk2(hv[0], hv[1]); w.y = pk2(hv[2], hv[3]); *(u32x2*)(H + (size_t)m * 1024 + c0) = w; } }
}
__device__ __forceinline__ void ph_ff1(LAS unsigned char* lds) {
    unsigned char* ws = WSB(); const int G = lgrid(), bx = lbid();
    pg8::Gemm g{(const bf16_t*)(ws + WS_H), (const bf16_t*)(ws + WS_WFF1), TG, 4096, 1024}; pg8::StaticOrder S; S.init(TG, 4096, G, bx);
    EpiRelu2 E{(bf16_t*)(ws + WS_FF1), 4096};
    pg8::gemm_phase<EpiRelu2, pg8::StaticOrder, true, true>(lds, g, S, E);
}
__device__ __forceinline__ void ph_ff2(LAS unsigned char* lds, int tbase) {
    unsigned char* ws = WSB(); const int G = lgrid(), bx = lbid();
    pg8::Gemm g{(const bf16_t*)(ws + WS_FF1), (const bf16_t*)(ws + WS_WFF2), TG, 1024, 4096}; pg8::StaticOrder S; S.init(TG, 1024, G, bx);
    EpiSsq E{(bf16_t*)(ws + WS_FF), 1024, (float*)(ws + WS_SSQ) + 3 * TT, tbase};
    pg8::gemm_phase<EpiSsq, pg8::StaticOrder, true, true>(lds, g, S, E);
}

__global__ void __launch_bounds__(512, 2) mega(Args a) {
    extern __shared__ __attribute__((aligned(16))) unsigned char lds_raw[];
    LAS unsigned char* lds = (LAS unsigned char*)lds_raw;
    cg::grid_group grid = cg::this_grid();
    volatile LAS unsigned* bst = (volatile LAS unsigned*)(lds + LDS_BYTES - 64);
    if (threadIdx.x < 2) bst[threadIdx.x] = 0u;
    __syncthreads();
    XcdBarrier xbar = xcd_barrier_post((unsigned*)a.ws, bst);
#ifndef NO_MOD
    ph_mod(lds);
#endif
#ifndef NO_WCP
    ph_wcopy(lds);
#endif
    ph_rope_zero();
    if (DUP_P0) { ph_mod(lds); ph_wcopy(lds); ph_rope_zero(); }
    grid.sync();
#pragma unroll 1
    for (int rd = 0; rd < NROUND; ++rd) {
        const int tbase = rd * TG;
        if (rd > 0) ph_final_rows(tbase - TG);
        ph_hrows(tbase);
        if (DUP_ROWS) ph_hrows(tbase);
        GSYNC();
#ifndef NO_GB
        ph_proj(lds, tbase);
#endif
        GSYNC();
#ifndef NO_GC
        ph_upq(lds, tbase); ph_upk(lds, tbase); ph_upv(lds, tbase);
#endif
#ifndef NO_CONV
        ph_conv(lds);
        if (DUP_CONV) ph_conv(lds);
#endif
        GSYNC();
#ifndef NO_PD
        ph_states(lds);
        if (DUP_SS) ph_states(lds);
#endif
        GSYNC();
        ph_scan();
        if (DUP_SS) ph_scan();
        GSYNC();
#ifndef NO_ATT
        ph_attn(lds);
        if (DUP_ATT) ph_attn(lds);
#endif
#ifndef NO_SSDC
        ph_ssdc(lds);
        if (DUP_SSDC) ph_ssdc(lds);
#endif
        GSYNC();
#ifndef NO_GG
        ph_merge_a(lds); ph_merge_b(lds);
#endif
        GSYNC();
#ifndef NO_GH
        ph_mix(lds, tbase);
#endif
        GSYNC();
        ph_x1rows(tbase);
        if (DUP_ROWS) ph_x1rows(tbase);
        GSYNC();
#ifndef NO_GJ
        ph_ff1(lds);
#endif
        GSYNC();
#ifndef NO_GK
        ph_ff2(lds, tbase);
#endif
        GSYNC();
    }
    ph_final_rows(TT - TG);
}


extern "C" void kernel_launch(void* const* d_in, const int* in_sizes, int n_in, void* d_out, int out_size, void* d_ws, size_t ws_size, hipStream_t stream) {
    static int grid = 0;
    if (grid == 0) {
        if (n_in != 25 || out_size != TT * DM || ws_size < WS_END) { fprintf(stderr, "kernel_launch: unexpected problem (n_in %d out %d ws %zu)\n", n_in, out_size, ws_size); grid = -1; return; }
        int dev = 0, cus = 0, per_cu = 0;
        hipGetDevice(&dev); hipDeviceGetAttribute(&cus, hipDeviceAttributeMultiprocessorCount, dev);
        hipFuncSetAttribute((const void*)mega, hipFuncAttributeMaxDynamicSharedMemorySize, LDS_BYTES);
        hipOccupancyMaxActiveBlocksPerMultiprocessor(&per_cu, (const void*)mega, 512, LDS_BYTES);
        (void)hipGetLastError();
        if (per_cu < 1) per_cu = 1;
        grid = cus;
    }
    if (grid < 0) return;
    if (hipMemsetAsync(d_ws, 0, 65536, stream) != hipSuccess) { fprintf(stderr, "memset failed\n"); return; }
    Args a{};
    for (int i = 0; i < 25; ++i) a.in[i] = d_in[i];
    a.out = (float*)d_out; a.ws = (unsigned char*)d_ws;
    void* args[] = {&a};
    hipError_t e = hipLaunchCooperativeKernel((const void*)mega, dim3(grid), dim3(512), args, LDS_BYTES, stream);
    if (e != hipSuccess) fprintf(stderr, "cooperative launch failed: %s (grid %d)\n", hipGetErrorString(e), grid);
}
```

```cpp
#include <hip/hip_runtime.h>
#include <hip/hip_cooperative_groups.h>
#include <cstdio>
#include <cstdint>
namespace cg = cooperative_groups;
#ifndef DUP_ATT
#define DUP_ATT 0
#endif
#ifndef DUP_P0
#define DUP_P0 0
#endif
#ifndef DUP_SS
#define DUP_SS 0
#endif
#ifndef DUP_ROWS
#define DUP_ROWS 0
#endif
#ifndef DUP_SYNC
#define DUP_SYNC 0
#endif
#ifndef DUP_CONV
#define DUP_CONV 0
#endif
#ifndef DUP_SSDC
#define DUP_SSDC 0
#endif
#define GSYNC() do { xcd_barrier(xbar); if (DUP_SYNC) xcd_barrier(xbar); } while (0)

#define LAS __attribute__((address_space(3)))
typedef unsigned short bf16_t;
typedef short bf16x8 __attribute__((ext_vector_type(8)));
typedef float f32x4 __attribute__((ext_vector_type(4)));
typedef float f32x2 __attribute__((ext_vector_type(2)));
typedef float f32x16 __attribute__((ext_vector_type(16)));
typedef unsigned u32x4 __attribute__((ext_vector_type(4)));
typedef unsigned u32x2 __attribute__((ext_vector_type(2)));

__device__ __forceinline__ int ltid() { int t = threadIdx.x; asm volatile("" : "+v"(t)); return t; }
__device__ __forceinline__ int lbid() { int b = blockIdx.x; asm volatile("" : "+s"(b)); return b; }
__device__ __forceinline__ int lgrid() { int g = gridDim.x; asm volatile("" : "+s"(g)); return g; }

namespace pg8 {
#define PG8_LAS __attribute__((address_space(3)))
constexpr int BM = 256, BK = 64, HALF = 128, HTB = HALF * BK * 2, STAGE_BYTES = 8 * HTB, NXCD = 8, WGM = 8;
__host__ __device__ __forceinline__ int lds_byte(int r, int c) { const int st = (r >> 4) * 2 + (c >> 5), rr = r & 15, cc = c & 31, ob = rr * 64 + cc * 2; return st * 1024 + (ob ^ (((ob >> 9) & 1) << 5)); }
__host__ __device__ __forceinline__ void stage_rc(int b, int& R, int& C) { const int st = b / 1024, sb = b % 1024, swz = sb ^ (((sb >> 9) & 1) << 5); R = (st >> 1) * 16 + swz / 64; C = (st & 1) * 32 + (swz % 64) / 2; }
__host__ __device__ __forceinline__ int perm32(int rho) { const int n = rho >> 4, i = rho & 15; return 8 * (i >> 2) + 4 * n + (i & 3); }
struct Unit { int pm, pn; };
struct Gemm { const bf16_t* A; const bf16_t* Bt; int M, N, K; };
struct StaticOrder {
    int nM, nN, nwg, G, c;
    __host__ __device__ void init(int M, int N, int G_, int c_) { nM = M / BM; nN = N / BM; nwg = nM * nN; G = G_; c = c_; }
    __host__ __device__ bool next(int i, Unit& u) const {
        const long L = (long)i * G + c; if (L >= nwg) return false;
        int wgid = (int)L; { const int q = nwg / NXCD, r = nwg % NXCD, xcd = wgid % NXCD, off = wgid / NXCD; wgid = (xcd < r ? xcd * (q + 1) : r * (q + 1) + (xcd - r) * q) + off; }
        const int nig = WGM * nN, gid = wgid / nig, fm = gid * WGM, gsz = (nM - fm) < WGM ? (nM - fm) : WGM;
        u.pm = fm + ((wgid % nig) % gsz); u.pn = (wgid % nig) / gsz; return true;
    }
    __device__ __forceinline__ void a_ready(const Unit&) const {}
    __device__ __forceinline__ void done(const Unit&) const {}
};
__device__ __forceinline__ unsigned cvt_pk_bf16(float lo, float hi) { unsigned r; asm volatile("v_cvt_pk_bf16_f32 %0, %1, %2" : "=v"(r) : "v"(lo), "v"(hi)); return r; }

template <class Epi, class Sched, bool ALIGN_EPI = false, bool SP2 = false>
__device__ __forceinline__ void gemm_phase(PG8_LAS unsigned char* lds, const Gemm g, const Sched& S, const Epi& E) {
    const int tid = ltid(), wid = __builtin_amdgcn_readfirstlane(tid >> 6), lane = tid & 63, wr = wid >> 2, wc = wid & 3, fr = lane & 15, fq = lane >> 4;
    const int K = g.K, nt = K / BK;
    unsigned voffA[2], voffB[2];
#pragma unroll
    for (int i = 0; i < 2; ++i) { int R, C; stage_rc(tid * 16 + i * 8192, R, C); const int Rb = Epi::PERM ? ((R & ~31) + perm32(R & 31)) : R;
        voffA[i] = (unsigned)(R * K + C) * 2u; voffB[i] = (unsigned)(Rb * K + C) * 2u; }
    const size_t kstep = (size_t)(BK * 2);
    const size_t hstep = (size_t)HALF * K * 2;
    const size_t tstep = 2 * hstep;
    const unsigned ldsw = (unsigned)wid * 1024u;
    const int aoff = lds_byte(wr * 64 + fr, fq * 8), boff = lds_byte(wc * 32 + fr, fq * 8);
#define PG8_SA(b, h) (((b) * 2 + (h)) * HTB)
#define PG8_SB(b, h) ((4 + (b) * 2 + (h)) * HTB)
#define PG8_STAGE(bufoff, gbase, voff) do { _Pragma("unroll") for (int _i = 0; _i < 2; ++_i) \
        __builtin_amdgcn_global_load_lds((const unsigned*)((const char*)(gbase) + (voff)[_i]), (PG8_LAS unsigned*)(lds + (bufoff) + ldsw + _i * 8192), 16, 0, 0); } while (0)
#define PG8_LDA(dst, b, h) do { _Pragma("unroll") for (int m = 0; m < 4; ++m) _Pragma("unroll") for (int k = 0; k < 2; ++k) dst[m][k] = *(const PG8_LAS bf16x8*)(lds + PG8_SA(b, h) + aoff + m * 2048 + k * 1024); } while (0)
#define PG8_LDB(dst, b, h) do { _Pragma("unroll") for (int n = 0; n < 2; ++n) _Pragma("unroll") for (int k = 0; k < 2; ++k) dst[n][k] = *(const PG8_LAS bf16x8*)(lds + PG8_SB(b, h) + boff + n * 2048 + k * 1024); } while (0)
#define PG8_MMA(ai, bj, At, Bt) do { __builtin_amdgcn_s_setprio(1); _Pragma("unroll") for (int m = 0; m < 4; ++m) _Pragma("unroll") for (int n = 0; n < 2; ++n) _Pragma("unroll") for (int k = 0; k < 2; ++k) \
        acc[ai][bj][m][n] = __builtin_amdgcn_mfma_f32_16x16x32_bf16(Bt[n][k], At[m][k], acc[ai][bj][m][n], 0, 0, 0); __builtin_amdgcn_s_setprio(0); } while (0)
#define PG8_WAIT_V(n) asm volatile("s_waitcnt vmcnt(" #n ")" ::: "memory")
#define PG8_WAIT_L(n) asm volatile("s_waitcnt lgkmcnt(" #n ")" ::: "memory")
#define PG8_BAR __builtin_amdgcn_s_barrier()
#define PG8_SCHED __builtin_amdgcn_sched_barrier(0)
    Unit cur, nxt; int ui = 0;
    if (!S.next(0, cur)) return;
    f32x4 acc[2][2][4][2];
#pragma unroll
    for (int a = 0; a < 2; ++a)
#pragma unroll
        for (int b = 0; b < 2; ++b)
#pragma unroll
            for (int m = 0; m < 4; ++m)
#pragma unroll
                for (int n = 0; n < 2; ++n) acc[a][b][m][n] = (f32x4){0.f, 0.f, 0.f, 0.f};
    bf16x8 At[4][2], B0[2][2], B1[2][2];
    const char* cA = (const char*)g.A + (size_t)cur.pm * tstep; const char* cB = (const char*)g.Bt + (size_t)cur.pn * tstep;
    S.a_ready(cur);
    if constexpr (SP2) {
        PG8_STAGE(PG8_SB(0, 0), cB, voffB); PG8_STAGE(PG8_SB(0, 1), cB + hstep, voffB); PG8_STAGE(PG8_SA(0, 0), cA, voffA); PG8_STAGE(PG8_SA(0, 1), cA + hstep, voffA);
        if (wr == 1) PG8_BAR;
        PG8_WAIT_V(2); PG8_BAR;
        PG8_STAGE(PG8_SB(1, 0), cB + kstep, voffB); PG8_STAGE(PG8_SA(1, 0), cA + kstep, voffA); PG8_STAGE(PG8_SB(1, 1), cB + hstep + kstep, voffB);
        PG8_WAIT_V(6); PG8_BAR;
    } else {
        PG8_STAGE(PG8_SB(0, 0), cB, voffB); PG8_STAGE(PG8_SA(0, 0), cA, voffA); PG8_STAGE(PG8_SB(0, 1), cB + hstep, voffB); PG8_STAGE(PG8_SA(0, 1), cA + hstep, voffA);
        if (wr == 1) PG8_BAR;
        PG8_WAIT_V(4); PG8_BAR;
        PG8_STAGE(PG8_SB(1, 0), cB + kstep, voffB); PG8_STAGE(PG8_SA(1, 0), cA + kstep, voffA); PG8_STAGE(PG8_SB(1, 1), cB + hstep + kstep, voffB);
        PG8_WAIT_V(6); PG8_BAR;
    }
    for (;;) {
        const bool has_next = S.next(ui + 1, nxt);
        const char* nA = has_next ? (const char*)g.A + (size_t)nxt.pm * tstep : cA; const char* nB = has_next ? (const char*)g.Bt + (size_t)nxt.pn * tstep : cB;
#pragma unroll 1
        for (int t = 0; t < nt; t += 2) {
            const bool last = (t == nt - 2);
            const char* a1 = cA + (size_t)(t + 1) * kstep;
            const char* a2 = last ? nA : cA + (size_t)(t + 2) * kstep; const char* b2 = last ? nB : cB + (size_t)(t + 2) * kstep;
            const char* a3 = a2 + kstep; const char* b3 = b2 + kstep;
            if (last && has_next) S.a_ready(nxt);
            if constexpr (SP2) {
            PG8_LDB(B0, 0, 0); PG8_LDB(B1, 0, 1); PG8_SCHED; PG8_LDA(At, 0, 0); PG8_STAGE(PG8_SA(1, 1), a1 + hstep, voffA);
            PG8_WAIT_V(8); PG8_WAIT_L(0); PG8_BAR; PG8_MMA(0, 0, At, B0); PG8_MMA(0, 1, At, B1); PG8_BAR; PG8_SCHED;
            PG8_LDA(At, 0, 1); PG8_STAGE(PG8_SB(0, 0), b2, voffB); PG8_STAGE(PG8_SB(0, 1), b2 + hstep, voffB); PG8_STAGE(PG8_SA(0, 0), a2, voffA);
            PG8_WAIT_V(8); PG8_WAIT_L(0); PG8_BAR; PG8_MMA(1, 0, At, B0); PG8_MMA(1, 1, At, B1); PG8_BAR; PG8_SCHED;
            PG8_LDB(B0, 1, 0); PG8_LDB(B1, 1, 1); PG8_SCHED; PG8_LDA(At, 1, 0); PG8_STAGE(PG8_SA(0, 1), a2 + hstep, voffA);
            PG8_WAIT_V(8); PG8_WAIT_L(0); PG8_BAR; PG8_MMA(0, 0, At, B0); PG8_MMA(0, 1, At, B1); PG8_BAR; PG8_SCHED;
            PG8_LDA(At, 1, 1); PG8_STAGE(PG8_SB(1, 0), b3, voffB); PG8_STAGE(PG8_SB(1, 1), b3 + hstep, voffB); PG8_STAGE(PG8_SA(1, 0), a3, voffA);
            PG8_WAIT_V(8); PG8_WAIT_L(0); PG8_BAR; PG8_MMA(1, 0, At, B0); PG8_MMA(1, 1, At, B1); PG8_BAR; PG8_SCHED;
            } else {
            PG8_LDB(B0, 0, 0); PG8_SCHED; PG8_LDA(At, 0, 0); PG8_STAGE(PG8_SA(1, 1), a1 + hstep, voffA);
            PG8_WAIT_L(8); PG8_BAR; PG8_WAIT_L(0); PG8_MMA(0, 0, At, B0); PG8_BAR; PG8_SCHED;
            PG8_LDB(B1, 0, 1); PG8_STAGE(PG8_SB(0, 0), b2, voffB);
            PG8_BAR; PG8_WAIT_L(0); PG8_MMA(0, 1, At, B1); PG8_BAR;
            PG8_LDA(At, 0, 1); PG8_STAGE(PG8_SA(0, 0), a2, voffA);
            PG8_BAR; PG8_WAIT_L(0); PG8_MMA(1, 0, At, B0); PG8_BAR; PG8_SCHED;
            PG8_STAGE(PG8_SB(0, 1), b2 + hstep, voffB);
            PG8_WAIT_V(6); PG8_BAR; PG8_MMA(1, 1, At, B1); PG8_BAR;
            PG8_LDB(B0, 1, 0); PG8_SCHED; PG8_LDA(At, 1, 0); PG8_STAGE(PG8_SA(0, 1), a2 + hstep, voffA);
            PG8_WAIT_L(8); PG8_BAR; PG8_WAIT_L(0); PG8_MMA(0, 0, At, B0); PG8_BAR; PG8_SCHED;
            PG8_LDB(B1, 1, 1); PG8_STAGE(PG8_SB(1, 0), b3, voffB);
            PG8_BAR; PG8_WAIT_L(0); PG8_MMA(0, 1, At, B1); PG8_BAR;
            PG8_LDA(At, 1, 1); PG8_STAGE(PG8_SA(1, 0), a3, voffA);
            PG8_BAR; PG8_WAIT_L(0); PG8_MMA(1, 0, At, B0); PG8_BAR; PG8_SCHED;
            PG8_STAGE(PG8_SB(1, 1), b3 + hstep, voffB);
            PG8_WAIT_V(6); PG8_BAR; PG8_MMA(1, 1, At, B1); PG8_BAR;
            }
        }
        if constexpr (ALIGN_EPI) { if (wr == 0) PG8_BAR; }
        if constexpr (!Epi::AFTER_DRAIN) { PG8_SCHED; int fr_l = fr, fq_l = fq; asm volatile("" : "+v"(fr_l), "+v"(fq_l) :: "memory"); E(acc, cur, wr, wc, fr_l, fq_l); asm volatile("" ::: "memory"); PG8_SCHED; S.done(cur); }
        if (!has_next) break;
#pragma unroll
        for (int a = 0; a < 2; ++a)
#pragma unroll
            for (int b = 0; b < 2; ++b)
#pragma unroll
                for (int m = 0; m < 4; ++m)
#pragma unroll
                    for (int n = 0; n < 2; ++n) acc[a][b][m][n] = (f32x4){0.f, 0.f, 0.f, 0.f};
        cur = nxt; cA = nA; cB = nB; ++ui;
        if constexpr (ALIGN_EPI) { if (wr == 1) PG8_BAR; }
    }
    PG8_WAIT_V(0);
    if constexpr (!ALIGN_EPI) { if (wr == 0) PG8_BAR; }
    PG8_BAR;
#undef PG8_SA
#undef PG8_SB
#undef PG8_STAGE
#undef PG8_LDA
#undef PG8_LDB
#undef PG8_MMA
#undef PG8_WAIT_V
#undef PG8_WAIT_L
#undef PG8_BAR
#undef PG8_SCHED
}
}

constexpr int BATCH = 16, SEQ = 4096, DM = 1024, TT = BATCH * SEQ;
constexpr int NB = 4, TG = NB * SEQ, NROUND = BATCH / NB;
constexpr int NPROJ = 8960;
constexpr float EPS = 1e-6f;
constexpr int LDS_BYTES = 147456;
constexpr size_t MiB = 1u << 20;
constexpr size_t WS_MOD = 1 * MiB, WS_WIN = 2 * MiB, WS_WUQ = 20 * MiB, WS_WUKN = 21 * MiB, WS_WUV = 22 * MiB, WS_WOA = 23 * MiB, WS_WOB = 25 * MiB,
                 WS_WOUT = 29 * MiB, WS_WFF1 = 31 * MiB, WS_WFF2 = 39 * MiB, WS_ROPE = 48 * MiB, WS_DEC = 65 * MiB;
constexpr size_t WS_H = 66 * MiB, WS_QL = 98 * MiB, WS_KVL = 106 * MiB, WS_KR = 114 * MiB, WS_DT = 116 * MiB, WS_Z = 118 * MiB, WS_XBC = 182 * MiB,
                 WS_SGA = 310 * MiB, WS_SGB = 342 * MiB, WS_QN = 374 * MiB, WS_QR = 406 * MiB, WS_KN = 422 * MiB, WS_VT = 454 * MiB, WS_CC = 486 * MiB,
                 WS_BC = 518 * MiB, WS_BT = 550 * MiB, WS_XT = 582 * MiB, WS_ATT = 646 * MiB, WS_ST = 678 * MiB, WS_HP = 806 * MiB, WS_SSM = 870 * MiB,
                 WS_SSQ = 934 * MiB, WS_END = 944 * MiB;
constexpr int SQ_Q = 0, SQ_KV = 4 * TT, SQ_MIX = 8 * TT, SQ_FF = 24 * TT;
constexpr size_t WS_FF1 = WS_XBC, WS_MA = WS_QN, WS_MERGED = WS_KN, WS_MIX = WS_VT, WS_FF = WS_ATT;

__device__ const double ROPE_INV[32] = {1.0, 0.7498942093324559, 0.5623413251903491, 0.4216965034285822, 0.31622776601683794, 0.23713737056616552, 0.1778279410038923, 0.1333521432163324, 0.1, 0.07498942093324558, 0.05623413251903491, 0.042169650342858224, 0.03162277660168379, 0.023713737056616554, 0.01778279410038923, 0.01333521432163324, 0.01, 0.007498942093324558, 0.005623413251903491, 0.004216965034285823, 0.0031622776601683794, 0.0023713737056616554, 0.0017782794100389228, 0.001333521432163324, 0.001, 0.0007498942093324559, 0.0005623413251903491, 0.00042169650342858224, 0.00031622776601683794, 0.00023713737056616554, 0.00017782794100389227, 0.0001333521432163324};

typedef __bf16 bf16x2_t __attribute__((ext_vector_type(2)));
__device__ __forceinline__ unsigned pk2(float lo, float hi) { const f32x2 v = {lo, hi}; const bf16x2_t b = __builtin_convertvector(v, bf16x2_t); return __builtin_bit_cast(unsigned, b); }
__device__ __forceinline__ float bflo(unsigned w) { return __builtin_bit_cast(float, w << 16); }
__device__ __forceinline__ float bfhi(unsigned w) { return __builtin_bit_cast(float, w & 0xffff0000u); }
__device__ __forceinline__ float wave_sum(float v) {
#pragma unroll
    for (int o = 1; o < 64; o <<= 1) v += __shfl_xor(v, o);
    return v;
}
__device__ __forceinline__ void st8(bf16_t* p, f32x4 a, f32x4 b) { u32x4 w; w.x = pk2(a[0], a[1]); w.y = pk2(a[2], a[3]); w.z = pk2(b[0], b[1]); w.w = pk2(b[2], b[3]); *(u32x4*)p = w; }
__device__ __forceinline__ void ld8(const bf16_t* p, f32x4& a, f32x4& b) { const u32x4 w = *(const u32x4*)p; a[0] = bflo(w.x); a[1] = bfhi(w.x); a[2] = bflo(w.y); a[3] = bfhi(w.y); b[0] = bflo(w.z); b[1] = bfhi(w.z); b[2] = bflo(w.w); b[3] = bfhi(w.w); }
__device__ __forceinline__ float sigm(float x) { return __builtin_amdgcn_rcpf(1.f + __builtin_amdgcn_exp2f(-1.4426950408889634f * x)); }
__device__ __forceinline__ float silu(float x) { return x * __builtin_amdgcn_rcpf(1.f + __builtin_amdgcn_exp2f(-1.4426950408889634f * x)); }
__device__ __forceinline__ float softplus(float x) {
    const float e = __expf(-fabsf(x));
    const float l = e < 0.03125f ? e * (1.f - e * (0.5f - e * (0.33333334f - 0.25f * e))) : __logf(1.f + e);
    return fmaxf(x, 0.f) + l;
}
__device__ __forceinline__ float bf2f_lds(const LAS unsigned char* p) { return __builtin_bit_cast(float, (unsigned)(*(const LAS unsigned short*)p) << 16); }
__device__ __forceinline__ float dot4(f32x4 a) { return (a[0] * a[0] + a[1] * a[1]) + (a[2] * a[2] + a[3] * a[3]); }
#define LDS_WAIT() asm volatile("s_waitcnt lgkmcnt(0)" ::: "memory")

__device__ __forceinline__ int srcmap(int map, int r) {
    if (map == 0) return r;
    if (map == 1) {
        if (r < 512) return r;
        if (r < 6656) return r + 64;
        if (r < 8704) return r + 96;
        if (r < 8768) { const int j = r - 8704, g8 = j >> 3, e = j & 7; return 512 + (e < 4 ? 4 * g8 + e : 32 + 4 * g8 + (e - 4)); }
        if (r < 8800) return 6720 + (r - 8768);
        return -1;
    }
    if (map == 2) {
        if (r < 1024) return (r >> 7) * 192 + (r & 127);
        const int rr = r - 1024, h = rr >> 6, j = rr & 63, g8 = j >> 3, e = j & 7;
        return h * 192 + 128 + (e < 4 ? 4 * g8 + e : 32 + 4 * g8 + (e - 4));
    }
    if (map == 3) return (r >> 7) * 256 + (r & 127);
    return (r >> 7) * 256 + 128 + (r & 127);
}
__device__ __forceinline__ void transpose_item(const float* W, int K, int N, bf16_t* WT, int map, const float* ks, int nblk, LAS float* scr, int item, int lane) {
    const int kb = item / nblk, nb = item % nblk, k0 = 64 * kb, n0 = 32 * nb;
    const int src = srcmap(map, n0 + (lane & 31));
#pragma unroll 8
    for (int i = 0; i < 32; ++i) { const int kk = 2 * i + (lane >> 5); float v = src >= 0 ? W[(size_t)(k0 + kk) * N + src] : 0.f; if (ks) v *= ks[k0 + kk]; scr[kk * 33 + (lane & 31)] = v; }
    LDS_WAIT(); asm volatile("" ::: "memory");
    const int c = lane & 7;
#pragma unroll
    for (int j = 0; j < 4; ++j) { const int n = (lane >> 3) + 8 * j; const LAS float* s = scr + (8 * c) * 33 + n;
        u32x4 o; o.x = pk2(s[0 * 33], s[1 * 33]); o.y = pk2(s[2 * 33], s[3 * 33]); o.z = pk2(s[4 * 33], s[5 * 33]); o.w = pk2(s[6 * 33], s[7 * 33]);
        *(u32x4*)(WT + (size_t)(n0 + n) * K + k0 + 8 * c) = o; }
    LDS_WAIT(); asm volatile("" ::: "memory");
}

#define ACC_T const f32x4 (&acc)[2][2][4][2]
struct EpiProj {
    static constexpr bool PERM = true, AFTER_DRAIN = false;
    bf16_t *QL, *KVL, *KR, *Z, *XBC, *SGA, *SGB; float* DT; float *ssq_q, *ssq_kv; const float* rope; const float* dt_bias; int tbase;
    __device__ __forceinline__ void operator()(ACC_T, const pg8::Unit& u, int wr, int wc, int fr, int fq) const {
        const int pn = u.pn, row0 = u.pm * 256 + wr * 64 + fr, cw = wc * 32 + 8 * fq;
        if (pn < 2) {
            bf16_t* O = pn == 0 ? QL : KVL; float* sq = (pn == 0 ? ssq_q : ssq_kv) + wc * TT + tbase;
#pragma unroll
            for (int ai = 0; ai < 2; ++ai)
#pragma unroll
                for (int m = 0; m < 4; ++m) { const int row = row0 + ai * 128 + m * 16; float s = 0.f;
#pragma unroll
                    for (int bj = 0; bj < 2; ++bj) { const f32x4 v0 = acc[ai][bj][m][0], v1 = acc[ai][bj][m][1]; st8(O + (unsigned)row * 256u + cw + bj * 128, v0, v1); s += dot4(v0) + dot4(v1); }
                    s += __shfl_xor(s, 16); s += __shfl_xor(s, 32);
                    if (fq == 0) sq[row] = s; }
        } else if (pn < 26) {
            bf16_t* O; int ld, c0; if (pn < 10) { O = Z; ld = 2048; c0 = (pn - 2) * 256; } else { O = XBC; ld = 4096; c0 = (pn - 10) * 256; }
#pragma unroll
            for (int ai = 0; ai < 2; ++ai)
#pragma unroll
                for (int m = 0; m < 4; ++m) { const int row = row0 + ai * 128 + m * 16;
#pragma unroll
                    for (int bj = 0; bj < 2; ++bj) st8(O + (unsigned)row * (unsigned)ld + c0 + cw + bj * 128, acc[ai][bj][m][0], acc[ai][bj][m][1]); }
        } else if (pn < 34) {
            bf16_t* O = pn < 30 ? SGA : SGB; const int c0 = ((pn - 26) & 3) * 256;
#pragma unroll
            for (int ai = 0; ai < 2; ++ai)
#pragma unroll
                for (int m = 0; m < 4; ++m) { const int row = row0 + ai * 128 + m * 16;
#pragma unroll
                    for (int bj = 0; bj < 2; ++bj) { f32x4 v0 = acc[ai][bj][m][0], v1 = acc[ai][bj][m][1];
#pragma unroll
                        for (int e = 0; e < 4; ++e) { v0[e] = sigm(v0[e]); v1[e] = sigm(v1[e]); }
                        st8(O + (unsigned)row * 1024u + c0 + cw + bj * 128, v0, v1); }
                    asm volatile("" ::: "memory"); }
        } else {
            if (wc < 2) {
                const int g8 = wc * 4 + fq;
#pragma unroll
                for (int ai = 0; ai < 2; ++ai)
#pragma unroll
                    for (int m = 0; m < 4; ++m) { const int row = row0 + ai * 128 + m * 16; const f32x4 v0 = acc[ai][0][m][0], v1 = acc[ai][0][m][1];
                        const f32x4* rp = (const f32x4*)(rope + (unsigned)((tbase + row) * 64 + 8 * g8)); const f32x4 c01 = rp[0], c23 = rp[1];
                        f32x4 o1, o2;
                        o1[0] = v0[0] * c01[0] - v1[0] * c01[1]; o2[0] = v0[0] * c01[1] + v1[0] * c01[0];
                        o1[1] = v0[1] * c01[2] - v1[1] * c01[3]; o2[1] = v0[1] * c01[3] + v1[1] * c01[2];
                        o1[2] = v0[2] * c23[0] - v1[2] * c23[1]; o2[2] = v0[2] * c23[1] + v1[2] * c23[0];
                        o1[3] = v0[3] * c23[2] - v1[3] * c23[3]; o2[3] = v0[3] * c23[3] + v1[3] * c23[2];
                        st8(KR + (unsigned)row * 64u + 8 * g8, o1, o2); asm volatile("" ::: "memory"); }
            } else if (wc == 2) {
                const int i0 = 8 * fq; const f32x4 b0 = *(const f32x4*)(dt_bias + i0), b1 = *(const f32x4*)(dt_bias + i0 + 4);
#pragma unroll
                for (int ai = 0; ai < 2; ++ai)
#pragma unroll
                    for (int m = 0; m < 4; ++m) { const int row = row0 + ai * 128 + m * 16; f32x4 v0 = acc[ai][0][m][0] + b0, v1 = acc[ai][0][m][1] + b1;
#pragma unroll
                        for (int e = 0; e < 4; ++e) { v0[e] = softplus(v0[e]); v1[e] = softplus(v1[e]); }
                        *(f32x4*)(DT + (unsigned)row * 32u + i0) = v0; *(f32x4*)(DT + (unsigned)row * 32u + i0 + 4) = v1; asm volatile("" ::: "memory"); }
            }
        }
    }
};
struct EpiQ {
    static constexpr bool PERM = true, AFTER_DRAIN = false;
    bf16_t *QN, *QR; const float* ssq; const float* rope; int tbase; float c2;
    __device__ __forceinline__ void operator()(ACC_T, const pg8::Unit& u, int wr, int wc, int fr, int fq) const {
        const int pn = u.pn, row0 = u.pm * 256 + wr * 64 + fr, cw = wc * 32 + 8 * fq;
#pragma unroll
        for (int ai = 0; ai < 2; ++ai)
#pragma unroll
            for (int m = 0; m < 4; ++m) { const int row = row0 + ai * 128 + m * 16; const float* sp = ssq + tbase + row; const float rs = rsqrtf(((sp[0] + sp[TT]) + (sp[2 * TT] + sp[3 * TT])) * (1.f / 256.f) + EPS) * c2;
#pragma unroll
                for (int bj = 0; bj < 2; ++bj) { const f32x4 v0 = acc[ai][bj][m][0] * rs, v1 = acc[ai][bj][m][1] * rs;
                    if (pn < 4) st8(QN + (unsigned)row * 1024u + pn * 256 + cw + bj * 128, v0, v1);
                    else { const int colr = (pn - 4) * 256 + cw + bj * 128, g8 = (colr & 63) >> 3;
                        const f32x4* rp = (const f32x4*)(rope + (unsigned)((tbase + row) * 64 + 8 * g8)); const f32x4 c01 = rp[0], c23 = rp[1];
                        f32x4 o1, o2;
                        o1[0] = v0[0] * c01[0] - v1[0] * c01[1]; o2[0] = v0[0] * c01[1] + v1[0] * c01[0];
                        o1[1] = v0[1] * c01[2] - v1[1] * c01[3]; o2[1] = v0[1] * c01[3] + v1[1] * c01[2];
                        o1[2] = v0[2] * c23[0] - v1[2] * c23[1]; o2[2] = v0[2] * c23[1] + v1[2] * c23[0];
                        o1[3] = v0[3] * c23[2] - v1[3] * c23[3]; o2[3] = v0[3] * c23[3] + v1[3] * c23[2];
                        st8(QR + (unsigned)row * 512u + colr, o1, o2); } }
                asm volatile("" ::: "memory"); }
    }
};
struct EpiRowScale {
    static constexpr bool PERM = true, AFTER_DRAIN = false;
    bf16_t* O; int ldc; const float* ssq; int tbase;
    __device__ __forceinline__ void operator()(ACC_T, const pg8::Unit& u, int wr, int wc, int fr, int fq) const {
        const int row0 = u.pm * 256 + wr * 64 + fr, col0 = u.pn * 256 + wc * 32 + 8 * fq;
#pragma unroll
        for (int ai = 0; ai < 2; ++ai)
#pragma unroll
            for (int m = 0; m < 4; ++m) { const int row = row0 + ai * 128 + m * 16; const float* sp = ssq + tbase + row; const float rs = rsqrtf(((sp[0] + sp[TT]) + (sp[2 * TT] + sp[3 * TT])) * (1.f / 256.f) + EPS);
#pragma unroll
                for (int bj = 0; bj < 2; ++bj) st8(O + (unsigned)row * (unsigned)ldc + col0 + bj * 128, acc[ai][bj][m][0] * rs, acc[ai][bj][m][1] * rs);
                asm volatile("" ::: "memory"); }
    }
};
struct EpiColScale {
    static constexpr bool PERM = true, AFTER_DRAIN = false;
    bf16_t* O; int ldc; const float* ssq; int tbase;
    __device__ __forceinline__ void operator()(ACC_T, const pg8::Unit& u, int wr, int wc, int fr, int fq) const {
        const int row0 = u.pm * 256 + wr * 64 + fr, col0 = u.pn * 256 + wc * 32 + 8 * fq;
#pragma unroll
        for (int bj = 0; bj < 2; ++bj) {
            const float* sp = ssq + tbase + col0 + bj * 128;
            f32x4 r0 = (*(const f32x4*)sp + *(const f32x4*)(sp + TT)) + (*(const f32x4*)(sp + 2 * TT) + *(const f32x4*)(sp + 3 * TT));
            f32x4 r1 = (*(const f32x4*)(sp + 4) + *(const f32x4*)(sp + TT + 4)) + (*(const f32x4*)(sp + 2 * TT + 4) + *(const f32x4*)(sp + 3 * TT + 4));
#pragma unroll
            for (int e = 0; e < 4; ++e) { r0[e] = rsqrtf(r0[e] * (1.f / 256.f) + EPS); r1[e] = rsqrtf(r1[e] * (1.f / 256.f) + EPS); }
#pragma unroll
            for (int ai = 0; ai < 2; ++ai)
#pragma unroll
                for (int m = 0; m < 4; ++m) { const int row = row0 + ai * 128 + m * 16; st8(O + (unsigned)row * (unsigned)ldc + col0 + bj * 128, acc[ai][bj][m][0] * r0, acc[ai][bj][m][1] * r1); }
            asm volatile("" ::: "memory");
        }
    }
};
template <int MODE> struct EpiGate {
    static constexpr bool PERM = true, AFTER_DRAIN = false;
    bf16_t* O; const bf16_t* G; const bf16_t* P;
    __device__ __forceinline__ void operator()(ACC_T, const pg8::Unit& u, int wr, int wc, int fr, int fq) const {
        const int row0 = u.pm * 256 + wr * 64 + fr, col0 = u.pn * 256 + wc * 32 + 8 * fq;
#pragma unroll
        for (int ai = 0; ai < 2; ++ai)
#pragma unroll
            for (int m = 0; m < 4; ++m) { const int row = row0 + ai * 128 + m * 16;
#pragma unroll
                for (int bj = 0; bj < 2; ++bj) { const unsigned off = (unsigned)row * 1024u + col0 + bj * 128; f32x4 g0, g1; ld8(G + off, g0, g1);
                    f32x4 v0 = acc[ai][bj][m][0] * g0, v1 = acc[ai][bj][m][1] * g1;
                    if (MODE == 1) { f32x4 p0, p1; ld8(P + off, p0, p1); v0 += p0; v1 += p1; }
                    st8(O + off, v0, v1); }
                asm volatile("" ::: "memory"); }
    }
};
struct EpiSsq {
    static constexpr bool PERM = true, AFTER_DRAIN = false;
    bf16_t* O; int ldc; float* ssq; int tbase;
    __device__ __forceinline__ void operator()(ACC_T, const pg8::Unit& u, int wr, int wc, int fr, int fq) const {
        const int row0 = u.pm * 256 + wr * 64 + fr, col0 = u.pn * 256 + wc * 32 + 8 * fq;
#pragma unroll
        for (int ai = 0; ai < 2; ++ai)
#pragma unroll
            for (int m = 0; m < 4; ++m) { const int row = row0 + ai * 128 + m * 16; float s = 0.f;
#pragma unroll
                for (int bj = 0; bj < 2; ++bj) { const f32x4 v0 = acc[ai][bj][m][0], v1 = acc[ai][bj][m][1]; st8(O + (unsigned)row * (unsigned)ldc + col0 + bj * 128, v0, v1); s += dot4(v0) + dot4(v1); }
                s += __shfl_xor(s, 16); s += __shfl_xor(s, 32);
                if (fq == 0) ssq[(u.pn * 4 + wc) * TT + tbase + row] = s; }
    }
};
struct EpiRelu2 {
    static constexpr bool PERM = true, AFTER_DRAIN = false;
    bf16_t* O; int ldc;
    __device__ __forceinline__ void operator()(ACC_T, const pg8::Unit& u, int wr, int wc, int fr, int fq) const {
        const int row0 = u.pm * 256 + wr * 64 + fr, col0 = u.pn * 256 + wc * 32 + 8 * fq;
#pragma unroll
        for (int ai = 0; ai < 2; ++ai)
#pragma unroll
            for (int m = 0; m < 4; ++m) { const int row = row0 + ai * 128 + m * 16;
#pragma unroll
                for (int bj = 0; bj < 2; ++bj) { f32x4 v0 = acc[ai][bj][m][0], v1 = acc[ai][bj][m][1];
#pragma unroll
                    for (int e = 0; e < 4; ++e) { const float a = fmaxf(v0[e], 0.f), b = fmaxf(v1[e], 0.f); v0[e] = a * a; v1[e] = b * b; }
                    st8(O + (unsigned)row * (unsigned)ldc + col0 + bj * 128, v0, v1); } }
    }
};

constexpr int ATT_KB = 24576, ATT_BUF = 40960;
__device__ __forceinline__ void attn_unit(LAS unsigned char* lds, const bf16_t* QN, const bf16_t* QR, const bf16_t* KN, const bf16_t* KR, const bf16_t* VT, bf16_t* ATT, int b, int h, int qb) {
    const int tid = ltid(), wid = __builtin_amdgcn_readfirstlane(tid >> 6), lane = tid & 63, r32 = lane & 31, hf = lane >> 5;
    const int tb = b * SEQ, q0w = qb * 256 + wid * 32;
    bf16x8 qf[12];
    { const unsigned t = (unsigned)(tb + q0w + r32);
#pragma unroll
      for (int ks = 0; ks < 8; ++ks) qf[ks] = *(const bf16x8*)(QN + t * 1024u + h * 128 + ks * 16 + hf * 8);
#pragma unroll
      for (int ks = 0; ks < 4; ++ks) qf[8 + ks] = *(const bf16x8*)(QR + t * 512u + h * 64 + ks * 16 + hf * 8); }
    f32x16 o[4];
#pragma unroll
    for (int i = 0; i < 4; ++i)
#pragma unroll
        for (int r = 0; r < 16; ++r) o[i][r] = 0.f;
    float m_i = -INFINITY, l_i = 0.f;
    const int nkt = 4 * (qb + 1);
    unsigned ksrc[3]; unsigned vsrc[2];
#pragma unroll
    for (int i = 0; i < 3; ++i) { const int pid = (wid + 8 * i) * 64 + lane, row = pid / 24, cp = pid % 24, c = (cp & ~7) | ((cp ^ row) & 7);
        ksrc[i] = c < 16 ? (unsigned)((tb + row) * 1024 + h * 128 + c * 8) : (0x80000000u | (unsigned)((tb + row) * 64 + (c - 16) * 8)); }
#pragma unroll
    for (int i = 0; i < 2; ++i) { const int pid = (wid + 8 * i) * 64 + lane, dv = pid >> 3, cp = pid & 7, c = cp ^ (dv & 7);
        vsrc[i] = (unsigned)((h * 128 + dv) * TG + tb + c * 8); }
#define ATT_DMA(kt, buf) do { \
    _Pragma("unroll") for (int i = 0; i < 3; ++i) { const bf16_t* src = (ksrc[i] & 0x80000000u) ? KR + ((ksrc[i] & 0x7fffffffu) + (unsigned)(kt) * 4096u) : KN + (ksrc[i] + (unsigned)(kt) * 65536u); \
        __builtin_amdgcn_global_load_lds((const unsigned*)src, (LAS unsigned*)(lds + (buf) * ATT_BUF + (wid + 8 * i) * 1024), 16, 0, 0); } \
    _Pragma("unroll") for (int i = 0; i < 2; ++i) \
        __builtin_amdgcn_global_load_lds((const unsigned*)(VT + (vsrc[i] + (unsigned)(kt) * 64u)), (LAS unsigned*)(lds + (buf) * ATT_BUF + ATT_KB + (wid + 8 * i) * 1024), 16, 0, 0); } while (0)
    __syncthreads();
    ATT_DMA(0, 0);
    const int tx = hf ^ (r32 & 7);
    for (int kt = 0; kt < nkt; ++kt) {
        asm volatile("s_waitcnt vmcnt(0)" ::: "memory");
        __syncthreads();
        if (kt + 1 < nkt) ATT_DMA(kt + 1, (kt + 1) & 1);
        const LAS unsigned char* kbuf = lds + (kt & 1) * ATT_BUF; const LAS unsigned char* vbuf = kbuf + ATT_KB;
        const int key0 = kt * 64;
        if (key0 <= q0w + 31) {
            f32x16 s[2];
#pragma unroll
            for (int kb = 0; kb < 2; ++kb) {
#pragma unroll
                for (int r = 0; r < 16; ++r) s[kb][r] = 0.f;
                const LAS unsigned char* krow = kbuf + (kb * 32 + r32) * 384;
#pragma unroll
                for (int ks = 0; ks < 12; ++ks) { const bf16x8 a = *(const LAS bf16x8*)(krow + (((2 * ks) & ~7) + (((2 * ks) & 7) ^ tx)) * 16);
                    s[kb] = __builtin_amdgcn_mfma_f32_32x32x16_bf16(a, qf[ks], s[kb], 0, 0, 0);
                    if ((ks & 3) == 3) __builtin_amdgcn_sched_barrier(0); }
            }
            if (key0 + 63 > q0w) {
                const int qi = q0w + r32;
#pragma unroll
                for (int kb = 0; kb < 2; ++kb)
#pragma unroll
                    for (int r = 0; r < 16; ++r) { const int key = key0 + kb * 32 + (r & 3) + 8 * (r >> 2) + 4 * hf; if (key > qi) s[kb][r] = -INFINITY; }
            }
            float mx = s[0][0];
#pragma unroll
            for (int kb = 0; kb < 2; ++kb)
#pragma unroll
                for (int r = 0; r < 16; ++r) mx = fmaxf(mx, s[kb][r]);
            mx = fmaxf(mx, __shfl_xor(mx, 32));
            const float m_new = fmaxf(m_i, mx), alpha = __builtin_amdgcn_exp2f(m_i - m_new);
            float ps = 0.f;
#pragma unroll
            for (int kb = 0; kb < 2; ++kb)
#pragma unroll
                for (int r = 0; r < 16; ++r) { const float p = __builtin_amdgcn_exp2f(s[kb][r] - m_new); s[kb][r] = p; ps += p; }
            l_i = l_i * alpha + ps; m_i = m_new;
#pragma unroll
            for (int i = 0; i < 4; ++i)
#pragma unroll
                for (int r = 0; r < 16; ++r) o[i][r] *= alpha;
            bf16x8 pb[2][2];
#pragma unroll
            for (int kb = 0; kb < 2; ++kb)
#pragma unroll
                for (int s2 = 0; s2 < 2; ++s2) { u32x4 w; w.x = pk2(s[kb][8 * s2 + 0], s[kb][8 * s2 + 1]); w.y = pk2(s[kb][8 * s2 + 2], s[kb][8 * s2 + 3]);
                    w.z = pk2(s[kb][8 * s2 + 4], s[kb][8 * s2 + 5]); w.w = pk2(s[kb][8 * s2 + 6], s[kb][8 * s2 + 7]); pb[kb][s2] = __builtin_bit_cast(bf16x8, w); }
            const int vx = r32 & 7;
#pragma unroll
            for (int dvb = 0; dvb < 4; ++dvb) {
                const LAS unsigned char* vrow = vbuf + (dvb * 32 + r32) * 128 + hf * 8;
#pragma unroll
                for (int kb = 0; kb < 2; ++kb)
#pragma unroll
                    for (int s2 = 0; s2 < 2; ++s2) { const int c = kb * 4 + s2 * 2;
                        const u32x2 lo = *(const LAS u32x2*)(vrow + ((c ^ vx) * 16)), hi = *(const LAS u32x2*)(vrow + (((c + 1) ^ vx) * 16)); u32x4 w; w.x = lo.x; w.y = lo.y; w.z = hi.x; w.w = hi.y;
                        o[dvb] = __builtin_amdgcn_mfma_f32_32x32x16_bf16(__builtin_bit_cast(bf16x8, w), pb[kb][s2], o[dvb], 0, 0, 0); }
                __builtin_amdgcn_sched_barrier(0);
            }
        }
    }
#undef ATT_DMA
    l_i += __shfl_xor(l_i, 32);
    const float inv = 1.f / l_i;
    bf16_t* orow = ATT + (unsigned)(tb + q0w + r32) * 1024u + h * 128;
#pragma unroll
    for (int dvb = 0; dvb < 4; ++dvb)
#pragma unroll
        for (int rg = 0; rg < 4; ++rg) { u32x2 w; w.x = pk2(o[dvb][4 * rg] * inv, o[dvb][4 * rg + 1] * inv); w.y = pk2(o[dvb][4 * rg + 2] * inv, o[dvb][4 * rg + 3] * inv);
            *(u32x2*)(orow + dvb * 32 + 8 * rg + 4 * hf) = w; }
}

constexpr int SP = 272;
__device__ __forceinline__ void ld_tile(LAS unsigned char* dst, const bf16_t* src, int rows) {
    for (int p = ltid(); p < rows * 16; p += 512) { const int r = p >> 4, c = p & 15; *(LAS u32x4*)(dst + r * SP + c * 16) = *(const u32x4*)(src + r * 128 + c * 8); }
}
__device__ __forceinline__ void chunk_prep(LAS float* dts, LAS float* acs, const float* DT, int trow0, int g, const float* a_log) {
    const int tid = ltid(), wid = tid >> 6, lane = tid & 63;
    if (wid < 4) {
        const float A = -__expf(a_log[g * 4 + wid]);
        const float d0 = DT[(size_t)(trow0 + 2 * lane) * 32 + g * 4 + wid], d1 = DT[(size_t)(trow0 + 2 * lane + 1) * 32 + g * 4 + wid];
        const float x0 = d0 * A, x1 = x0 + d1 * A;
        float incl = x1;
#pragma unroll
        for (int o = 1; o < 64; o <<= 1) { const float v = __shfl_up(incl, o); if (lane >= o) incl += v; }
        const float excl = incl - x1;
        acs[wid * 128 + 2 * lane] = excl + x0; acs[wid * 128 + 2 * lane + 1] = excl + x1;
        dts[wid * 128 + 2 * lane] = d0; dts[wid * 128 + 2 * lane + 1] = d1;
    }
    __syncthreads();
}
__device__ __forceinline__ bf16x8 ldsfrag(const LAS unsigned char* base, int row, int k0) { return *(const LAS bf16x8*)(base + row * SP + k0 * 2); }

#define XB_TMO      128
#define XB_XCNT(j)  (256  + 64 * (j))
#define XB_XSUB(j)  (1280 + 64 * (j))
#define XB_XGEN(j)  (2304 + 64 * (j))
#define XB_TOP      3328
#define XB_TOPGEN   3392
#define XCD_BAR_WORDS 3456
#define XB_SPIN_CAP (1u << 18)

__device__ __forceinline__ unsigned xb_ld(unsigned* p)              { return __hip_atomic_load(p, __ATOMIC_RELAXED, __HIP_MEMORY_SCOPE_AGENT); }
__device__ __forceinline__ unsigned xb_add(unsigned* p, unsigned v) { return __hip_atomic_fetch_add(p, v, __ATOMIC_RELAXED, __HIP_MEMORY_SCOPE_AGENT); }
__device__ __forceinline__ unsigned xb_xcc_id() { return (unsigned)__builtin_amdgcn_s_getreg((3 << 11) | 20) & 0xFu; }
#define XB_SPIN(cond, bar) do { unsigned _sp = 0; while (cond) { __builtin_amdgcn_s_sleep(1); \
    if ((++_sp & 255u) == 0u) { if (xb_ld(&(bar)[XB_TMO])) break; if (_sp > XB_SPIN_CAP) { atomicAdd(&(bar)[XB_TMO], 1u); break; } } } } while (0)

struct XcdBarrier {
    unsigned* bar; unsigned x;
    volatile LAS unsigned* st;
};

__device__ __forceinline__ XcdBarrier xcd_barrier_post(unsigned* bar, volatile LAS unsigned* st) {
    XcdBarrier b; b.bar = bar; b.x = xb_xcc_id(); b.st = st;
    if (threadIdx.x == 0) (void)xb_add(&bar[XB_XCNT(b.x)], 1u);
    return b;
}
__device__ __forceinline__ void xcd_barrier_complete(unsigned* bar, unsigned x, unsigned& nloc, unsigned& nx) {
    const unsigned G = gridDim.x * gridDim.y * gridDim.z;
    unsigned sum, cnt, mine, sp = 0u;
    for (;;) {
        sum = 0u; cnt = 0u; mine = 0u;
#pragma unroll
        for (unsigned j = 0; j < 16; ++j) { const unsigned c = xb_ld(&bar[XB_XCNT(j)]); sum += c; cnt += (c > 0u) ? 1u : 0u; mine = (j == x) ? c : mine; }
        if (sum == G) break;
        __builtin_amdgcn_s_sleep(1);
        if ((++sp & 255u) == 0u) { if (xb_ld(&bar[XB_TMO])) break; if (sp > XB_SPIN_CAP) { atomicAdd(&bar[XB_TMO], 1u); break; } }
    }
    nloc = mine > 0u ? mine : 1u; nx = cnt > 0u ? cnt : 1u;
}

__device__ __forceinline__ void xcd_barrier(const XcdBarrier& b) {
    asm volatile("s_waitcnt vmcnt(0)" ::: "memory");
    __syncthreads();
    if (threadIdx.x == 0) {
        unsigned* bar = b.bar;
        __builtin_amdgcn_s_waitcnt(0);
        unsigned nloc = b.st[0], nx = b.st[1];
        if (nloc == 0u) { xcd_barrier_complete(bar, b.x, nloc, nx); b.st[0] = nloc; b.st[1] = nx; }
        const unsigned old = xb_add(&bar[XB_XSUB(b.x)], 1u);
        const unsigned gen = old / nloc;
        if (old + 1u == (gen + 1u) * nloc) {
            __builtin_amdgcn_fence(__ATOMIC_RELEASE, "agent");
            asm volatile("s_waitcnt vmcnt(0)" ::: "memory");
            const unsigned og = xb_add(&bar[XB_TOP], 1u);
            const unsigned tg = og / nx;
            if (og + 1u == (tg + 1u) * nx) xb_add(&bar[XB_TOPGEN], 1u);
            else XB_SPIN(xb_ld(&bar[XB_TOPGEN]) == tg, bar);
            __builtin_amdgcn_fence(__ATOMIC_ACQUIRE, "agent");
            xb_add(&bar[XB_XGEN(b.x)], 1u);
            asm volatile("s_waitcnt vmcnt(0)" ::: "memory");
        } else {
            XB_SPIN(xb_ld(&bar[XB_XGEN(b.x)]) == gen, bar);
            __builtin_amdgcn_fence(__ATOMIC_ACQUIRE, "agent");
            asm volatile("s_waitcnt vmcnt(0)" ::: "memory");
        }
    }
    __syncthreads();
}

struct Args { const void* in[25]; float* out; unsigned char* ws; };
__device__ __forceinline__ const void* in_ptr(int i) {
    int off = i * 8; asm volatile("" : "+s"(off));
    const __attribute__((address_space(4))) char* kp = (const __attribute__((address_space(4))) char*)__builtin_amdgcn_kernarg_segment_ptr();
    return *(const void* const __attribute__((address_space(4)))*)(kp + off);
}
#define INF(i) ((const float*)in_ptr(i))
#define WSB() ((unsigned char*)in_ptr(26))
#define OUTP() ((float*)in_ptr(25))

__device__ __forceinline__ void ph_mod(LAS unsigned char* lds) {
    const int tid = ltid(), lane = tid & 63, wid = __builtin_amdgcn_readfirstlane(tid >> 6), G = lgrid(), bx = lbid();
    float* MOD = (float*)(WSB() + WS_MOD);
    const float* cvec = INF(1); const float* w_ada = INF(3); const float* b_ada = INF(4);
    for (int item = bx; item < 96; item += G) {
        LAS float* sc = (LAS float*)lds;
        LAS float* red = (LAS float*)(lds + 65536);
        for (int i = tid; i < 16384; i += 512) { const int b = i >> 10, k = i & 1023; sc[k * 16 + b] = silu(cvec[i]); }
        __syncthreads();
        const int kg = tid >> 4, cl = tid & 15, j0 = item * 64 + cl * 4;
        f32x4 ac[16];
#pragma unroll
        for (int b = 0; b < 16; ++b) ac[b] = (f32x4){0.f, 0.f, 0.f, 0.f};
#pragma unroll 2
        for (int i = 0; i < 32; ++i) { const int k = kg + 32 * i; const f32x4 w = *(const f32x4*)(w_ada + (size_t)k * 6144 + j0);
            const LAS f32x4* sp = (const LAS f32x4*)(sc + k * 16);
#pragma unroll
            for (int q = 0; q < 4; ++q) { const f32x4 s4 = sp[q];
#pragma unroll
                for (int e = 0; e < 4; ++e) ac[q * 4 + e] += w * s4[e]; } }
#pragma unroll
        for (int b = 0; b < 16; ++b)
#pragma unroll
            for (int e = 0; e < 4; ++e) { float v = ac[b][e]; v += __shfl_xor(v, 16); v += __shfl_xor(v, 32); ac[b][e] = v; }
        if (lane < 16) {
#pragma unroll
            for (int b = 0; b < 16; ++b) *(LAS f32x4*)(red + (wid * 16 + b) * 64 + cl * 4) = ac[b];
        }
        __syncthreads();
        for (int i = tid; i < 1024; i += 512) { const int b = i >> 6, cc = i & 63; float s = b_ada[item * 64 + cc];
#pragma unroll
            for (int w = 0; w < 8; ++w) s += red[(w * 16 + b) * 64 + cc];
            MOD[b * 6144 + item * 64 + cc] = s; }
        __syncthreads();
    }
}
__device__ __forceinline__ void ph_wcopy(LAS unsigned char* lds) {
    const int tid = ltid(), lane = tid & 63, wid = __builtin_amdgcn_readfirstlane(tid >> 6), G = lgrid(), bx = lbid();
    const int gw = bx * 8 + wid, NGW = G * 8;
    unsigned char* ws = WSB();
    LAS float* scr = (LAS float*)(lds + wid * 8448);
    constexpr int I0 = 16 * 280, I1 = 4 * 48, I2 = 4 * 32, I3 = 4 * 32, I4 = 16 * 32, I5 = 32 * 32, I6 = 16 * 32, I7 = 16 * 128, I8 = 64 * 32;
    constexpr int NIT = I0 + I1 + I2 + I3 + I4 + I5 + I6 + I7 + I8;
    for (int it = gw; it < NIT; it += NGW) {
        int r = it;
        if (r < I0) { transpose_item(INF(7), 1024, 8800, (bf16_t*)(ws + WS_WIN), 1, nullptr, 280, scr, r, lane); continue; } r -= I0;
        if (r < I1) { transpose_item(INF(10), 256, 1536, (bf16_t*)(ws + WS_WUQ), 2, INF(8), 48, scr, r, lane); continue; } r -= I1;
        if (r < I2) { transpose_item(INF(11), 256, 2048, (bf16_t*)(ws + WS_WUKN), 3, INF(9), 32, scr, r, lane); continue; } r -= I2;
        if (r < I3) { transpose_item(INF(11), 256, 2048, (bf16_t*)(ws + WS_WUV), 4, INF(9), 32, scr, r, lane); continue; } r -= I3;
        if (r < I4) { transpose_item(INF(12), 1024, 1024, (bf16_t*)(ws + WS_WOA), 0, nullptr, 32, scr, r, lane); continue; } r -= I4;
        if (r < I5) { transpose_item(INF(19), 2048, 1024, (bf16_t*)(ws + WS_WOB), 0, nullptr, 32, scr, r, lane); continue; } r -= I5;
        if (r < I6) { transpose_item(INF(20), 1024, 1024, (bf16_t*)(ws + WS_WOUT), 0, nullptr, 32, scr, r, lane); continue; } r -= I6;
        if (r < I7) { transpose_item(INF(23), 1024, 4096, (bf16_t*)(ws + WS_WFF1), 0, nullptr, 128, scr, r, lane); continue; } r -= I7;
        transpose_item(INF(24), 4096, 1024, (bf16_t*)(ws + WS_WFF2), 0, nullptr, 32, scr, r, lane);
    }
}
__device__ __forceinline__ void ph_rope_zero() {
    const int tid = ltid(), G = lgrid(), bx = lbid();
    unsigned char* ws = WSB(); float* ROPE = (float*)(ws + WS_ROPE); const int* positions = (const int*)in_ptr(2);
    for (int idx = bx * 512 + tid; idx < TT * 32; idx += G * 512) {
        const int t = idx >> 5, i = idx & 31;
        const double ang = (double)positions[t] * ROPE_INV[i];
        const double n = __builtin_rint(ang * 0.15915494309189535);
        const double r = ang - n * 6.283185307179586476925, x2 = r * r;
        double ts = r, s = r, tc = 1.0, c = 1.0;
#pragma unroll
        for (int k = 1; k <= 13; ++k) { ts *= -x2 * (1.0 / (double)((2 * k) * (2 * k + 1))); s += ts; tc *= -x2 * (1.0 / (double)((2 * k - 1) * (2 * k))); c += tc; }
        *(f32x2*)(ROPE + (size_t)idx * 2) = (f32x2){(float)c, (float)s};
    }
}
__device__ __forceinline__ void ph_final_rows(int pb) {
    const int tid = ltid(), lane = tid & 63, wid = __builtin_amdgcn_readfirstlane(tid >> 6), G = lgrid(), bx = lbid();
    const int gw = bx * 8 + wid, NGW = G * 8;
    unsigned char* ws = WSB(); const float* SSQ_FF = (const float*)(ws + WS_SSQ) + SQ_FF; const float* MOD = (const float*)(ws + WS_MOD); const bf16_t* FF = (const bf16_t*)(ws + WS_FF);
    const float* g_post_mlp = INF(22); float* out = OUTP();
    for (int m = gw; m < TG; m += NGW) { const int t = pb + m, b = t >> 12;
        float sv = lane < 16 ? SSQ_FF[lane * TT + t] : 0.f; sv += __shfl_xor(sv, 1); sv += __shfl_xor(sv, 2); sv += __shfl_xor(sv, 4); sv += __shfl_xor(sv, 8); sv = __shfl(sv, 0);
        const float rs = rsqrtf(sv * (1.f / 1024.f) + EPS); const float* gate2 = MOD + b * 6144 + 5120;
#pragma unroll
        for (int j = 0; j < 4; ++j) { const int c0 = 4 * lane + 256 * j; const u32x2 w = *(const u32x2*)(FF + (size_t)m * 1024 + c0);
            f32x4 f = {bflo(w.x), bfhi(w.x), bflo(w.y), bfhi(w.y)}; const f32x4 g = *(const f32x4*)(g_post_mlp + c0), ga = *(const f32x4*)(gate2 + c0);
            f32x4* op = (f32x4*)(out + (size_t)t * 1024 + c0); *op = *op + ga * (f * rs * g); } }
}
__device__ __forceinline__ void ph_hrows(int tbase) {
    const int tid = ltid(), lane = tid & 63, wid = __builtin_amdgcn_readfirstlane(tid >> 6), G = lgrid(), bx = lbid();
    const int gw = bx * 8 + wid, NGW = G * 8;
    unsigned char* ws = WSB(); const float* MOD = (const float*)(ws + WS_MOD); bf16_t* H = (bf16_t*)(ws + WS_H);
    const float* x = INF(0); const float* g_pre_mix = INF(5);
    for (int m = gw; m < TG; m += NGW) { const int t = tbase + m, b = t >> 12;
        const f32x4* xr = (const f32x4*)(x + (size_t)t * 1024) + lane; f32x4 v[4]; float s = 0.f;
#pragma unroll
        for (int j = 0; j < 4; ++j) { v[j] = xr[64 * j]; s += dot4(v[j]); }
        const float rs = rsqrtf(wave_sum(s) * (1.f / 1024.f) + EPS); const float* shift = MOD + b * 6144; const float* scale = shift + 1024;
#pragma unroll
        for (int j = 0; j < 4; ++j) { const int c0 = 4 * lane + 256 * j; const f32x4 g = *(const f32x4*)(g_pre_mix + c0), sc = *(const f32x4*)(scale + c0), sh = *(const f32x4*)(shift + c0);
            const f32x4 hv = v[j] * rs * g * (sc + 1.f) + sh; u32x2 w; w.x = pk2(hv[0], hv[1]); w.y = pk2(hv[2], hv[3]); *(u32x2*)(H + (size_t)m * 1024 + c0) = w; } }
}
__device__ __forceinline__ void ph_proj(LAS unsigned char* lds, int tbase) {
    unsigned char* ws = WSB(); const int G = lgrid(), bx = lbid();
    pg8::Gemm g{(const bf16_t*)(ws + WS_H), (const bf16_t*)(ws + WS_WIN), TG, NPROJ, 1024}; pg8::StaticOrder S; S.init(TG, NPROJ, G, bx);
    float* SSQ = (float*)(ws + WS_SSQ);
    EpiProj E{(bf16_t*)(ws + WS_QL), (bf16_t*)(ws + WS_KVL), (bf16_t*)(ws + WS_KR), (bf16_t*)(ws + WS_Z), (bf16_t*)(ws + WS_XBC), (bf16_t*)(ws + WS_SGA), (bf16_t*)(ws + WS_SGB),
              (float*)(ws + WS_DT), SSQ + SQ_Q, SSQ + SQ_KV, (const float*)(ws + WS_ROPE), INF(15), tbase};
    pg8::gemm_phase<EpiProj, pg8::StaticOrder, true, true>(lds, g, S, E);
}
__device__ __forceinline__ void ph_upq(LAS unsigned char* lds, int tbase) {
    unsigned char* ws = WSB(); const int G = lgrid(), bx = lbid();
    pg8::Gemm g{(const bf16_t*)(ws + WS_QL), (const bf16_t*)(ws + WS_WUQ), TG, 1536, 256}; pg8::StaticOrder S; S.init(TG, 1536, G, bx);
    EpiQ E{(bf16_t*)(ws + WS_QN), (bf16_t*)(ws + WS_QR), (const float*)(ws + WS_SSQ) + SQ_Q, (const float*)(ws + WS_ROPE), tbase, 0.07216878364870322f * 1.4426950408889634f};
    pg8::gemm_phase<EpiQ, pg8::StaticOrder, true, true>(lds, g, S, E);
}
__device__ __forceinline__ void ph_upk(LAS unsigned char* lds, int tbase) {
    unsigned char* ws = WSB(); const int G = lgrid(), bx = lbid();
    pg8::Gemm g{(const bf16_t*)(ws + WS_KVL), (const bf16_t*)(ws + WS_WUKN), TG, 1024, 256}; pg8::StaticOrder S; S.init(TG, 1024, G, bx);
    EpiRowScale E{(bf16_t*)(ws + WS_KN), 1024, (const float*)(ws + WS_SSQ) + SQ_KV, tbase};
    pg8::gemm_phase<EpiRowScale, pg8::StaticOrder, true, true>(lds, g, S, E);
}
__device__ __forceinline__ void ph_upv(LAS unsigned char* lds, int tbase) {
    unsigned char* ws = WSB(); const int G = lgrid(), bx = lbid();
    pg8::Gemm g{(const bf16_t*)(ws + WS_WUV), (const bf16_t*)(ws + WS_KVL), 1024, TG, 256}; pg8::StaticOrder S; S.init(1024, TG, G, bx);
    EpiColScale E{(bf16_t*)(ws + WS_VT), TG, (const float*)(ws + WS_SSQ) + SQ_KV, tbase};
    pg8::gemm_phase<EpiColScale, pg8::StaticOrder, true, true>(lds, g, S, E);
}
__device__ __forceinline__ void ph_conv(LAS unsigned char* lds) {
    const int tid = ltid(), lane = tid & 63, wid = __builtin_amdgcn_readfirstlane(tid >> 6), G = lgrid(), bx = lbid();
    const int gw = bx * 8 + wid, NGW = G * 8;
    unsigned char* ws = WSB(); const bf16_t* XBC = (const bf16_t*)(ws + WS_XBC);
    const float* conv_w = INF(13); const float* conv_b = INF(14);
    LAS unsigned char* tile = lds + wid * 16768;
    for (int item = gw; item < NB * 32 * 64; item += NGW) {
        const int slab = item & 63, c = (item >> 6) & 31, b = item >> 11;
        const int ch0 = slab * 64;
        {
            u32x4 v[16];
            const bf16_t* src = XBC + (unsigned)((b * SEQ + c * 128) * 4096 + ch0);
#pragma unroll
            for (int i = 0; i < 16; ++i) { const int p = i * 64 + lane; v[i] = *(const u32x4*)(src + (unsigned)((p >> 3) * 4096 + (p & 7) * 8)); }
            u32x4 hv = {0u, 0u, 0u, 0u};
            if (lane < 24 && c > 0) hv = *(const u32x4*)(XBC + (unsigned)((b * SEQ + c * 128 - 3 + (lane >> 3)) * 4096 + ch0 + (lane & 7) * 8));
#pragma unroll
            for (int i = 0; i < 16; ++i) { const int p = i * 64 + lane; *(LAS u32x4*)(tile + (3 + (p >> 3)) * 128 + (p & 7) * 16) = v[i]; }
            if (lane < 24) *(LAS u32x4*)(tile + (lane >> 3) * 128 + (lane & 7) * 16) = hv;
        }
        LDS_WAIT(); __builtin_amdgcn_wave_barrier();
        if (slab < 48) {
            bf16_t* dst;
            if (slab < 32) { const int bl = (b * 32 + c) * 8 + (slab >> 2); dst = (bf16_t*)(ws + WS_XT) + ((size_t)(bl * 4 + (slab & 3)) * 64) * 128; }
            else { const int bl = (b * 32 + c) * 8 + ((slab - 32) >> 1); dst = (bf16_t*)(ws + WS_BT) + ((size_t)bl * 128 + ((slab - 32) & 1) * 64) * 128; }
            const int ch = lane;
            const float w0 = conv_w[ch0 + ch], w1 = conv_w[4096 + ch0 + ch], w2 = conv_w[8192 + ch0 + ch], w3 = conv_w[12288 + ch0 + ch], bb = conv_b[ch0 + ch];
            const LAS unsigned char* tp = tile + ch * 2;
            float u0 = bf2f_lds(tp), u1 = bf2f_lds(tp + 128), u2 = bf2f_lds(tp + 256);
#pragma unroll 2
            for (int q = 0; q < 16; ++q) {
                float uu[11]; uu[0] = u0; uu[1] = u1; uu[2] = u2;
#pragma unroll
                for (int i = 0; i < 8; ++i) uu[3 + i] = bf2f_lds(tp + (q * 8 + 3 + i) * 128);
                float ov[8];
#pragma unroll
                for (int j = 0; j < 8; ++j) ov[j] = silu(bb + w0 * uu[j] + w1 * uu[j + 1] + w2 * uu[j + 2] + w3 * uu[j + 3]);
                u32x4 w; w.x = pk2(ov[0], ov[1]); w.y = pk2(ov[2], ov[3]); w.z = pk2(ov[4], ov[5]); w.w = pk2(ov[6], ov[7]);
                *(u32x4*)(dst + (unsigned)(ch * 128 + q * 8)) = w;
                u0 = uu[8]; u1 = uu[9]; u2 = uu[10];
            }
        }
        if (slab >= 32) {
            const int s2 = slab - (slab < 48 ? 32 : 48); const int bl = (b * 32 + c) * 8 + (s2 >> 1);
            bf16_t* dst = (bf16_t*)(ws + (slab < 48 ? WS_BC : WS_CC)) + (size_t)bl * 128 * 128 + (s2 & 1) * 64;
            const int cgp = lane & 7, lr = lane >> 3, chb = ch0 + cgp * 8;
            f32x4 wa[4], wb[4];
#pragma unroll
            for (int k = 0; k < 4; ++k) { wa[k] = *(const f32x4*)(conv_w + k * 4096 + chb); wb[k] = *(const f32x4*)(conv_w + k * 4096 + chb + 4); }
            const f32x4 b0 = *(const f32x4*)(conv_b + chb), b1 = *(const f32x4*)(conv_b + chb + 4);
#pragma unroll 2
            for (int q = 0; q < 16; ++q) { const int l = q * 8 + lr;
                f32x4 a0 = b0, a1 = b1;
#pragma unroll
                for (int k = 0; k < 4; ++k) { const u32x4 uw = *(const LAS u32x4*)(tile + (l + k) * 128 + cgp * 16);
                    const f32x4 x0 = {bflo(uw.x), bfhi(uw.x), bflo(uw.y), bfhi(uw.y)}, x1 = {bflo(uw.z), bfhi(uw.z), bflo(uw.w), bfhi(uw.w)};
                    a0 += wa[k] * x0; a1 += wb[k] * x1; }
#pragma unroll
                for (int e = 0; e < 4; ++e) { a0[e] = silu(a0[e]); a1[e] = silu(a1[e]); }
                st8(dst + (unsigned)(l * 128 + cgp * 8), a0, a1); }
        }
        LDS_WAIT(); __builtin_amdgcn_wave_barrier();
    }
    __syncthreads();
}
__device__ __forceinline__ void ph_states(LAS unsigned char* lds) {
    const int tid = ltid(), lane = tid & 63, wid = __builtin_amdgcn_readfirstlane(tid >> 6), G = lgrid(), bx = lbid();
    unsigned char* ws = WSB(); const float* DT = (const float*)(ws + WS_DT); float* DEC = (float*)(ws + WS_DEC); const float* a_log = INF(16);
    for (int item = bx; item < NB * 32 * 8; item += G) {
        const int bl = item, g = item & 7, c = (item >> 3) & 31, b = item >> 8;
        LAS unsigned char* XTs = lds; LAS unsigned char* BTs = lds + 256 * SP;
        LAS float* dts = (LAS float*)(lds + 384 * SP); LAS float* acs = dts + 512; LAS float* wsc = acs + 512;
        ld_tile(XTs, (const bf16_t*)(ws + WS_XT) + (size_t)bl * 4 * 8192, 256); ld_tile(BTs, (const bf16_t*)(ws + WS_BT) + (size_t)bl * 16384, 128);
        chunk_prep(dts, acs, DT, b * SEQ + c * 128, g, a_log);
        { const int hh = tid >> 7; wsc[tid] = dts[tid] * __expf(acs[hh * 128 + 127] - acs[tid]); }
        if (tid < 4) DEC[(b * 32 + c) * 32 + g * 4 + tid] = __expf(acs[tid * 128 + 127]);
        __syncthreads();
        const int r32 = lane & 31, hf = lane >> 5, pb = wid >> 2, nb = wid & 3;
#pragma unroll 1
        for (int hh = 0; hh < 4; ++hh) {
            f32x16 acc;
#pragma unroll
            for (int r = 0; r < 16; ++r) acc[r] = 0.f;
#pragma unroll 2
            for (int ks = 0; ks < 8; ++ks) {
                const u32x4 xa = *(const LAS u32x4*)(XTs + (hh * 64 + pb * 32 + r32) * SP + (ks * 16 + hf * 8) * 2);
                const LAS f32x4* wp = (const LAS f32x4*)(wsc + hh * 128 + ks * 16 + hf * 8); const f32x4 w0 = wp[0], w1 = wp[1];
                u32x4 xs; xs.x = pk2(bflo(xa.x) * w0[0], bfhi(xa.x) * w0[1]); xs.y = pk2(bflo(xa.y) * w0[2], bfhi(xa.y) * w0[3]);
                xs.z = pk2(bflo(xa.z) * w1[0], bfhi(xa.z) * w1[1]); xs.w = pk2(bflo(xa.w) * w1[2], bfhi(xa.w) * w1[3]);
                const bf16x8 bb = ldsfrag(BTs, nb * 32 + r32, ks * 16 + hf * 8);
                acc = __builtin_amdgcn_mfma_f32_32x32x16_bf16(__builtin_bit_cast(bf16x8, xs), bb, acc, 0, 0, 0);
            }
            float* sp = (float*)(ws + WS_ST) + ((size_t)bl * 4 + hh) * 8192 + nb * 32 + r32;
#pragma unroll
            for (int r = 0; r < 16; ++r) sp[(pb * 32 + (r & 3) + 8 * (r >> 2) + 4 * hf) * 128] = acc[r];
        }
        __syncthreads();
    }
}
__device__ __forceinline__ void ph_scan() {
    const int tid = ltid(), G = lgrid(), bx = lbid();
    unsigned char* ws = WSB(); const float* ST = (const float*)(ws + WS_ST); bf16_t* HP = (bf16_t*)(ws + WS_HP); const float* DEC = (const float*)(ws + WS_DEC);
    for (int e = bx * 512 + tid; e < NB * 32 * 2048; e += G * 512) {
        const int bgh = e >> 11, pn4 = e & 2047, b = bgh >> 5, gh = bgh & 31;
        f32x4 st = {0.f, 0.f, 0.f, 0.f};
#pragma unroll 4
        for (int c = 0; c < 32; ++c) { const size_t off = ((size_t)((b * 32 + c) * 32 + gh)) * 8192 + pn4 * 4;
            const f32x4 s = *(const f32x4*)(ST + off); u32x2 w; w.x = pk2(st[0], st[1]); w.y = pk2(st[2], st[3]); *(u32x2*)(HP + off) = w;
            st = st * DEC[(b * 32 + c) * 32 + gh] + s; }
    }
}
__device__ __forceinline__ void ph_attn(LAS unsigned char* lds) {
    const int G = lgrid(), bx = lbid();
    unsigned char* ws = WSB();
    const bf16_t* QN = (const bf16_t*)(ws + WS_QN); const bf16_t* QR = (const bf16_t*)(ws + WS_QR); const bf16_t* KN = (const bf16_t*)(ws + WS_KN);
    const bf16_t* KR = (const bf16_t*)(ws + WS_KR); const bf16_t* VT = (const bf16_t*)(ws + WS_VT); bf16_t* ATT = (bf16_t*)(ws + WS_ATT);
    for (int pi = bx; pi < NB * 64; pi += G) { const int b = pi >> 6, h = (pi >> 3) & 7, j = pi & 7;
#pragma unroll 1
        for (int k = 0; k < 2; ++k) attn_unit(lds, QN, QR, KN, KR, VT, ATT, b, h, k ? j : 15 - j); }
    __syncthreads();
}
__device__ __forceinline__ void ph_ssdc(LAS unsigned char* lds) {
    const int tid = ltid(), lane = tid & 63, wid = __builtin_amdgcn_readfirstlane(tid >> 6), G = lgrid(), bx = lbid();
    unsigned char* ws = WSB(); const float* DT = (const float*)(ws + WS_DT); const float* a_log = INF(16);
    LAS unsigned char* Cs = lds; LAS unsigned char* Bs = lds + 32768; LAS unsigned char* XTs = lds + 65536;
    LAS float* dts = (LAS float*)(lds + 131072); LAS float* acs = dts + 512; LAS float* rowp = acs + 512;
    const int r32 = lane & 31, hf = lane >> 5, h = wid >> 1, wl = wid & 1;
    for (int item = bx; item < NB * 32 * 8; item += G) {
        const int bl = item, g = item & 7, c = (item >> 3) & 31, b = item >> 8;
        const int trow0 = b * SEQ + c * 128;
        bf16x8 hpf[2][8];
#pragma unroll
        for (int pb = 0; pb < 2; ++pb) { const bf16_t* hp = (const bf16_t*)(ws + WS_HP) + ((size_t)bl * 4 + h) * 8192 + (unsigned)((pb * 32 + r32) * 128 + hf * 8);
#pragma unroll
            for (int ks = 0; ks < 8; ++ks) hpf[pb][ks] = *(const bf16x8*)(hp + ks * 16); }
        {
            int tid = ltid(); const int lane = tid & 63;
            const bf16_t* cc = (const bf16_t*)(ws + WS_CC) + (size_t)bl * 16384; const bf16_t* bc = (const bf16_t*)(ws + WS_BC) + (size_t)bl * 16384; const bf16_t* xt = (const bf16_t*)(ws + WS_XT) + (size_t)bl * 32768;
            {
                u32x4 v[8];
#pragma unroll
                for (int i = 0; i < 4; ++i) { v[i] = *(const u32x4*)(cc + (unsigned)((tid + 512 * i) * 8)); v[4 + i] = *(const u32x4*)(bc + (unsigned)((tid + 512 * i) * 8)); }
#pragma unroll
                for (int i = 0; i < 4; ++i) { const int p = tid + 512 * i, r = p >> 4, cp = (p & 15) ^ (r & 15);
                    *(LAS u32x4*)(Cs + r * 256 + cp * 16) = v[i]; *(LAS u32x4*)(Bs + r * 256 + cp * 16) = v[4 + i]; }
            }
            asm volatile("" ::: "memory");
            {
                u32x4 v[8];
#pragma unroll
                for (int i = 0; i < 8; ++i) v[i] = *(const u32x4*)(xt + (unsigned)((tid + 512 * i) * 8));
#pragma unroll
                for (int i = 0; i < 8; ++i) { const int p = tid + 512 * i, r = p >> 4, cp = (p & 15) ^ (r & 15); *(LAS u32x4*)(XTs + r * 256 + cp * 16) = v[i]; }
            }
            if (wid < 4) {
                const float A = -__expf(a_log[g * 4 + wid]);
                const float d0 = DT[(unsigned)((trow0 + 2 * lane) * 32 + g * 4 + wid)], d1 = DT[(unsigned)((trow0 + 2 * lane + 1) * 32 + g * 4 + wid)];
                const float x0 = d0 * A, x1 = x0 + d1 * A;
                float incl = x1;
#pragma unroll
                for (int o = 1; o < 64; o <<= 1) { const float t = __shfl_up(incl, o); if (lane >= o) incl += t; }
                const float excl = incl - x1;
                acs[wid * 128 + 2 * lane] = excl + x0; acs[wid * 128 + 2 * lane + 1] = excl + x1;
                dts[wid * 128 + 2 * lane] = d0; dts[wid * 128 + 2 * lane + 1] = d1;
            }
        }
        __syncthreads();
        f32x16 yacc[2][2];
#pragma unroll
        for (int li = 0; li < 2; ++li)
#pragma unroll
            for (int pb = 0; pb < 2; ++pb)
#pragma unroll
                for (int r = 0; r < 16; ++r) yacc[li][pb][r] = 0.f;
        const int sw = r32 & 15;
#pragma unroll
        for (int pb = 0; pb < 2; ++pb) {
#pragma unroll
            for (int li = 0; li < 2; ++li) { const int lb = li == 0 ? (wl ? 1 : 0) : (wl ? 2 : 3);
                const LAS unsigned char* crow = Cs + (lb * 32 + r32) * 256;
#pragma unroll
                for (int ks = 0; ks < 8; ++ks) yacc[li][pb] = __builtin_amdgcn_mfma_f32_32x32x16_bf16(hpf[pb][ks], *(const LAS bf16x8*)(crow + (((2 * ks + hf) ^ sw) * 16)), yacc[li][pb], 0, 0, 0);
            }
        }
        const float dsk = INF(17)[g * 4 + h];
#pragma unroll
        for (int li = 0; li < 2; ++li) {
            const int lb = li == 0 ? (wl ? 1 : 0) : (wl ? 2 : 3);
            const int l = lb * 32 + r32;
            const float al = acs[h * 128 + l];
            { const float ea = __expf(al);
#pragma unroll
              for (int pb = 0; pb < 2; ++pb)
#pragma unroll
                  for (int r = 0; r < 16; ++r) yacc[li][pb][r] *= ea; }
            const LAS unsigned char* crow = Cs + (lb * 32 + r32) * 256;
#pragma unroll 1
            for (int sb = 0; sb <= lb; ++sb) {
                f32x16 cbt;
#pragma unroll
                for (int r = 0; r < 16; ++r) cbt[r] = 0.f;
                const LAS unsigned char* brow = Bs + (sb * 32 + r32) * 256;
#pragma unroll
                for (int ks = 0; ks < 8; ++ks) cbt = __builtin_amdgcn_mfma_f32_32x32x16_bf16(*(const LAS bf16x8*)(brow + (((2 * ks + hf) ^ sw) * 16)), *(const LAS bf16x8*)(crow + (((2 * ks + hf) ^ sw) * 16)), cbt, 0, 0, 0);
                bf16x8 mt[2];
                { unsigned pk[8];
#pragma unroll
                  for (int rg = 0; rg < 4; ++rg) { const int s0 = sb * 32 + 8 * rg + 4 * hf;
                      const f32x4 as4 = *(const LAS f32x4*)(acs + h * 128 + s0), ds4 = *(const LAS f32x4*)(dts + h * 128 + s0);
                      float mv[4];
#pragma unroll
                      for (int e = 0; e < 4; ++e) { const int s = s0 + e; float val = cbt[4 * rg + e] * __expf(fminf(al - as4[e], 0.f)) * ds4[e];
                          if (s == l) val += dsk;
                          if (s > l) val = 0.f;
                          mv[e] = val; }
                      pk[2 * rg] = pk2(mv[0], mv[1]); pk[2 * rg + 1] = pk2(mv[2], mv[3]); }
                  u32x4 w0 = {pk[0], pk[1], pk[2], pk[3]}, w1 = {pk[4], pk[5], pk[6], pk[7]};
                  mt[0] = __builtin_bit_cast(bf16x8, w0); mt[1] = __builtin_bit_cast(bf16x8, w1); }
#pragma unroll
                for (int pb = 0; pb < 2; ++pb) { const LAS unsigned char* xrow = XTs + (h * 64 + pb * 32 + r32) * 256 + hf * 8;
#pragma unroll
                    for (int s2 = 0; s2 < 2; ++s2) { const int cpi = sb * 4 + s2 * 2;
                        const u32x2 lo = *(const LAS u32x2*)(xrow + ((cpi ^ sw) * 16)), hi = *(const LAS u32x2*)(xrow + (((cpi + 1) ^ sw) * 16));
                        u32x4 w = {lo.x, lo.y, hi.x, hi.y};
                        yacc[li][pb] = __builtin_amdgcn_mfma_f32_32x32x16_bf16(__builtin_bit_cast(bf16x8, w), mt[s2], yacc[li][pb], 0, 0, 0); } }
            }
        }
#pragma unroll
        for (int li = 0; li < 2; ++li) { const int lb = li == 0 ? (wl ? 1 : 0) : (wl ? 2 : 3); const int l = lb * 32 + r32;
            const bf16_t* zp = (const bf16_t*)(ws + WS_Z) + (unsigned)((trow0 + l) * 2048 + g * 256 + h * 64 + 4 * hf);
            float ssq = 0.f;
#pragma unroll
            for (int pb = 0; pb < 2; ++pb)
#pragma unroll
                for (int rg = 0; rg < 4; ++rg) { const u32x2 zw = *(const u32x2*)(zp + pb * 32 + 8 * rg); const float zz[4] = {bflo(zw.x), bfhi(zw.x), bflo(zw.y), bfhi(zw.y)};
#pragma unroll
                    for (int e = 0; e < 4; ++e) { const float v = yacc[li][pb][4 * rg + e] * silu(zz[e]); yacc[li][pb][4 * rg + e] = v; ssq += v * v; } }
            ssq += __shfl_xor(ssq, 32);
            if (hf == 0) rowp[h * 128 + l] = ssq; }
        __syncthreads();
#pragma unroll
        for (int li = 0; li < 2; ++li) { const int lb = li == 0 ? (wl ? 1 : 0) : (wl ? 2 : 3); const int l = lb * 32 + r32;
            const float rs = rsqrtf((rowp[l] + rowp[128 + l] + rowp[256 + l] + rowp[384 + l]) * (1.f / 256.f) + EPS);
            bf16_t* op = (bf16_t*)(ws + WS_SSM) + (unsigned)((trow0 + l) * 2048 + g * 256 + h * 64 + 4 * hf); const float* gp = INF(18) + g * 256 + h * 64 + 4 * hf;
#pragma unroll
            for (int pb = 0; pb < 2; ++pb)
#pragma unroll
                for (int rg = 0; rg < 4; ++rg) { const f32x4 gs = *(const f32x4*)(gp + pb * 32 + 8 * rg);
                    u32x2 w; w.x = pk2(yacc[li][pb][4 * rg] * rs * gs[0], yacc[li][pb][4 * rg + 1] * rs * gs[1]); w.y = pk2(yacc[li][pb][4 * rg + 2] * rs * gs[2], yacc[li][pb][4 * rg + 3] * rs * gs[3]);
                    *(u32x2*)(op + pb * 32 + 8 * rg) = w; } }
    }
    __syncthreads();
}
__device__ __forceinline__ void ph_merge_a(LAS unsigned char* lds) {
    unsigned char* ws = WSB(); const int G = lgrid(), bx = lbid();
    pg8::Gemm g{(const bf16_t*)(ws + WS_ATT), (const bf16_t*)(ws + WS_WOA), TG, 1024, 1024}; pg8::StaticOrder S; S.init(TG, 1024, G, bx);
    EpiGate<0> E{(bf16_t*)(ws + WS_MA), (const bf16_t*)(ws + WS_SGA), nullptr};
    pg8::gemm_phase<EpiGate<0>, pg8::StaticOrder, true, true>(lds, g, S, E);
    asm volatile("s_waitcnt vmcnt(0)" ::: "memory");
}
__device__ __forceinline__ void ph_merge_b(LAS unsigned char* lds) {
    unsigned char* ws = WSB(); const int G = lgrid(), bx = lbid();
    pg8::Gemm g{(const bf16_t*)(ws + WS_SSM), (const bf16_t*)(ws + WS_WOB), TG, 1024, 2048}; pg8::StaticOrder S; S.init(TG, 1024, G, bx);
    EpiGate<1> E{(bf16_t*)(ws + WS_MERGED), (const bf16_t*)(ws + WS_SGB), (const bf16_t*)(ws + WS_MA)};
    pg8::gemm_phase<EpiGate<1>, pg8::StaticOrder, true, true>(lds, g, S, E);
}
__device__ __forceinline__ void ph_mix(LAS unsigned char* lds, int tbase) {
    unsigned char* ws = WSB(); const int G = lgrid(), bx = lbid();
    pg8::Gemm g{(const bf16_t*)(ws + WS_MERGED), (const bf16_t*)(ws + WS_WOUT), TG, 1024, 1024}; pg8::StaticOrder S; S.init(TG, 1024, G, bx);
    EpiSsq E{(bf16_t*)(ws + WS_MIX), 1024, (float*)(ws + WS_SSQ) + SQ_MIX, tbase};
    pg8::gemm_phase<EpiSsq, pg8::StaticOrder, true, true>(lds, g, S, E);
}
__device__ __forceinline__ void ph_x1rows(int tbase) {
    const int tid = ltid(), lane = tid & 63, wid = __builtin_amdgcn_readfirstlane(tid >> 6), G = lgrid(), bx = lbid();
    const int gw = bx * 8 + wid, NGW = G * 8;
    unsigned char* ws = WSB(); const float* SSQ_MIX = (const float*)(ws + WS_SSQ) + SQ_MIX; const float* MOD = (const float*)(ws + WS_MOD);
    const bf16_t* MIX = (const bf16_t*)(ws + WS_MIX); bf16_t* H = (bf16_t*)(ws + WS_H);
    const float* x = INF(0); const float* g_post_mix = INF(6); const float* g_pre_mlp = INF(21); float* out = OUTP();
    for (int m = gw; m < TG; m += NGW) { const int t = tbase + m, b = t >> 12;
        float sv = lane < 16 ? SSQ_MIX[lane * TT + t] : 0.f; sv += __shfl_xor(sv, 1); sv += __shfl_xor(sv, 2); sv += __shfl_xor(sv, 4); sv += __shfl_xor(sv, 8); sv = __shfl(sv, 0);
        const float rs1 = rsqrtf(sv * (1.f / 1024.f) + EPS); const float* mod = MOD + b * 6144;
        f32x4 v[4]; float s = 0.f;
#pragma unroll
        for (int j = 0; j < 4; ++j) { const int c0 = 4 * lane + 256 * j; const u32x2 w = *(const u32x2*)(MIX + (size_t)m * 1024 + c0);
            const f32x4 f = {bflo(w.x), bfhi(w.x), bflo(w.y), bfhi(w.y)}; const f32x4 g = *(const f32x4*)(g_post_mix + c0), ga = *(const f32x4*)(mod + 2048 + c0);
            v[j] = *(const f32x4*)(x + (size_t)t * 1024 + c0) + ga * (f * rs1 * g); *(f32x4*)(out + (size_t)t * 1024 + c0) = v[j]; s += dot4(v[j]); }
        const float rs2 = rsqrtf(wave_sum(s) * (1.f / 1024.f) + EPS);
#pragma unroll
        for (int j = 0; j < 4; ++j) { const int c0 = 4 * lane + 256 * j; const f32x4 g = *(const f32x4*)(g_pre_mlp + c0), sc = *(const f32x4*)(mod + 4096 + c0), sh = *(const f32x4*)(mod + 3072 + c0);
            const f32x4 hv = v[j] * rs2 * g * (sc + 1.f) + sh; u32x2 w; w.x = pk2(hv[0], hv[1]); w.y = pk2(hv[2], hv[3]); *(u32x2*)(H + (size_t)m * 1024 + c0) = w; } }
}
__device__ __forceinline__ void ph_ff1(LAS unsigned char* lds) {
    unsigned char* ws = WSB(); const int G = lgrid(), bx = lbid();
    pg8::Gemm g{(const bf16_t*)(ws + WS_H), (const bf16_t*)(ws + WS_WFF1), TG, 4096, 1024}; pg8::StaticOrder S; S.init(TG, 4096, G, bx);
    EpiRelu2 E{(bf16_t*)(ws + WS_FF1), 4096};
    pg8::gemm_phase<EpiRelu2, pg8::StaticOrder, true, true>(lds, g, S, E);
}
__device__ __forceinline__ void ph_ff2(LAS unsigned char* lds, int tbase) {
    unsigned char* ws = WSB(); const int G = lgrid(), bx = lbid();
    pg8::Gemm g{(const bf16_t*)(ws + WS_FF1), (const bf16_t*)(ws + WS_WFF2), TG, 1024, 4096}; pg8::StaticOrder S; S.init(TG, 1024, G, bx);
    EpiSsq E{(bf16_t*)(ws + WS_FF), 1024, (float*)(ws + WS_SSQ) + SQ_FF, tbase};
    pg8::gemm_phase<EpiSsq, pg8::StaticOrder, true, true>(lds, g, S, E);
}

__global__ void __launch_bounds__(512, 2) mega(Args a) {
    extern __shared__ __attribute__((aligned(16))) unsigned char lds_raw[];
    LAS unsigned char* lds = (LAS unsigned char*)lds_raw;
    cg::grid_group grid = cg::this_grid();
    volatile LAS unsigned* bst = (volatile LAS unsigned*)(lds + LDS_BYTES - 64);
    if (threadIdx.x < 2) bst[threadIdx.x] = 0u;
    __syncthreads();
    XcdBarrier xbar = xcd_barrier_post((unsigned*)a.ws, bst);
#ifndef NO_MOD
    ph_mod(lds);
#endif
#ifndef NO_WCP
    ph_wcopy(lds);
#endif
    ph_rope_zero();
    if (DUP_P0) { ph_mod(lds); ph_wcopy(lds); ph_rope_zero(); }
    grid.sync();
#pragma unroll 1
    for (int rd = 0; rd < NROUND; ++rd) {
        const int tbase = rd * TG;
        if (rd > 0) ph_final_rows(tbase - TG);
        ph_hrows(tbase);
        if (DUP_ROWS) ph_hrows(tbase);
        GSYNC();
#ifndef NO_GB
        ph_proj(lds, tbase);
#endif
        GSYNC();
#ifndef NO_GC
        ph_upq(lds, tbase); ph_upk(lds, tbase); ph_upv(lds, tbase);
#endif
#ifndef NO_CONV
        ph_conv(lds);
        if (DUP_CONV) ph_conv(lds);
#endif
        GSYNC();
#ifndef NO_PD
        ph_states(lds);
        if (DUP_SS) ph_states(lds);
#endif
        GSYNC();
        ph_scan();
        if (DUP_SS) ph_scan();
        GSYNC();
#ifndef NO_ATT
        ph_attn(lds);
        if (DUP_ATT) ph_attn(lds);
#endif
#ifndef NO_SSDC
        ph_ssdc(lds);
        if (DUP_SSDC) ph_ssdc(lds);
#endif
        GSYNC();
#ifndef NO_GG
        ph_merge_a(lds); ph_merge_b(lds);
#endif
        GSYNC();
#ifndef NO_GH
        ph_mix(lds, tbase);
#endif
        GSYNC();
        ph_x1rows(tbase);
        if (DUP_ROWS) ph_x1rows(tbase);
        GSYNC();
#ifndef NO_GJ
        ph_ff1(lds);
#endif
        GSYNC();
#ifndef NO_GK
        ph_ff2(lds, tbase);
#endif
        GSYNC();
    }
    ph_final_rows(TT - TG);
}


extern "C" void kernel_launch(void* const* d_in, const int* in_sizes, int n_in, void* d_out, int out_size, void* d_ws, size_t ws_size, hipStream_t stream) {
    static int grid = 0;
    if (grid == 0) {
        if (n_in != 25 || out_size != TT * DM || ws_size < WS_END) { fprintf(stderr, "kernel_launch: unexpected problem (n_in %d out %d ws %zu)\n", n_in, out_size, ws_size); grid = -1; return; }
        int dev = 0, cus = 0, per_cu = 0;
        hipGetDevice(&dev); hipDeviceGetAttribute(&cus, hipDeviceAttributeMultiprocessorCount, dev);
        hipFuncSetAttribute((const void*)mega, hipFuncAttributeMaxDynamicSharedMemorySize, LDS_BYTES);
        hipOccupancyMaxActiveBlocksPerMultiprocessor(&per_cu, (const void*)mega, 512, LDS_BYTES);
        (void)hipGetLastError();
        if (per_cu < 1) per_cu = 1;
        grid = cus;
    }
    if (grid < 0) return;
    if (hipMemsetAsync(d_ws, 0, 65536, stream) != hipSuccess) { fprintf(stderr, "memset failed\n"); return; }
    Args a{};
    for (int i = 0; i < 25; ++i) a.in[i] = d_in[i];
    a.out = (float*)d_out; a.ws = (unsigned char*)d_ws;
    void* args[] = {&a};
    hipError_t e = hipLaunchCooperativeKernel((const void*)mega, dim3(grid), dim3(512), args, LDS_BYTES, stream);
    if (e != hipSuccess) fprintf(stderr, "cooperative launch failed: %s (grid %d)\n", hipGetErrorString(e), grid);
}
```

```cpp
#include <hip/hip_runtime.h>
#include <hip/hip_cooperative_groups.h>
#include <cstdio>
#include <cstdint>
namespace cg = cooperative_groups;
#ifndef DUP_ATT
#define DUP_ATT 0
#endif
#ifndef DUP_P0
#define DUP_P0 0
#endif
#ifndef DUP_SS
#define DUP_SS 0
#endif
#ifndef DUP_ROWS
#define DUP_ROWS 0
#endif
#ifndef DUP_SYNC
#define DUP_SYNC 0
#endif
#ifndef DUP_CONV
#define DUP_CONV 0
#endif
#ifndef DUP_SSDC
#define DUP_SSDC 0
#endif
#define GSYNC() do { xcd_barrier(xbar); if (DUP_SYNC) xcd_barrier(xbar); } while (0)

#define LAS __attribute__((address_space(3)))
typedef unsigned short bf16_t;
typedef short bf16x8 __attribute__((ext_vector_type(8)));
typedef float f32x4 __attribute__((ext_vector_type(4)));
typedef float f32x2 __attribute__((ext_vector_type(2)));
typedef float f32x16 __attribute__((ext_vector_type(16)));
typedef unsigned u32x4 __attribute__((ext_vector_type(4)));
typedef unsigned u32x2 __attribute__((ext_vector_type(2)));

__device__ __forceinline__ int ltid() { int t = threadIdx.x; asm volatile("" : "+v"(t)); return t; }
__device__ __forceinline__ int lbid() { int b = blockIdx.x; asm volatile("" : "+s"(b)); return b; }
__device__ __forceinline__ int lgrid() { int g = gridDim.x; asm volatile("" : "+s"(g)); return g; }

namespace pg8 {
#define PG8_LAS __attribute__((address_space(3)))
constexpr int BM = 256, BK = 64, HALF = 128, HTB = HALF * BK * 2, STAGE_BYTES = 8 * HTB, NXCD = 8, WGM = 8;
__host__ __device__ __forceinline__ int lds_byte(int r, int c) { const int st = (r >> 4) * 2 + (c >> 5), rr = r & 15, cc = c & 31, ob = rr * 64 + cc * 2; return st * 1024 + (ob ^ (((ob >> 9) & 1) << 5)); }
__host__ __device__ __forceinline__ void stage_rc(int b, int& R, int& C) { const int st = b / 1024, sb = b % 1024, swz = sb ^ (((sb >> 9) & 1) << 5); R = (st >> 1) * 16 + swz / 64; C = (st & 1) * 32 + (swz % 64) / 2; }
__host__ __device__ __forceinline__ int perm32(int rho) { const int n = rho >> 4, i = rho & 15; return 8 * (i >> 2) + 4 * n + (i & 3); }
struct Unit { int pm, pn; };
struct Gemm { const bf16_t* A; const bf16_t* Bt; int M, N, K; };
struct StaticOrder {
    int nM, nN, nwg, G, c;
    __host__ __device__ void init(int M, int N, int G_, int c_) { nM = M / BM; nN = N / BM; nwg = nM * nN; G = G_; c = c_; }
    __host__ __device__ bool next(int i, Unit& u) const {
        const long L = (long)i * G + c; if (L >= nwg) return false;
        int wgid = (int)L; { const int q = nwg / NXCD, r = nwg % NXCD, xcd = wgid % NXCD, off = wgid / NXCD; wgid = (xcd < r ? xcd * (q + 1) : r * (q + 1) + (xcd - r) * q) + off; }
        const int nig = WGM * nN, gid = wgid / nig, fm = gid * WGM, gsz = (nM - fm) < WGM ? (nM - fm) : WGM;
        u.pm = fm + ((wgid % nig) % gsz); u.pn = (wgid % nig) / gsz; return true;
    }
    __device__ __forceinline__ void a_ready(const Unit&) const {}
    __device__ __forceinline__ void done(const Unit&) const {}
};
__device__ __forceinline__ unsigned cvt_pk_bf16(float lo, float hi) { unsigned r; asm volatile("v_cvt_pk_bf16_f32 %0, %1, %2" : "=v"(r) : "v"(lo), "v"(hi)); return r; }

template <class Epi, class Sched, bool ALIGN_EPI = false, bool SP2 = false>
__device__ __forceinline__ void gemm_phase(PG8_LAS unsigned char* lds, const Gemm g, const Sched& S, const Epi& E) {
    const int tid = ltid(), wid = __builtin_amdgcn_readfirstlane(tid >> 6), lane = tid & 63, wr = wid >> 2, wc = wid & 3, fr = lane & 15, fq = lane >> 4;
    const int K = g.K, nt = K / BK;
    unsigned voffA[2], voffB[2];
#pragma unroll
    for (int i = 0; i < 2; ++i) { int R, C; stage_rc(tid * 16 + i * 8192, R, C); const int Rb = Epi::PERM ? ((R & ~31) + perm32(R & 31)) : R;
        voffA[i] = (unsigned)(R * K + C) * 2u; voffB[i] = (unsigned)(Rb * K + C) * 2u; }
    const size_t kstep = (size_t)(BK * 2);
    const size_t hstep = (size_t)HALF * K * 2;
    const size_t tstep = 2 * hstep;
    const unsigned ldsw = (unsigned)wid * 1024u;
    const int aoff = lds_byte(wr * 64 + fr, fq * 8), boff = lds_byte(wc * 32 + fr, fq * 8);
#define PG8_SA(b, h) (((b) * 2 + (h)) * HTB)
#define PG8_SB(b, h) ((4 + (b) * 2 + (h)) * HTB)
#define PG8_STAGE(bufoff, gbase, voff) do { _Pragma("unroll") for (int _i = 0; _i < 2; ++_i) \
        __builtin_amdgcn_global_load_lds((const unsigned*)((const char*)(gbase) + (voff)[_i]), (PG8_LAS unsigned*)(lds + (bufoff) + ldsw + _i * 8192), 16, 0, 0); } while (0)
#define PG8_LDA(dst, b, h) do { _Pragma("unroll") for (int m = 0; m < 4; ++m) _Pragma("unroll") for (int k = 0; k < 2; ++k) dst[m][k] = *(const PG8_LAS bf16x8*)(lds + PG8_SA(b, h) + aoff + m * 2048 + k * 1024); } while (0)
#define PG8_LDB(dst, b, h) do { _Pragma("unroll") for (int n = 0; n < 2; ++n) _Pragma("unroll") for (int k = 0; k < 2; ++k) dst[n][k] = *(const PG8_LAS bf16x8*)(lds + PG8_SB(b, h) + boff + n * 2048 + k * 1024); } while (0)
#define PG8_MMA(ai, bj, At, Bt) do { __builtin_amdgcn_s_setprio(1); _Pragma("unroll") for (int m = 0; m < 4; ++m) _Pragma("unroll") for (int n = 0; n < 2; ++n) _Pragma("unroll") for (int k = 0; k < 2; ++k) \
        acc[ai][bj][m][n] = __builtin_amdgcn_mfma_f32_16x16x32_bf16(Bt[n][k], At[m][k], acc[ai][bj][m][n], 0, 0, 0); __builtin_amdgcn_s_setprio(0); } while (0)
#define PG8_WAIT_V(n) asm volatile("s_waitcnt vmcnt(" #n ")" ::: "memory")
#define PG8_WAIT_L(n) asm volatile("s_waitcnt lgkmcnt(" #n ")" ::: "memory")
#define PG8_BAR __builtin_amdgcn_s_barrier()
#define PG8_SCHED __builtin_amdgcn_sched_barrier(0)
    Unit cur, nxt; int ui = 0;
    if (!S.next(0, cur)) return;
    f32x4 acc[2][2][4][2];
#pragma unroll
    for (int a = 0; a < 2; ++a)
#pragma unroll
        for (int b = 0; b < 2; ++b)
#pragma unroll
            for (int m = 0; m < 4; ++m)
#pragma unroll
                for (int n = 0; n < 2; ++n) acc[a][b][m][n] = (f32x4){0.f, 0.f, 0.f, 0.f};
    bf16x8 At[4][2], B0[2][2], B1[2][2];
    const char* cA = (const char*)g.A + (size_t)cur.pm * tstep; const char* cB = (const char*)g.Bt + (size_t)cur.pn * tstep;
    S.a_ready(cur);
    if constexpr (SP2) {
        PG8_STAGE(PG8_SB(0, 0), cB, voffB); PG8_STAGE(PG8_SB(0, 1), cB + hstep, voffB); PG8_STAGE(PG8_SA(0, 0), cA, voffA); PG8_STAGE(PG8_SA(0, 1), cA + hstep, voffA);
        if (wr == 1) PG8_BAR;
        PG8_WAIT_V(2); PG8_BAR;
        PG8_STAGE(PG8_SB(1, 0), cB + kstep, voffB); PG8_STAGE(PG8_SA(1, 0), cA + kstep, voffA); PG8_STAGE(PG8_SB(1, 1), cB + hstep + kstep, voffB);
        PG8_WAIT_V(6); PG8_BAR;
    } else {
        PG8_STAGE(PG8_SB(0, 0), cB, voffB); PG8_STAGE(PG8_SA(0, 0), cA, voffA); PG8_STAGE(PG8_SB(0, 1), cB + hstep, voffB); PG8_STAGE(PG8_SA(0, 1), cA + hstep, voffA);
        if (wr == 1) PG8_BAR;
        PG8_WAIT_V(4); PG8_BAR;
        PG8_STAGE(PG8_SB(1, 0), cB + kstep, voffB); PG8_STAGE(PG8_SA(1, 0), cA + kstep, voffA); PG8_STAGE(PG8_SB(1, 1), cB + hstep + kstep, voffB);
        PG8_WAIT_V(6); PG8_BAR;
    }
    for (;;) {
        const bool has_next = S.next(ui + 1, nxt);
        const char* nA = has_next ? (const char*)g.A + (size_t)nxt.pm * tstep : cA; const char* nB = has_next ? (const char*)g.Bt + (size_t)nxt.pn * tstep : cB;
#pragma unroll 1
        for (int t = 0; t < nt; t += 2) {
            const bool last = (t == nt - 2);
            const char* a1 = cA + (size_t)(t + 1) * kstep;
            const char* a2 = last ? nA : cA + (size_t)(t + 2) * kstep; const char* b2 = last ? nB : cB + (size_t)(t + 2) * kstep;
            const char* a3 = a2 + kstep; const char* b3 = b2 + kstep;
            if (last && has_next) S.a_ready(nxt);
            if constexpr (SP2) {
            PG8_LDB(B0, 0, 0); PG8_LDB(B1, 0, 1); PG8_SCHED; PG8_LDA(At, 0, 0); PG8_STAGE(PG8_SA(1, 1), a1 + hstep, voffA);
            PG8_WAIT_V(8); PG8_WAIT_L(0); PG8_BAR; PG8_MMA(0, 0, At, B0); PG8_MMA(0, 1, At, B1); PG8_BAR; PG8_SCHED;
            PG8_LDA(At, 0, 1); PG8_STAGE(PG8_SB(0, 0), b2, voffB); PG8_STAGE(PG8_SB(0, 1), b2 + hstep, voffB); PG8_STAGE(PG8_SA(0, 0), a2, voffA);
            PG8_WAIT_V(8); PG8_WAIT_L(0); PG8_BAR; PG8_MMA(1, 0, At, B0); PG8_MMA(1, 1, At, B1); PG8_BAR; PG8_SCHED;
            PG8_LDB(B0, 1, 0); PG8_LDB(B1, 1, 1); PG8_SCHED; PG8_LDA(At, 1, 0); PG8_STAGE(PG8_SA(0, 1), a2 + hstep, voffA);
            PG8_WAIT_V(8); PG8_WAIT_L(0); PG8_BAR; PG8_MMA(0, 0, At, B0); PG8_MMA(0, 1, At, B1); PG8_BAR; PG8_SCHED;
            PG8_LDA(At, 1, 1); PG8_STAGE(PG8_SB(1, 0), b3, voffB); PG8_STAGE(PG8_SB(1, 1), b3 + hstep, voffB); PG8_STAGE(PG8_SA(1, 0), a3, voffA);
            PG8_WAIT_V(8); PG8_WAIT_L(0); PG8_BAR; PG8_MMA(1, 0, At, B0); PG8_MMA(1, 1, At, B1); PG8_BAR; PG8_SCHED;
            } else {
            PG8_LDB(B0, 0, 0); PG8_SCHED; PG8_LDA(At, 0, 0); PG8_STAGE(PG8_SA(1, 1), a1 + hstep, voffA);
            PG8_WAIT_L(8); PG8_BAR; PG8_WAIT_L(0); PG8_MMA(0, 0, At, B0); PG8_BAR; PG8_SCHED;
            PG8_LDB(B1, 0, 1); PG8_STAGE(PG8_SB(0, 0), b2, voffB);
            PG8_BAR; PG8_WAIT_L(0); PG8_MMA(0, 1, At, B1); PG8_BAR;
            PG8_LDA(At, 0, 1); PG8_STAGE(PG8_SA(0, 0), a2, voffA);
            PG8_BAR; PG8_WAIT_L(0); PG8_MMA(1, 0, At, B0); PG8_BAR; PG8_SCHED;
            PG8_STAGE(PG8_SB(0, 1), b2 + hstep, voffB);
            PG8_WAIT_V(6); PG8_BAR; PG8_MMA(1, 1, At, B1); PG8_BAR;
            PG8_LDB(B0, 1, 0); PG8_SCHED; PG8_LDA(At, 1, 0); PG8_STAGE(PG8_SA(0, 1), a2 + hstep, voffA);
            PG8_WAIT_L(8); PG8_BAR; PG8_WAIT_L(0); PG8_MMA(0, 0, At, B0); PG8_BAR; PG8_SCHED;
            PG8_LDB(B1, 1, 1); PG8_STAGE(PG8_SB(1, 0), b3, voffB);
            PG8_BAR; PG8_WAIT_L(0); PG8_MMA(0, 1, At, B1); PG8_BAR;
            PG8_LDA(At, 1, 1); PG8_STAGE(PG8_SA(1, 0), a3, voffA);
            PG8_BAR; PG8_WAIT_L(0); PG8_MMA(1, 0, At, B0); PG8_BAR; PG8_SCHED;
            PG8_STAGE(PG8_SB(1, 1), b3 + hstep, voffB);
            PG8_WAIT_V(6); PG8_BAR; PG8_MMA(1, 1, At, B1); PG8_BAR;
            }
        }
        if constexpr (ALIGN_EPI) { if (wr == 0) PG8_BAR; }
        if constexpr (!Epi::AFTER_DRAIN) { PG8_SCHED; int fr_l = fr, fq_l = fq; asm volatile("" : "+v"(fr_l), "+v"(fq_l) :: "memory"); E(acc, cur, wr, wc, fr_l, fq_l); asm volatile("" ::: "memory"); PG8_SCHED; S.done(cur); }
        if (!has_next) break;
#pragma unroll
        for (int a = 0; a < 2; ++a)
#pragma unroll
            for (int b = 0; b < 2; ++b)
#pragma unroll
                for (int m = 0; m < 4; ++m)
#pragma unroll
                    for (int n = 0; n < 2; ++n) acc[a][b][m][n] = (f32x4){0.f, 0.f, 0.f, 0.f};
        cur = nxt; cA = nA; cB = nB; ++ui;
        if constexpr (ALIGN_EPI) { if (wr == 1) PG8_BAR; }
    }
    PG8_WAIT_V(0);
    if constexpr (!ALIGN_EPI) { if (wr == 0) PG8_BAR; }
    PG8_BAR;
#undef PG8_SA
#undef PG8_SB
#undef PG8_STAGE
#undef PG8_LDA
#undef PG8_LDB
#undef PG8_MMA
#undef PG8_WAIT_V
#undef PG8_WAIT_L
#undef PG8_BAR
#undef PG8_SCHED
}
}

constexpr int BATCH = 16, SEQ = 4096, DM = 1024, TT = BATCH * SEQ;
constexpr int NB = 4, TG = NB * SEQ, NROUND = BATCH / NB;
constexpr int NPROJ = 8960;
constexpr float EPS = 1e-6f;
constexpr int LDS_BYTES = 147456;
constexpr size_t MiB = 1u << 20;
constexpr size_t WS_MOD = 1 * MiB, WS_WIN = 2 * MiB, WS_WUQ = 20 * MiB, WS_WUKN = 21 * MiB, WS_WUV = 22 * MiB, WS_WOA = 23 * MiB, WS_WOB = 25 * MiB,
                 WS_WOUT = 29 * MiB, WS_WFF1 = 31 * MiB, WS_WFF2 = 39 * MiB, WS_ROPE = 48 * MiB, WS_DEC = 65 * MiB;
constexpr size_t WS_H = 66 * MiB, WS_QL = 98 * MiB, WS_KVL = 106 * MiB, WS_KR = 114 * MiB, WS_DT = 116 * MiB, WS_Z = 118 * MiB, WS_XBC = 182 * MiB,
                 WS_SGA = 310 * MiB, WS_SGB = 342 * MiB, WS_QN = 374 * MiB, WS_QR = 406 * MiB, WS_KN = 422 * MiB, WS_VT = 454 * MiB, WS_CC = 486 * MiB,
                 WS_BC = 518 * MiB, WS_BT = 550 * MiB, WS_XT = 582 * MiB, WS_ATT = 646 * MiB, WS_ST = 678 * MiB, WS_HP = 806 * MiB, WS_SSM = 870 * MiB,
                 WS_SSQ = 934 * MiB, WS_END = 944 * MiB;
constexpr int SQ_Q = 0, SQ_KV = 4 * TT, SQ_MIX = 8 * TT, SQ_FF = 24 * TT;
constexpr size_t WS_FF1 = WS_XBC, WS_MA = WS_QN, WS_MERGED = WS_KN, WS_MIX = WS_VT, WS_FF = WS_ATT;

__device__ const double ROPE_INV[32] = {1.0, 0.7498942093324559, 0.5623413251903491, 0.4216965034285822, 0.31622776601683794, 0.23713737056616552, 0.1778279410038923, 0.1333521432163324, 0.1, 0.07498942093324558, 0.05623413251903491, 0.042169650342858224, 0.03162277660168379, 0.023713737056616554, 0.01778279410038923, 0.01333521432163324, 0.01, 0.007498942093324558, 0.005623413251903491, 0.004216965034285823, 0.0031622776601683794, 0.0023713737056616554, 0.0017782794100389228, 0.001333521432163324, 0.001, 0.0007498942093324559, 0.0005623413251903491, 0.00042169650342858224, 0.00031622776601683794, 0.00023713737056616554, 0.00017782794100389227, 0.0001333521432163324};

typedef __bf16 bf16x2_t __attribute__((ext_vector_type(2)));
__device__ __forceinline__ unsigned pk2(float lo, float hi) { const f32x2 v = {lo, hi}; const bf16x2_t b = __builtin_convertvector(v, bf16x2_t); return __builtin_bit_cast(unsigned, b); }
__device__ __forceinline__ float bflo(unsigned w) { return __builtin_bit_cast(float, w << 16); }
__device__ __forceinline__ float bfhi(unsigned w) { return __builtin_bit_cast(float, w & 0xffff0000u); }
__device__ __forceinline__ float wave_sum(float v) {
#pragma unroll
    for (int o = 1; o < 64; o <<= 1) v += __shfl_xor(v, o);
    return v;
}
__device__ __forceinline__ void st8(bf16_t* p, f32x4 a, f32x4 b) { u32x4 w; w.x = pk2(a[0], a[1]); w.y = pk2(a[2], a[3]); w.z = pk2(b[0], b[1]); w.w = pk2(b[2], b[3]); *(u32x4*)p = w; }
__device__ __forceinline__ void ld8(const bf16_t* p, f32x4& a, f32x4& b) { const u32x4 w = *(const u32x4*)p; a[0] = bflo(w.x); a[1] = bfhi(w.x); a[2] = bflo(w.y); a[3] = bfhi(w.y); b[0] = bflo(w.z); b[1] = bfhi(w.z); b[2] = bflo(w.w); b[3] = bfhi(w.w); }
__device__ __forceinline__ float sigm(float x) { return __builtin_amdgcn_rcpf(1.f + __builtin_amdgcn_exp2f(-1.4426950408889634f * x)); }
__device__ __forceinline__ float silu(float x) { return x * __builtin_amdgcn_rcpf(1.f + __builtin_amdgcn_exp2f(-1.4426950408889634f * x)); }
__device__ __forceinline__ float softplus(float x) {
    const float e = __expf(-fabsf(x));
    const float l = e < 0.03125f ? e * (1.f - e * (0.5f - e * (0.33333334f - 0.25f * e))) : __logf(1.f + e);
    return fmaxf(x, 0.f) + l;
}
__device__ __forceinline__ float bf2f_lds(const LAS unsigned char* p) { return __builtin_bit_cast(float, (unsigned)(*(const LAS unsigned short*)p) << 16); }
__device__ __forceinline__ float dot4(f32x4 a) { return (a[0] * a[0] + a[1] * a[1]) + (a[2] * a[2] + a[3] * a[3]); }
#define LDS_WAIT() asm volatile("s_waitcnt lgkmcnt(0)" ::: "memory")

__device__ __forceinline__ int srcmap(int map, int r) {
    if (map == 0) return r;
    if (map == 1) {
        if (r < 512) return r;
        if (r < 6656) return r + 64;
        if (r < 8704) return r + 96;
        if (r < 8768) { const int j = r - 8704, g8 = j >> 3, e = j & 7; return 512 + (e < 4 ? 4 * g8 + e : 32 + 4 * g8 + (e - 4)); }
        if (r < 8800) return 6720 + (r - 8768);
        return -1;
    }
    if (map == 2) {
        if (r < 1024) return (r >> 7) * 192 + (r & 127);
        const int rr = r - 1024, h = rr >> 6, j = rr & 63, g8 = j >> 3, e = j & 7;
        return h * 192 + 128 + (e < 4 ? 4 * g8 + e : 32 + 4 * g8 + (e - 4));
    }
    if (map == 3) return (r >> 7) * 256 + (r & 127);
    return (r >> 7) * 256 + 128 + (r & 127);
}
__device__ __forceinline__ void transpose_item(const float* W, int K, int N, bf16_t* WT, int map, const float* ks, int nblk, LAS float* scr, int item, int lane) {
    const int kb = item / nblk, nb = item % nblk, k0 = 64 * kb, n0 = 32 * nb;
    const int src = srcmap(map, n0 + (lane & 31));
#pragma unroll 8
    for (int i = 0; i < 32; ++i) { const int kk = 2 * i + (lane >> 5); float v = src >= 0 ? W[(size_t)(k0 + kk) * N + src] : 0.f; if (ks) v *= ks[k0 + kk]; scr[kk * 33 + (lane & 31)] = v; }
    LDS_WAIT(); asm volatile("" ::: "memory");
    const int c = lane & 7;
#pragma unroll
    for (int j = 0; j < 4; ++j) { const int n = (lane >> 3) + 8 * j; const LAS float* s = scr + (8 * c) * 33 + n;
        u32x4 o; o.x = pk2(s[0 * 33], s[1 * 33]); o.y = pk2(s[2 * 33], s[3 * 33]); o.z = pk2(s[4 * 33], s[5 * 33]); o.w = pk2(s[6 * 33], s[7 * 33]);
        *(u32x4*)(WT + (size_t)(n0 + n) * K + k0 + 8 * c) = o; }
    LDS_WAIT(); asm volatile("" ::: "memory");
}

#define ACC_T const f32x4 (&acc)[2][2][4][2]
struct EpiProj {
    static constexpr bool PERM = true, AFTER_DRAIN = false;
    bf16_t *QL, *KVL, *KR, *Z, *XBC, *SGA, *SGB; float* DT; float *ssq_q, *ssq_kv; const float* rope; const float* dt_bias; int tbase;
    __device__ __forceinline__ void operator()(ACC_T, const pg8::Unit& u, int wr, int wc, int fr, int fq) const {
        const int pn = u.pn, row0 = u.pm * 256 + wr * 64 + fr, cw = wc * 32 + 8 * fq;
        if (pn < 2) {
            bf16_t* O = pn == 0 ? QL : KVL; float* sq = (pn == 0 ? ssq_q : ssq_kv) + wc * TT + tbase;
#pragma unroll
            for (int ai = 0; ai < 2; ++ai)
#pragma unroll
                for (int m = 0; m < 4; ++m) { const int row = row0 + ai * 128 + m * 16; float s = 0.f;
#pragma unroll
                    for (int bj = 0; bj < 2; ++bj) { const f32x4 v0 = acc[ai][bj][m][0], v1 = acc[ai][bj][m][1]; st8(O + (unsigned)row * 256u + cw + bj * 128, v0, v1); s += dot4(v0) + dot4(v1); }
                    s += __shfl_xor(s, 16); s += __shfl_xor(s, 32);
                    if (fq == 0) sq[row] = s; }
        } else if (pn < 26) {
            bf16_t* O; int ld, c0; if (pn < 10) { O = Z; ld = 2048; c0 = (pn - 2) * 256; } else { O = XBC; ld = 4096; c0 = (pn - 10) * 256; }
#pragma unroll
            for (int ai = 0; ai < 2; ++ai)
#pragma unroll
                for (int m = 0; m < 4; ++m) { const int row = row0 + ai * 128 + m * 16;
#pragma unroll
                    for (int bj = 0; bj < 2; ++bj) st8(O + (unsigned)row * (unsigned)ld + c0 + cw + bj * 128, acc[ai][bj][m][0], acc[ai][bj][m][1]); }
        } else if (pn < 34) {
            bf16_t* O = pn < 30 ? SGA : SGB; const int c0 = ((pn - 26) & 3) * 256;
#pragma unroll
            for (int ai = 0; ai < 2; ++ai)
#pragma unroll
                for (int m = 0; m < 4; ++m) { const int row = row0 + ai * 128 + m * 16;
#pragma unroll
                    for (int bj = 0; bj < 2; ++bj) { f32x4 v0 = acc[ai][bj][m][0], v1 = acc[ai][bj][m][1];
#pragma unroll
                        for (int e = 0; e < 4; ++e) { v0[e] = sigm(v0[e]); v1[e] = sigm(v1[e]); }
                        st8(O + (unsigned)row * 1024u + c0 + cw + bj * 128, v0, v1); }
                    asm volatile("" ::: "memory"); }
        } else {
            if (wc < 2) {
                const int g8 = wc * 4 + fq;
#pragma unroll
                for (int ai = 0; ai < 2; ++ai)
#pragma unroll
                    for (int m = 0; m < 4; ++m) { const int row = row0 + ai * 128 + m * 16; const f32x4 v0 = acc[ai][0][m][0], v1 = acc[ai][0][m][1];
                        const f32x4* rp = (const f32x4*)(rope + (unsigned)((tbase + row) * 64 + 8 * g8)); const f32x4 c01 = rp[0], c23 = rp[1];
                        f32x4 o1, o2;
                        o1[0] = v0[0] * c01[0] - v1[0] * c01[1]; o2[0] = v0[0] * c01[1] + v1[0] * c01[0];
                        o1[1] = v0[1] * c01[2] - v1[1] * c01[3]; o2[1] = v0[1] * c01[3] + v1[1] * c01[2];
                        o1[2] = v0[2] * c23[0] - v1[2] * c23[1]; o2[2] = v0[2] * c23[1] + v1[2] * c23[0];
                        o1[3] = v0[3] * c23[2] - v1[3] * c23[3]; o2[3] = v0[3] * c23[3] + v1[3] * c23[2];
                        st8(KR + (unsigned)row * 64u + 8 * g8, o1, o2); asm volatile("" ::: "memory"); }
            } else if (wc == 2) {
                const int i0 = 8 * fq; const f32x4 b0 = *(const f32x4*)(dt_bias + i0), b1 = *(const f32x4*)(dt_bias + i0 + 4);
#pragma unroll
                for (int ai = 0; ai < 2; ++ai)
#pragma unroll
                    for (int m = 0; m < 4; ++m) { const int row = row0 + ai * 128 + m * 16; f32x4 v0 = acc[ai][0][m][0] + b0, v1 = acc[ai][0][m][1] + b1;
#pragma unroll
                        for (int e = 0; e < 4; ++e) { v0[e] = softplus(v0[e]); v1[e] = softplus(v1[e]); }
                        *(f32x4*)(DT + (unsigned)row * 32u + i0) = v0; *(f32x4*)(DT + (unsigned)row * 32u + i0 + 4) = v1; asm volatile("" ::: "memory"); }
            }
        }
    }
};
struct EpiQ {
    static constexpr bool PERM = true, AFTER_DRAIN = false;
    bf16_t *QN, *QR; const float* ssq; const float* rope; int tbase; float c2;
    __device__ __forceinline__ void operator()(ACC_T, const pg8::Unit& u, int wr, int wc, int fr, int fq) const {
        const int pn = u.pn, row0 = u.pm * 256 + wr * 64 + fr, cw = wc * 32 + 8 * fq;
#pragma unroll
        for (int ai = 0; ai < 2; ++ai)
#pragma unroll
            for (int m = 0; m < 4; ++m) { const int row = row0 + ai * 128 + m * 16; const float* sp = ssq + tbase + row; const float rs = rsqrtf(((sp[0] + sp[TT]) + (sp[2 * TT] + sp[3 * TT])) * (1.f / 256.f) + EPS) * c2;
#pragma unroll
                for (int bj = 0; bj < 2; ++bj) { const f32x4 v0 = acc[ai][bj][m][0] * rs, v1 = acc[ai][bj][m][1] * rs;
                    if (pn < 4) st8(QN + (unsigned)row * 1024u + pn * 256 + cw + bj * 128, v0, v1);
                    else { const int colr = (pn - 4) * 256 + cw + bj * 128, g8 = (colr & 63) >> 3;
                        const f32x4* rp = (const f32x4*)(rope + (unsigned)((tbase + row) * 64 + 8 * g8)); const f32x4 c01 = rp[0], c23 = rp[1];
                        f32x4 o1, o2;
                        o1[0] = v0[0] * c01[0] - v1[0] * c01[1]; o2[0] = v0[0] * c01[1] + v1[0] * c01[0];
                        o1[1] = v0[1] * c01[2] - v1[1] * c01[3]; o2[1] = v0[1] * c01[3] + v1[1] * c01[2];
                        o1[2] = v0[2] * c23[0] - v1[2] * c23[1]; o2[2] = v0[2] * c23[1] + v1[2] * c23[0];
                        o1[3] = v0[3] * c23[2] - v1[3] * c23[3]; o2[3] = v0[3] * c23[3] + v1[3] * c23[2];
                        st8(QR + (unsigned)row * 512u + colr, o1, o2); } }
                asm volatile("" ::: "memory"); }
    }
};
struct EpiRowScale {
    static constexpr bool PERM = true, AFTER_DRAIN = false;
    bf16_t* O; int ldc; const float* ssq; int tbase;
    __device__ __forceinline__ void operator()(ACC_T, const pg8::Unit& u, int wr, int wc, int fr, int fq) const {
        const int row0 = u.pm * 256 + wr * 64 + fr, col0 = u.pn * 256 + wc * 32 + 8 * fq;
#pragma unroll
        for (int ai = 0; ai < 2; ++ai)
#pragma unroll
            for (int m = 0; m < 4; ++m) { const int row = row0 + ai * 128 + m * 16; const float* sp = ssq + tbase + row; const float rs = rsqrtf(((sp[0] + sp[TT]) + (sp[2 * TT] + sp[3 * TT])) * (1.f / 256.f) + EPS);
#pragma unroll
                for (int bj = 0; bj < 2; ++bj) st8(O + (unsigned)row * (unsigned)ldc + col0 + bj * 128, acc[ai][bj][m][0] * rs, acc[ai][bj][m][1] * rs);
                asm volatile("" ::: "memory"); }
    }
};
struct EpiColScale {
    static constexpr bool PERM = true, AFTER_DRAIN = false;
    bf16_t* O; int ldc; const float* ssq; int tbase;
    __device__ __forceinline__ void operator()(ACC_T, const pg8::Unit& u, int wr, int wc, int fr, int fq) const {
        const int row0 = u.pm * 256 + wr * 64 + fr, col0 = u.pn * 256 + wc * 32 + 8 * fq;
#pragma unroll
        for (int bj = 0; bj < 2; ++bj) {
            const float* sp = ssq + tbase + col0 + bj * 128;
            f32x4 r0 = (*(const f32x4*)sp + *(const f32x4*)(sp + TT)) + (*(const f32x4*)(sp + 2 * TT) + *(const f32x4*)(sp + 3 * TT));
            f32x4 r1 = (*(const f32x4*)(sp + 4) + *(const f32x4*)(sp + TT + 4)) + (*(const f32x4*)(sp + 2 * TT + 4) + *(const f32x4*)(sp + 3 * TT + 4));
#pragma unroll
            for (int e = 0; e < 4; ++e) { r0[e] = rsqrtf(r0[e] * (1.f / 256.f) + EPS); r1[e] = rsqrtf(r1[e] * (1.f / 256.f) + EPS); }
#pragma unroll
            for (int ai = 0; ai < 2; ++ai)
#pragma unroll
                for (int m = 0; m < 4; ++m) { const int row = row0 + ai * 128 + m * 16; st8(O + (unsigned)row * (unsigned)ldc + col0 + bj * 128, acc[ai][bj][m][0] * r0, acc[ai][bj][m][1] * r1); }
            asm volatile("" ::: "memory");
        }
    }
};
template <int MODE> struct EpiGate {
    static constexpr bool PERM = true, AFTER_DRAIN = false;
    bf16_t* O; const bf16_t* G; const bf16_t* P;
    __device__ __forceinline__ void operator()(ACC_T, const pg8::Unit& u, int wr, int wc, int fr, int fq) const {
        const int row0 = u.pm * 256 + wr * 64 + fr, col0 = u.pn * 256 + wc * 32 + 8 * fq;
#pragma unroll
        for (int ai = 0; ai < 2; ++ai)
#pragma unroll
            for (int m = 0; m < 4; ++m) { const int row = row0 + ai * 128 + m * 16;
#pragma unroll
                for (int bj = 0; bj < 2; ++bj) { const unsigned off = (unsigned)row * 1024u + col0 + bj * 128; f32x4 g0, g1; ld8(G + off, g0, g1);
                    f32x4 v0 = acc[ai][bj][m][0] * g0, v1 = acc[ai][bj][m][1] * g1;
                    if (MODE == 1) { f32x4 p0, p1; ld8(P + off, p0, p1); v0 += p0; v1 += p1; }
                    st8(O + off, v0, v1); }
                asm volatile("" ::: "memory"); }
    }
};
struct EpiSsq {
    static constexpr bool PERM = true, AFTER_DRAIN = false;
    bf16_t* O; int ldc; float* ssq; int tbase;
    __device__ __forceinline__ void operator()(ACC_T, const pg8::Unit& u, int wr, int wc, int fr, int fq) const {
        const int row0 = u.pm * 256 + wr * 64 + fr, col0 = u.pn * 256 + wc * 32 + 8 * fq;
#pragma unroll
        for (int ai = 0; ai < 2; ++ai)
#pragma unroll
            for (int m = 0; m < 4; ++m) { const int row = row0 + ai * 128 + m * 16; float s = 0.f;
#pragma unroll
                for (int bj = 0; bj < 2; ++bj) { const f32x4 v0 = acc[ai][bj][m][0], v1 = acc[ai][bj][m][1]; st8(O + (unsigned)row * (unsigned)ldc + col0 + bj * 128, v0, v1); s += dot4(v0) + dot4(v1); }
                s += __shfl_xor(s, 16); s += __shfl_xor(s, 32);
                if (fq == 0) ssq[(u.pn * 4 + wc) * TT + tbase + row] = s; }
    }
};
struct EpiRelu2 {
    static constexpr bool PERM = true, AFTER_DRAIN = false;
    bf16_t* O; int ldc;
    __device__ __forceinline__ void operator()(ACC_T, const pg8::Unit& u, int wr, int wc, int fr, int fq) const {
        const int row0 = u.pm * 256 + wr * 64 + fr, col0 = u.pn * 256 + wc * 32 + 8 * fq;
#pragma unroll
        for (int ai = 0; ai < 2; ++ai)
#pragma unroll
            for (int m = 0; m < 4; ++m) { const int row = row0 + ai * 128 + m * 16;
#pragma unroll
                for (int bj = 0; bj < 2; ++bj) { f32x4 v0 = acc[ai][bj][m][0], v1 = acc[ai][bj][m][1];
#pragma unroll
                    for (int e = 0; e < 4; ++e) { const float a = fmaxf(v0[e], 0.f), b = fmaxf(v1[e], 0.f); v0[e] = a * a; v1[e] = b * b; }
                    st8(O + (unsigned)row * (unsigned)ldc + col0 + bj * 128, v0, v1); } }
    }
};

constexpr int ATT_KB = 24576, ATT_BUF = 40960;
__device__ __forceinline__ void attn_unit(LAS unsigned char* lds, const bf16_t* QN, const bf16_t* QR, const bf16_t* KN, const bf16_t* KR, const bf16_t* VT, bf16_t* ATT, int b, int h, int qb) {
    const int tid = ltid(), wid = __builtin_amdgcn_readfirstlane(tid >> 6), lane = tid & 63, r32 = lane & 31, hf = lane >> 5;
    const int tb = b * SEQ, q0w = qb * 256 + wid * 32;
    bf16x8 qf[12];
    { const unsigned t = (unsigned)(tb + q0w + r32);
#pragma unroll
      for (int ks = 0; ks < 8; ++ks) qf[ks] = *(const bf16x8*)(QN + t * 1024u + h * 128 + ks * 16 + hf * 8);
#pragma unroll
      for (int ks = 0; ks < 4; ++ks) qf[8 + ks] = *(const bf16x8*)(QR + t * 512u + h * 64 + ks * 16 + hf * 8); }
    f32x16 o[4];
#pragma unroll
    for (int i = 0; i < 4; ++i)
#pragma unroll
        for (int r = 0; r < 16; ++r) o[i][r] = 0.f;
    float m_i = -INFINITY, l_i = 0.f;
    const int nkt = 4 * (qb + 1);
    unsigned ksrc[3]; unsigned vsrc[2];
#pragma unroll
    for (int i = 0; i < 3; ++i) { const int pid = (wid + 8 * i) * 64 + lane, row = pid / 24, cp = pid % 24, c = (cp & ~7) | ((cp ^ row) & 7);
        ksrc[i] = c < 16 ? (unsigned)((tb + row) * 1024 + h * 128 + c * 8) : (0x80000000u | (unsigned)((tb + row) * 64 + (c - 16) * 8)); }
#pragma unroll
    for (int i = 0; i < 2; ++i) { const int pid = (wid + 8 * i) * 64 + lane, dv = pid >> 3, cp = pid & 7, c = cp ^ (dv & 7);
        vsrc[i] = (unsigned)((h * 128 + dv) * TG + tb + c * 8); }
#define ATT_DMA(kt, buf) do { \
    _Pragma("unroll") for (int i = 0; i < 3; ++i) { const bf16_t* src = (ksrc[i] & 0x80000000u) ? KR + ((ksrc[i] & 0x7fffffffu) + (unsigned)(kt) * 4096u) : KN + (ksrc[i] + (unsigned)(kt) * 65536u); \
        __builtin_amdgcn_global_load_lds((const unsigned*)src, (LAS unsigned*)(lds + (buf) * ATT_BUF + (wid + 8 * i) * 1024), 16, 0, 0); } \
    _Pragma("unroll") for (int i = 0; i < 2; ++i) \
        __builtin_amdgcn_global_load_lds((const unsigned*)(VT + (vsrc[i] + (unsigned)(kt) * 64u)), (LAS unsigned*)(lds + (buf) * ATT_BUF + ATT_KB + (wid + 8 * i) * 1024), 16, 0, 0); } while (0)
    __syncthreads();
    ATT_DMA(0, 0);
    const int tx = hf ^ (r32 & 7);
    for (int kt = 0; kt < nkt; ++kt) {
        asm volatile("s_waitcnt vmcnt(0)" ::: "memory");
        __syncthreads();
        if (kt + 1 < nkt) ATT_DMA(kt + 1, (kt + 1) & 1);
        const LAS unsigned char* kbuf = lds + (kt & 1) * ATT_BUF; const LAS unsigned char* vbuf = kbuf + ATT_KB;
        const int key0 = kt * 64;
        if (key0 <= q0w + 31) {
            f32x16 s[2];
#pragma unroll
            for (int kb = 0; kb < 2; ++kb) {
#pragma unroll
                for (int r = 0; r < 16; ++r) s[kb][r] = 0.f;
                const LAS unsigned char* krow = kbuf + (kb * 32 + r32) * 384;
#pragma unroll
                for (int ks = 0; ks < 12; ++ks) { const bf16x8 a = *(const LAS bf16x8*)(krow + (((2 * ks) & ~7) + (((2 * ks) & 7) ^ tx)) * 16);
                    s[kb] = __builtin_amdgcn_mfma_f32_32x32x16_bf16(a, qf[ks], s[kb], 0, 0, 0);
                    if ((ks & 3) == 3) __builtin_amdgcn_sched_barrier(0); }
            }
            if (key0 + 63 > q0w) {
                const int qi = q0w + r32;
#pragma unroll
                for (int kb = 0; kb < 2; ++kb)
#pragma unroll
                    for (int r = 0; r < 16; ++r) { const int key = key0 + kb * 32 + (r & 3) + 8 * (r >> 2) + 4 * hf; if (key > qi) s[kb][r] = -INFINITY; }
            }
            float mx = s[0][0];
#pragma unroll
            for (int kb = 0; kb < 2; ++kb)
#pragma unroll
                for (int r = 0; r < 16; ++r) mx = fmaxf(mx, s[kb][r]);
            mx = fmaxf(mx, __shfl_xor(mx, 32));
            const float m_new = fmaxf(m_i, mx);
            if (__any(m_new - m_i > 8.f)) {
                const float alpha = __builtin_amdgcn_exp2f(m_i - m_new);
                l_i *= alpha; m_i = m_new;
#pragma unroll
                for (int i = 0; i < 4; ++i)
#pragma unroll
                    for (int r = 0; r < 16; ++r) o[i][r] *= alpha;
            }
            float ps = 0.f;
#pragma unroll
            for (int kb = 0; kb < 2; ++kb)
#pragma unroll
                for (int r = 0; r < 16; ++r) { const float p = __builtin_amdgcn_exp2f(s[kb][r] - m_i); s[kb][r] = p; ps += p; }
            l_i += ps;
            bf16x8 pb[2][2];
#pragma unroll
            for (int kb = 0; kb < 2; ++kb)
#pragma unroll
                for (int s2 = 0; s2 < 2; ++s2) { u32x4 w; w.x = pk2(s[kb][8 * s2 + 0], s[kb][8 * s2 + 1]); w.y = pk2(s[kb][8 * s2 + 2], s[kb][8 * s2 + 3]);
                    w.z = pk2(s[kb][8 * s2 + 4], s[kb][8 * s2 + 5]); w.w = pk2(s[kb][8 * s2 + 6], s[kb][8 * s2 + 7]); pb[kb][s2] = __builtin_bit_cast(bf16x8, w); }
            const int vx = r32 & 7;
#pragma unroll
            for (int dvb = 0; dvb < 4; ++dvb) {
                const LAS unsigned char* vrow = vbuf + (dvb * 32 + r32) * 128 + hf * 8;
#pragma unroll
                for (int kb = 0; kb < 2; ++kb)
#pragma unroll
                    for (int s2 = 0; s2 < 2; ++s2) { const int c = kb * 4 + s2 * 2;
                        const u32x2 lo = *(const LAS u32x2*)(vrow + ((c ^ vx) * 16)), hi = *(const LAS u32x2*)(vrow + (((c + 1) ^ vx) * 16)); u32x4 w; w.x = lo.x; w.y = lo.y; w.z = hi.x; w.w = hi.y;
                        o[dvb] = __builtin_amdgcn_mfma_f32_32x32x16_bf16(__builtin_bit_cast(bf16x8, w), pb[kb][s2], o[dvb], 0, 0, 0); }
                __builtin_amdgcn_sched_barrier(0);
            }
        }
    }
#undef ATT_DMA
    l_i += __shfl_xor(l_i, 32);
    const float inv = 1.f / l_i;
    bf16_t* orow = ATT + (unsigned)(tb + q0w + r32) * 1024u + h * 128;
#pragma unroll
    for (int dvb = 0; dvb < 4; ++dvb)
#pragma unroll
        for (int rg = 0; rg < 4; ++rg) { u32x2 w; w.x = pk2(o[dvb][4 * rg] * inv, o[dvb][4 * rg + 1] * inv); w.y = pk2(o[dvb][4 * rg + 2] * inv, o[dvb][4 * rg + 3] * inv);
            *(u32x2*)(orow + dvb * 32 + 8 * rg + 4 * hf) = w; }
}

constexpr int SP = 272;
__device__ __forceinline__ void ld_tile(LAS unsigned char* dst, const bf16_t* src, int rows) {
    for (int p = ltid(); p < rows * 16; p += 512) { const int r = p >> 4, c = p & 15; *(LAS u32x4*)(dst + r * SP + c * 16) = *(const u32x4*)(src + r * 128 + c * 8); }
}
__device__ __forceinline__ void chunk_prep(LAS float* dts, LAS float* acs, const float* DT, int trow0, int g, const float* a_log) {
    const int tid = ltid(), wid = tid >> 6, lane = tid & 63;
    if (wid < 4) {
        const float A = -__expf(a_log[g * 4 + wid]);
        const float d0 = DT[(size_t)(trow0 + 2 * lane) * 32 + g * 4 + wid], d1 = DT[(size_t)(trow0 + 2 * lane + 1) * 32 + g * 4 + wid];
        const float x0 = d0 * A, x1 = x0 + d1 * A;
        float incl = x1;
#pragma unroll
        for (int o = 1; o < 64; o <<= 1) { const float v = __shfl_up(incl, o); if (lane >= o) incl += v; }
        const float excl = incl - x1;
        acs[wid * 128 + 2 * lane] = excl + x0; acs[wid * 128 + 2 * lane + 1] = excl + x1;
        dts[wid * 128 + 2 * lane] = d0; dts[wid * 128 + 2 * lane + 1] = d1;
    }
    __syncthreads();
}
__device__ __forceinline__ bf16x8 ldsfrag(const LAS unsigned char* base, int row, int k0) { return *(const LAS bf16x8*)(base + row * SP + k0 * 2); }

#define XB_TMO      128
#define XB_XCNT(j)  (256  + 64 * (j))
#define XB_XSUB(j)  (1280 + 64 * (j))
#define XB_XGEN(j)  (2304 + 64 * (j))
#define XB_TOP      3328
#define XB_TOPGEN   3392
#define XCD_BAR_WORDS 3456
#define XB_SPIN_CAP (1u << 18)

__device__ __forceinline__ unsigned xb_ld(unsigned* p)              { return __hip_atomic_load(p, __ATOMIC_RELAXED, __HIP_MEMORY_SCOPE_AGENT); }
__device__ __forceinline__ unsigned xb_add(unsigned* p, unsigned v) { return __hip_atomic_fetch_add(p, v, __ATOMIC_RELAXED, __HIP_MEMORY_SCOPE_AGENT); }
__device__ __forceinline__ unsigned xb_xcc_id() { return (unsigned)__builtin_amdgcn_s_getreg((3 << 11) | 20) & 0xFu; }
#define XB_SPIN(cond, bar) do { unsigned _sp = 0; while (cond) { __builtin_amdgcn_s_sleep(1); \
    if ((++_sp & 255u) == 0u) { if (xb_ld(&(bar)[XB_TMO])) break; if (_sp > XB_SPIN_CAP) { atomicAdd(&(bar)[XB_TMO], 1u); break; } } } } while (0)

struct XcdBarrier {
    unsigned* bar; unsigned x;
    volatile LAS unsigned* st;
};

__device__ __forceinline__ XcdBarrier xcd_barrier_post(unsigned* bar, volatile LAS unsigned* st) {
    XcdBarrier b; b.bar = bar; b.x = xb_xcc_id(); b.st = st;
    if (threadIdx.x == 0) (void)xb_add(&bar[XB_XCNT(b.x)], 1u);
    return b;
}
__device__ __forceinline__ void xcd_barrier_complete(unsigned* bar, unsigned x, unsigned& nloc, unsigned& nx) {
    const unsigned G = gridDim.x * gridDim.y * gridDim.z;
    unsigned sum, cnt, mine, sp = 0u;
    for (;;) {
        sum = 0u; cnt = 0u; mine = 0u;
#pragma unroll
        for (unsigned j = 0; j < 16; ++j) { const unsigned c = xb_ld(&bar[XB_XCNT(j)]); sum += c; cnt += (c > 0u) ? 1u : 0u; mine = (j == x) ? c : mine; }
        if (sum == G) break;
        __builtin_amdgcn_s_sleep(1);
        if ((++sp & 255u) == 0u) { if (xb_ld(&bar[XB_TMO])) break; if (sp > XB_SPIN_CAP) { atomicAdd(&bar[XB_TMO], 1u); break; } }
    }
    nloc = mine > 0u ? mine : 1u; nx = cnt > 0u ? cnt : 1u;
}

__device__ __forceinline__ void xcd_barrier(const XcdBarrier& b) {
    asm volatile("s_waitcnt vmcnt(0)" ::: "memory");
    __syncthreads();
    if (threadIdx.x == 0) {
        unsigned* bar = b.bar;
        __builtin_amdgcn_s_waitcnt(0);
        unsigned nloc = b.st[0], nx = b.st[1];
        if (nloc == 0u) { xcd_barrier_complete(bar, b.x, nloc, nx); b.st[0] = nloc; b.st[1] = nx; }
        const unsigned old = xb_add(&bar[XB_XSUB(b.x)], 1u);
        const unsigned gen = old / nloc;
        if (old + 1u == (gen + 1u) * nloc) {
            __builtin_amdgcn_fence(__ATOMIC_RELEASE, "agent");
            asm volatile("s_waitcnt vmcnt(0)" ::: "memory");
            const unsigned og = xb_add(&bar[XB_TOP], 1u);
            const unsigned tg = og / nx;
            if (og + 1u == (tg + 1u) * nx) xb_add(&bar[XB_TOPGEN], 1u);
            else XB_SPIN(xb_ld(&bar[XB_TOPGEN]) == tg, bar);
            __builtin_amdgcn_fence(__ATOMIC_ACQUIRE, "agent");
            xb_add(&bar[XB_XGEN(b.x)], 1u);
            asm volatile("s_waitcnt vmcnt(0)" ::: "memory");
        } else {
            XB_SPIN(xb_ld(&bar[XB_XGEN(b.x)]) == gen, bar);
            __builtin_amdgcn_fence(__ATOMIC_ACQUIRE, "agent");
            asm volatile("s_waitcnt vmcnt(0)" ::: "memory");
        }
    }
    __syncthreads();
}

struct Args { const void* in[25]; float* out; unsigned char* ws; };
__device__ __forceinline__ const void* in_ptr(int i) {
    int off = i * 8; asm volatile("" : "+s"(off));
    const __attribute__((address_space(4))) char* kp = (const __attribute__((address_space(4))) char*)__builtin_amdgcn_kernarg_segment_ptr();
    return *(const void* const __attribute__((address_space(4)))*)(kp + off);
}
#define INF(i) ((const float*)in_ptr(i))
#define WSB() ((unsigned char*)in_ptr(26))
#define OUTP() ((float*)in_ptr(25))

__device__ __forceinline__ void ph_mod(LAS unsigned char* lds) {
    const int tid = ltid(), lane = tid & 63, wid = __builtin_amdgcn_readfirstlane(tid >> 6), G = lgrid(), bx = lbid();
    float* MOD = (float*)(WSB() + WS_MOD);
    const float* cvec = INF(1); const float* w_ada = INF(3); const float* b_ada = INF(4);
    for (int item = bx; item < 96; item += G) {
        LAS float* sc = (LAS float*)lds;
        LAS float* red = (LAS float*)(lds + 65536);
        for (int i = tid; i < 16384; i += 512) { const int b = i >> 10, k = i & 1023; sc[k * 16 + b] = silu(cvec[i]); }
        __syncthreads();
        const int kg = tid >> 4, cl = tid & 15, j0 = item * 64 + cl * 4;
        f32x4 ac[16];
#pragma unroll
        for (int b = 0; b < 16; ++b) ac[b] = (f32x4){0.f, 0.f, 0.f, 0.f};
#pragma unroll 2
        for (int i = 0; i < 32; ++i) { const int k = kg + 32 * i; const f32x4 w = *(const f32x4*)(w_ada + (size_t)k * 6144 + j0);
            const LAS f32x4* sp = (const LAS f32x4*)(sc + k * 16);
#pragma unroll
            for (int q = 0; q < 4; ++q) { const f32x4 s4 = sp[q];
#pragma unroll
                for (int e = 0; e < 4; ++e) ac[q * 4 + e] += w * s4[e]; } }
#pragma unroll
        for (int b = 0; b < 16; ++b)
#pragma unroll
            for (int e = 0; e < 4; ++e) { float v = ac[b][e]; v += __shfl_xor(v, 16); v += __shfl_xor(v, 32); ac[b][e] = v; }
        if (lane < 16) {
#pragma unroll
            for (int b = 0; b < 16; ++b) *(LAS f32x4*)(red + (wid * 16 + b) * 64 + cl * 4) = ac[b];
        }
        __syncthreads();
        for (int i = tid; i < 1024; i += 512) { const int b = i >> 6, cc = i & 63; float s = b_ada[item * 64 + cc];
#pragma unroll
            for (int w = 0; w < 8; ++w) s += red[(w * 16 + b) * 64 + cc];
            MOD[b * 6144 + item * 64 + cc] = s; }
        __syncthreads();
    }
}
__device__ __forceinline__ void ph_wcopy(LAS unsigned char* lds) {
    const int tid = ltid(), lane = tid & 63, wid = __builtin_amdgcn_readfirstlane(tid >> 6), G = lgrid(), bx = lbid();
    const int gw = bx * 8 + wid, NGW = G * 8;
    unsigned char* ws = WSB();
    LAS float* scr = (LAS float*)(lds + wid * 8448);
    constexpr int I0 = 16 * 280, I1 = 4 * 48, I2 = 4 * 32, I3 = 4 * 32, I4 = 16 * 32, I5 = 32 * 32, I6 = 16 * 32, I7 = 16 * 128, I8 = 64 * 32;
    constexpr int NIT = I0 + I1 + I2 + I3 + I4 + I5 + I6 + I7 + I8;
    for (int it = gw; it < NIT; it += NGW) {
        int r = it;
        if (r < I0) { transpose_item(INF(7), 1024, 8800, (bf16_t*)(ws + WS_WIN), 1, nullptr, 280, scr, r, lane); continue; } r -= I0;
        if (r < I1) { transpose_item(INF(10), 256, 1536, (bf16_t*)(ws + WS_WUQ), 2, INF(8), 48, scr, r, lane); continue; } r -= I1;
        if (r < I2) { transpose_item(INF(11), 256, 2048, (bf16_t*)(ws + WS_WUKN), 3, INF(9), 32, scr, r, lane); continue; } r -= I2;
        if (r < I3) { transpose_item(INF(11), 256, 2048, (bf16_t*)(ws + WS_WUV), 4, INF(9), 32, scr, r, lane); continue; } r -= I3;
        if (r < I4) { transpose_item(INF(12), 1024, 1024, (bf16_t*)(ws + WS_WOA), 0, nullptr, 32, scr, r, lane); continue; } r -= I4;
        if (r < I5) { transpose_item(INF(19), 2048, 1024, (bf16_t*)(ws + WS_WOB), 0, nullptr, 32, scr, r, lane); continue; } r -= I5;
        if (r < I6) { transpose_item(INF(20), 1024, 1024, (bf16_t*)(ws + WS_WOUT), 0, nullptr, 32, scr, r, lane); continue; } r -= I6;
        if (r < I7) { transpose_item(INF(23), 1024, 4096, (bf16_t*)(ws + WS_WFF1), 0, nullptr, 128, scr, r, lane); continue; } r -= I7;
        transpose_item(INF(24), 4096, 1024, (bf16_t*)(ws + WS_WFF2), 0, nullptr, 32, scr, r, lane);
    }
}
__device__ __forceinline__ void ph_rope_zero() {
    const int tid = ltid(), G = lgrid(), bx = lbid();
    unsigned char* ws = WSB(); float* ROPE = (float*)(ws + WS_ROPE); const int* positions = (const int*)in_ptr(2);
    for (int idx = bx * 512 + tid; idx < TT * 32; idx += G * 512) {
        const int t = idx >> 5, i = idx & 31;
        const double ang = (double)positions[t] * ROPE_INV[i];
        const double n = __builtin_rint(ang * 0.15915494309189535);
        const double r = ang - n * 6.283185307179586476925, x2 = r * r;
        double ts = r, s = r, tc = 1.0, c = 1.0;
#pragma unroll
        for (int k = 1; k <= 13; ++k) { ts *= -x2 * (1.0 / (double)((2 * k) * (2 * k + 1))); s += ts; tc *= -x2 * (1.0 / (double)((2 * k - 1) * (2 * k))); c += tc; }
        *(f32x2*)(ROPE + (size_t)idx * 2) = (f32x2){(float)c, (float)s};
    }
}
__device__ __forceinline__ void ph_final_rows(int pb) {
    const int tid = ltid(), lane = tid & 63, wid = __builtin_amdgcn_readfirstlane(tid >> 6), G = lgrid(), bx = lbid();
    const int gw = bx * 8 + wid, NGW = G * 8;
    unsigned char* ws = WSB(); const float* SSQ_FF = (const float*)(ws + WS_SSQ) + SQ_FF; const float* MOD = (const float*)(ws + WS_MOD); const bf16_t* FF = (const bf16_t*)(ws + WS_FF);
    const float* g_post_mlp = INF(22); float* out = OUTP();
    for (int m = gw; m < TG; m += NGW) { const int t = pb + m, b = t >> 12;
        float sv = lane < 16 ? SSQ_FF[lane * TT + t] : 0.f; sv += __shfl_xor(sv, 1); sv += __shfl_xor(sv, 2); sv += __shfl_xor(sv, 4); sv += __shfl_xor(sv, 8); sv = __shfl(sv, 0);
        const float rs = rsqrtf(sv * (1.f / 1024.f) + EPS); const float* gate2 = MOD + b * 6144 + 5120;
#pragma unroll
        for (int j = 0; j < 4; ++j) { const int c0 = 4 * lane + 256 * j; const u32x2 w = *(const u32x2*)(FF + (size_t)m * 1024 + c0);
            f32x4 f = {bflo(w.x), bfhi(w.x), bflo(w.y), bfhi(w.y)}; const f32x4 g = *(const f32x4*)(g_post_mlp + c0), ga = *(const f32x4*)(gate2 + c0);
            f32x4* op = (f32x4*)(out + (size_t)t * 1024 + c0); *op = *op + ga * (f * rs * g); } }
}
__device__ __forceinline__ void ph_hrows(int tbase) {
    const int tid = ltid(), lane = tid & 63, wid = __builtin_amdgcn_readfirstlane(tid >> 6), G = lgrid(), bx = lbid();
    const int gw = bx * 8 + wid, NGW = G * 8;
    unsigned char* ws = WSB(); const float* MOD = (const float*)(ws + WS_MOD); bf16_t* H = (bf16_t*)(ws + WS_H);
    const float* x = INF(0); const float* g_pre_mix = INF(5);
    for (int m = gw; m < TG; m += NGW) { const int t = tbase + m, b = t >> 12;
        const f32x4* xr = (const f32x4*)(x + (size_t)t * 1024) + lane; f32x4 v[4]; float s = 0.f;
#pragma unroll
        for (int j = 0; j < 4; ++j) { v[j] = xr[64 * j]; s += dot4(v[j]); }
        const float rs = rsqrtf(wave_sum(s) * (1.f / 1024.f) + EPS); const float* shift = MOD + b * 6144; const float* scale = shift + 1024;
#pragma unroll
        for (int j = 0; j < 4; ++j) { const int c0 = 4 * lane + 256 * j; const f32x4 g = *(const f32x4*)(g_pre_mix + c0), sc = *(const f32x4*)(scale + c0), sh = *(const f32x4*)(shift + c0);
            const f32x4 hv = v[j] * rs * g * (sc + 1.f) + sh; u32x2 w; w.x = pk2(hv[0], hv[1]); w.y = pk2(hv[2], hv[3]); *(u32x2*)(H + (size_t)m * 1024 + c0) = w; } }
}
__device__ __forceinline__ void ph_proj(LAS unsigned char* lds, int tbase) {
    unsigned char* ws = WSB(); const int G = lgrid(), bx = lbid();
    pg8::Gemm g{(const bf16_t*)(ws + WS_H), (const bf16_t*)(ws + WS_WIN), TG, NPROJ, 1024}; pg8::StaticOrder S; S.init(TG, NPROJ, G, bx);
    float* SSQ = (float*)(ws + WS_SSQ);
    EpiProj E{(bf16_t*)(ws + WS_QL), (bf16_t*)(ws + WS_KVL), (bf16_t*)(ws + WS_KR), (bf16_t*)(ws + WS_Z), (bf16_t*)(ws + WS_XBC), (bf16_t*)(ws + WS_SGA), (bf16_t*)(ws + WS_SGB),
              (float*)(ws + WS_DT), SSQ + SQ_Q, SSQ + SQ_KV, (const float*)(ws + WS_ROPE), INF(15), tbase};
    pg8::gemm_phase<EpiProj, pg8::StaticOrder, true, true>(lds, g, S, E);
}
__device__ __forceinline__ void ph_upq(LAS unsigned char* lds, int tbase) {
    unsigned char* ws = WSB(); const int G = lgrid(), bx = lbid();
    pg8::Gemm g{(const bf16_t*)(ws + WS_QL), (const bf16_t*)(ws + WS_WUQ), TG, 1536, 256}; pg8::StaticOrder S; S.init(TG, 1536, G, bx);
    EpiQ E{(bf16_t*)(ws + WS_QN), (bf16_t*)(ws + WS_QR), (const float*)(ws + WS_SSQ) + SQ_Q, (const float*)(ws + WS_ROPE), tbase, 0.07216878364870322f * 1.4426950408889634f};
    pg8::gemm_phase<EpiQ, pg8::StaticOrder, true, true>(lds, g, S, E);
}
__device__ __forceinline__ void ph_upk(LAS unsigned char* lds, int tbase) {
    unsigned char* ws = WSB(); const int G = lgrid(), bx = lbid();
    pg8::Gemm g{(const bf16_t*)(ws + WS_KVL), (const bf16_t*)(ws + WS_WUKN), TG, 1024, 256}; pg8::StaticOrder S; S.init(TG, 1024, G, bx);
    EpiRowScale E{(bf16_t*)(ws + WS_KN), 1024, (const float*)(ws + WS_SSQ) + SQ_KV, tbase};
    pg8::gemm_phase<EpiRowScale, pg8::StaticOrder, true, true>(lds, g, S, E);
}
__device__ __forceinline__ void ph_upv(LAS unsigned char* lds, int tbase) {
    unsigned char* ws = WSB(); const int G = lgrid(), bx = lbid();
    pg8::Gemm g{(const bf16_t*)(ws + WS_WUV), (const bf16_t*)(ws + WS_KVL), 1024, TG, 256}; pg8::StaticOrder S; S.init(1024, TG, G, bx);
    EpiColScale E{(bf16_t*)(ws + WS_VT), TG, (const float*)(ws + WS_SSQ) + SQ_KV, tbase};
    pg8::gemm_phase<EpiColScale, pg8::StaticOrder, true, true>(lds, g, S, E);
}
__device__ __forceinline__ void ph_conv(LAS unsigned char* lds) {
    const int tid = ltid(), lane = tid & 63, wid = __builtin_amdgcn_readfirstlane(tid >> 6), G = lgrid(), bx = lbid();
    const int gw = bx * 8 + wid, NGW = G * 8;
    unsigned char* ws = WSB(); const bf16_t* XBC = (const bf16_t*)(ws + WS_XBC);
    const float* conv_w = INF(13); const float* conv_b = INF(14);
    LAS unsigned char* tile = lds + wid * 16768;
    for (int item = gw; item < NB * 32 * 64; item += NGW) {
        const int slab = item & 63, c = (item >> 6) & 31, b = item >> 11;
        const int ch0 = slab * 64;
        {
            u32x4 v[16];
            const bf16_t* src = XBC + (unsigned)((b * SEQ + c * 128) * 4096 + ch0);
#pragma unroll
            for (int i = 0; i < 16; ++i) { const int p = i * 64 + lane; v[i] = *(const u32x4*)(src + (unsigned)((p >> 3) * 4096 + (p & 7) * 8)); }
            u32x4 hv = {0u, 0u, 0u, 0u};
            if (lane < 24 && c > 0) hv = *(const u32x4*)(XBC + (unsigned)((b * SEQ + c * 128 - 3 + (lane >> 3)) * 4096 + ch0 + (lane & 7) * 8));
#pragma unroll
            for (int i = 0; i < 16; ++i) { const int p = i * 64 + lane; *(LAS u32x4*)(tile + (3 + (p >> 3)) * 128 + (p & 7) * 16) = v[i]; }
            if (lane < 24) *(LAS u32x4*)(tile + (lane >> 3) * 128 + (lane & 7) * 16) = hv;
        }
        LDS_WAIT(); __builtin_amdgcn_wave_barrier();
        if (slab < 48) {
            bf16_t* dst;
            if (slab < 32) { const int bl = (b * 32 + c) * 8 + (slab >> 2); dst = (bf16_t*)(ws + WS_XT) + ((size_t)(bl * 4 + (slab & 3)) * 64) * 128; }
            else { const int bl = (b * 32 + c) * 8 + ((slab - 32) >> 1); dst = (bf16_t*)(ws + WS_BT) + ((size_t)bl * 128 + ((slab - 32) & 1) * 64) * 128; }
            const int ch = lane;
            const float w0 = conv_w[ch0 + ch], w1 = conv_w[4096 + ch0 + ch], w2 = conv_w[8192 + ch0 + ch], w3 = conv_w[12288 + ch0 + ch], bb = conv_b[ch0 + ch];
            const LAS unsigned char* tp = tile + ch * 2;
            float u0 = bf2f_lds(tp), u1 = bf2f_lds(tp + 128), u2 = bf2f_lds(tp + 256);
#pragma unroll 2
            for (int q = 0; q < 16; ++q) {
                float uu[11]; uu[0] = u0; uu[1] = u1; uu[2] = u2;
#pragma unroll
                for (int i = 0; i < 8; ++i) uu[3 + i] = bf2f_lds(tp + (q * 8 + 3 + i) * 128);
                float ov[8];
#pragma unroll
                for (int j = 0; j < 8; ++j) ov[j] = silu(bb + w0 * uu[j] + w1 * uu[j + 1] + w2 * uu[j + 2] + w3 * uu[j + 3]);
                u32x4 w; w.x = pk2(ov[0], ov[1]); w.y = pk2(ov[2], ov[3]); w.z = pk2(ov[4], ov[5]); w.w = pk2(ov[6], ov[7]);
                *(u32x4*)(dst + (unsigned)(ch * 128 + q * 8)) = w;
                u0 = uu[8]; u1 = uu[9]; u2 = uu[10];
            }
        }
        if (slab >= 32) {
            const int s2 = slab - (slab < 48 ? 32 : 48); const int bl = (b * 32 + c) * 8 + (s2 >> 1);
            bf16_t* dst = (bf16_t*)(ws + (slab < 48 ? WS_BC : WS_CC)) + (size_t)bl * 128 * 128 + (s2 & 1) * 64;
            const int cgp = lane & 7, lr = lane >> 3, chb = ch0 + cgp * 8;
            f32x4 wa[4], wb[4];
#pragma unroll
            for (int k = 0; k < 4; ++k) { wa[k] = *(const f32x4*)(conv_w + k * 4096 + chb); wb[k] = *(const f32x4*)(conv_w + k * 4096 + chb + 4); }
            const f32x4 b0 = *(const f32x4*)(conv_b + chb), b1 = *(const f32x4*)(conv_b + chb + 4);
#pragma unroll 2
            for (int q = 0; q < 16; ++q) { const int l = q * 8 + lr;
                f32x4 a0 = b0, a1 = b1;
#pragma unroll
                for (int k = 0; k < 4; ++k) { const u32x4 uw = *(const LAS u32x4*)(tile + (l + k) * 128 + cgp * 16);
                    const f32x4 x0 = {bflo(uw.x), bfhi(uw.x), bflo(uw.y), bfhi(uw.y)}, x1 = {bflo(uw.z), bfhi(uw.z), bflo(uw.w), bfhi(uw.w)};
                    a0 += wa[k] * x0; a1 += wb[k] * x1; }
#pragma unroll
                for (int e = 0; e < 4; ++e) { a0[e] = silu(a0[e]); a1[e] = silu(a1[e]); }
                st8(dst + (unsigned)(l * 128 + cgp * 8), a0, a1); }
        }
        LDS_WAIT(); __builtin_amdgcn_wave_barrier();
    }
    __syncthreads();
}
__device__ __forceinline__ void ph_states(LAS unsigned char* lds) {
    const int tid = ltid(), lane = tid & 63, wid = __builtin_amdgcn_readfirstlane(tid >> 6), G = lgrid(), bx = lbid();
    unsigned char* ws = WSB(); const float* DT = (const float*)(ws + WS_DT); float* DEC = (float*)(ws + WS_DEC); const float* a_log = INF(16);
    for (int item = bx; item < NB * 32 * 8; item += G) {
        const int bl = item, g = item & 7, c = (item >> 3) & 31, b = item >> 8;
        LAS unsigned char* XTs = lds; LAS unsigned char* BTs = lds + 256 * SP;
        LAS float* dts = (LAS float*)(lds + 384 * SP); LAS float* acs = dts + 512; LAS float* wsc = acs + 512;
        ld_tile(XTs, (const bf16_t*)(ws + WS_XT) + (size_t)bl * 4 * 8192, 256); ld_tile(BTs, (const bf16_t*)(ws + WS_BT) + (size_t)bl * 16384, 128);
        chunk_prep(dts, acs, DT, b * SEQ + c * 128, g, a_log);
        { const int hh = tid >> 7; wsc[tid] = dts[tid] * __expf(acs[hh * 128 + 127] - acs[tid]); }
        if (tid < 4) DEC[(b * 32 + c) * 32 + g * 4 + tid] = __expf(acs[tid * 128 + 127]);
        __syncthreads();
        const int r32 = lane & 31, hf = lane >> 5, pb = wid >> 2, nb = wid & 3;
#pragma unroll 1
        for (int hh = 0; hh < 4; ++hh) {
            f32x16 acc;
#pragma unroll
            for (int r = 0; r < 16; ++r) acc[r] = 0.f;
#pragma unroll 2
            for (int ks = 0; ks < 8; ++ks) {
                const u32x4 xa = *(const LAS u32x4*)(XTs + (hh * 64 + pb * 32 + r32) * SP + (ks * 16 + hf * 8) * 2);
                const LAS f32x4* wp = (const LAS f32x4*)(wsc + hh * 128 + ks * 16 + hf * 8); const f32x4 w0 = wp[0], w1 = wp[1];
                u32x4 xs; xs.x = pk2(bflo(xa.x) * w0[0], bfhi(xa.x) * w0[1]); xs.y = pk2(bflo(xa.y) * w0[2], bfhi(xa.y) * w0[3]);
                xs.z = pk2(bflo(xa.z) * w1[0], bfhi(xa.z) * w1[1]); xs.w = pk2(bflo(xa.w) * w1[2], bfhi(xa.w) * w1[3]);
                const bf16x8 bb = ldsfrag(BTs, nb * 32 + r32, ks * 16 + hf * 8);
                acc = __builtin_amdgcn_mfma_f32_32x32x16_bf16(__builtin_bit_cast(bf16x8, xs), bb, acc, 0, 0, 0);
            }
            bf16_t* sp = (bf16_t*)(ws + WS_ST) + ((size_t)bl * 4 + hh) * 8192 + nb * 32 + r32;
#pragma unroll
            for (int r = 0; r < 16; ++r) sp[(pb * 32 + (r & 3) + 8 * (r >> 2) + 4 * hf) * 128] = (bf16_t)(pk2(acc[r], 0.f) & 0xffffu);
        }
        __syncthreads();
    }
}
__device__ __forceinline__ void ph_scan() {
    const int tid = ltid(), G = lgrid(), bx = lbid();
    unsigned char* ws = WSB(); const bf16_t* ST = (const bf16_t*)(ws + WS_ST); bf16_t* HP = (bf16_t*)(ws + WS_HP); const float* DEC = (const float*)(ws + WS_DEC);
    for (int e = bx * 512 + tid; e < NB * 32 * 1024; e += G * 512) {
        const int bgh = e >> 10, pn8 = e & 1023, b = bgh >> 5, gh = bgh & 31;
        f32x4 s0 = {0.f, 0.f, 0.f, 0.f}, s1 = {0.f, 0.f, 0.f, 0.f};
#pragma unroll 4
        for (int c = 0; c < 32; ++c) { const unsigned off = (unsigned)(((b * 32 + c) * 32 + gh) * 8192 + pn8 * 8);
            f32x4 a0, a1; ld8(ST + off, a0, a1); st8(HP + off, s0, s1);
            const float d = DEC[(b * 32 + c) * 32 + gh]; s0 = s0 * d + a0; s1 = s1 * d + a1; }
    }
}
__device__ __forceinline__ void ph_attn(LAS unsigned char* lds) {
    const int G = lgrid(), bx = lbid();
    unsigned char* ws = WSB();
    const bf16_t* QN = (const bf16_t*)(ws + WS_QN); const bf16_t* QR = (const bf16_t*)(ws + WS_QR); const bf16_t* KN = (const bf16_t*)(ws + WS_KN);
    const bf16_t* KR = (const bf16_t*)(ws + WS_KR); const bf16_t* VT = (const bf16_t*)(ws + WS_VT); bf16_t* ATT = (bf16_t*)(ws + WS_ATT);
    for (int pi = bx; pi < NB * 64; pi += G) { const int b = pi >> 6, h = (pi >> 3) & 7, j = pi & 7;
#pragma unroll 1
        for (int k = 0; k < 2; ++k) attn_unit(lds, QN, QR, KN, KR, VT, ATT, b, h, k ? j : 15 - j); }
    __syncthreads();
}
__device__ __forceinline__ void ph_ssdc(LAS unsigned char* lds) {
    const int tid = ltid(), lane = tid & 63, wid = __builtin_amdgcn_readfirstlane(tid >> 6), G = lgrid(), bx = lbid();
    unsigned char* ws = WSB(); const float* DT = (const float*)(ws + WS_DT); const float* a_log = INF(16);
    LAS unsigned char* Cs = lds; LAS unsigned char* Bs = lds + 32768; LAS unsigned char* XTs = lds + 65536;
    LAS float* dts = (LAS float*)(lds + 131072); LAS float* acs = dts + 512; LAS float* rowp = acs + 512;
    const int r32 = lane & 31, hf = lane >> 5, h = wid >> 1, wl = wid & 1;
    for (int item = bx; item < NB * 32 * 8; item += G) {
        const int bl = item, g = item & 7, c = (item >> 3) & 31, b = item >> 8;
        const int trow0 = b * SEQ + c * 128;
        bf16x8 hpf[2][8];
#pragma unroll
        for (int pb = 0; pb < 2; ++pb) { const bf16_t* hp = (const bf16_t*)(ws + WS_HP) + ((size_t)bl * 4 + h) * 8192 + (unsigned)((pb * 32 + r32) * 128 + hf * 8);
#pragma unroll
            for (int ks = 0; ks < 8; ++ks) hpf[pb][ks] = *(const bf16x8*)(hp + ks * 16); }
        {
            int tid = ltid(); const int lane = tid & 63;
            const bf16_t* cc = (const bf16_t*)(ws + WS_CC) + (size_t)bl * 16384; const bf16_t* bc = (const bf16_t*)(ws + WS_BC) + (size_t)bl * 16384; const bf16_t* xt = (const bf16_t*)(ws + WS_XT) + (size_t)bl * 32768;
            {
                u32x4 v[8];
#pragma unroll
                for (int i = 0; i < 4; ++i) { v[i] = *(const u32x4*)(cc + (unsigned)((tid + 512 * i) * 8)); v[4 + i] = *(const u32x4*)(bc + (unsigned)((tid + 512 * i) * 8)); }
#pragma unroll
                for (int i = 0; i < 4; ++i) { const int p = tid + 512 * i, r = p >> 4, cp = (p & 15) ^ (r & 15);
                    *(LAS u32x4*)(Cs + r * 256 + cp * 16) = v[i]; *(LAS u32x4*)(Bs + r * 256 + cp * 16) = v[4 + i]; }
            }
            asm volatile("" ::: "memory");
            {
                u32x4 v[8];
#pragma unroll
                for (int i = 0; i < 8; ++i) v[i] = *(const u32x4*)(xt + (unsigned)((tid + 512 * i) * 8));
#pragma unroll
                for (int i = 0; i < 8; ++i) { const int p = tid + 512 * i, r = p >> 4, cp = (p & 15) ^ (r & 15); *(LAS u32x4*)(XTs + r * 256 + cp * 16) = v[i]; }
            }
            if (wid < 4) {
                const float A = -__expf(a_log[g * 4 + wid]);
                const float d0 = DT[(unsigned)((trow0 + 2 * lane) * 32 + g * 4 + wid)], d1 = DT[(unsigned)((trow0 + 2 * lane + 1) * 32 + g * 4 + wid)];
                const float x0 = d0 * A, x1 = x0 + d1 * A;
                float incl = x1;
#pragma unroll
                for (int o = 1; o < 64; o <<= 1) { const float t = __shfl_up(incl, o); if (lane >= o) incl += t; }
                const float excl = incl - x1;
                acs[wid * 128 + 2 * lane] = excl + x0; acs[wid * 128 + 2 * lane + 1] = excl + x1;
                dts[wid * 128 + 2 * lane] = d0; dts[wid * 128 + 2 * lane + 1] = d1;
            }
        }
        __syncthreads();
        f32x16 yacc[2][2];
#pragma unroll
        for (int li = 0; li < 2; ++li)
#pragma unroll
            for (int pb = 0; pb < 2; ++pb)
#pragma unroll
                for (int r = 0; r < 16; ++r) yacc[li][pb][r] = 0.f;
        const int sw = r32 & 15;
#pragma unroll
        for (int pb = 0; pb < 2; ++pb) {
#pragma unroll
            for (int li = 0; li < 2; ++li) { const int lb = li == 0 ? (wl ? 1 : 0) : (wl ? 2 : 3);
                const LAS unsigned char* crow = Cs + (lb * 32 + r32) * 256;
#pragma unroll
                for (int ks = 0; ks < 8; ++ks) yacc[li][pb] = __builtin_amdgcn_mfma_f32_32x32x16_bf16(hpf[pb][ks], *(const LAS bf16x8*)(crow + (((2 * ks + hf) ^ sw) * 16)), yacc[li][pb], 0, 0, 0);
            }
        }
        const float dsk = INF(17)[g * 4 + h];
#pragma unroll
        for (int li = 0; li < 2; ++li) {
            const int lb = li == 0 ? (wl ? 1 : 0) : (wl ? 2 : 3);
            const int l = lb * 32 + r32;
            const float al = acs[h * 128 + l];
            { const float ea = __expf(al);
#pragma unroll
              for (int pb = 0; pb < 2; ++pb)
#pragma unroll
                  for (int r = 0; r < 16; ++r) yacc[li][pb][r] *= ea; }
            const LAS unsigned char* crow = Cs + (lb * 32 + r32) * 256;
#pragma unroll 1
            for (int sb = 0; sb <= lb; ++sb) {
                f32x16 cbt;
#pragma unroll
                for (int r = 0; r < 16; ++r) cbt[r] = 0.f;
                const LAS unsigned char* brow = Bs + (sb * 32 + r32) * 256;
#pragma unroll
                for (int ks = 0; ks < 8; ++ks) cbt = __builtin_amdgcn_mfma_f32_32x32x16_bf16(*(const LAS bf16x8*)(brow + (((2 * ks + hf) ^ sw) * 16)), *(const LAS bf16x8*)(crow + (((2 * ks + hf) ^ sw) * 16)), cbt, 0, 0, 0);
                bf16x8 mt[2];
                { unsigned pk[8];
#pragma unroll
                  for (int rg = 0; rg < 4; ++rg) { const int s0 = sb * 32 + 8 * rg + 4 * hf;
                      const f32x4 as4 = *(const LAS f32x4*)(acs + h * 128 + s0), ds4 = *(const LAS f32x4*)(dts + h * 128 + s0);
                      float mv[4];
#pragma unroll
                      for (int e = 0; e < 4; ++e) { const int s = s0 + e; float val = cbt[4 * rg + e] * __expf(fminf(al - as4[e], 0.f)) * ds4[e];
                          if (s == l) val += dsk;
                          if (s > l) val = 0.f;
                          mv[e] = val; }
                      pk[2 * rg] = pk2(mv[0], mv[1]); pk[2 * rg + 1] = pk2(mv[2], mv[3]); }
                  u32x4 w0 = {pk[0], pk[1], pk[2], pk[3]}, w1 = {pk[4], pk[5], pk[6], pk[7]};
                  mt[0] = __builtin_bit_cast(bf16x8, w0); mt[1] = __builtin_bit_cast(bf16x8, w1); }
#pragma unroll
                for (int pb = 0; pb < 2; ++pb) { const LAS unsigned char* xrow = XTs + (h * 64 + pb * 32 + r32) * 256 + hf * 8;
#pragma unroll
                    for (int s2 = 0; s2 < 2; ++s2) { const int cpi = sb * 4 + s2 * 2;
                        const u32x2 lo = *(const LAS u32x2*)(xrow + ((cpi ^ sw) * 16)), hi = *(const LAS u32x2*)(xrow + (((cpi + 1) ^ sw) * 16));
                        u32x4 w = {lo.x, lo.y, hi.x, hi.y};
                        yacc[li][pb] = __builtin_amdgcn_mfma_f32_32x32x16_bf16(__builtin_bit_cast(bf16x8, w), mt[s2], yacc[li][pb], 0, 0, 0); } }
            }
        }
#pragma unroll
        for (int li = 0; li < 2; ++li) { const int lb = li == 0 ? (wl ? 1 : 0) : (wl ? 2 : 3); const int l = lb * 32 + r32;
            const bf16_t* zp = (const bf16_t*)(ws + WS_Z) + (unsigned)((trow0 + l) * 2048 + g * 256 + h * 64 + 4 * hf);
            float ssq = 0.f;
#pragma unroll
            for (int pb = 0; pb < 2; ++pb)
#pragma unroll
                for (int rg = 0; rg < 4; ++rg) { const u32x2 zw = *(const u32x2*)(zp + pb * 32 + 8 * rg); const float zz[4] = {bflo(zw.x), bfhi(zw.x), bflo(zw.y), bfhi(zw.y)};
#pragma unroll
                    for (int e = 0; e < 4; ++e) { const float v = yacc[li][pb][4 * rg + e] * silu(zz[e]); yacc[li][pb][4 * rg + e] = v; ssq += v * v; } }
            ssq += __shfl_xor(ssq, 32);
            if (hf == 0) rowp[h * 128 + l] = ssq; }
        __syncthreads();
#pragma unroll
        for (int li = 0; li < 2; ++li) { const int lb = li == 0 ? (wl ? 1 : 0) : (wl ? 2 : 3); const int l = lb * 32 + r32;
            const float rs = rsqrtf((rowp[l] + rowp[128 + l] + rowp[256 + l] + rowp[384 + l]) * (1.f / 256.f) + EPS);
            bf16_t* op = (bf16_t*)(ws + WS_SSM) + (unsigned)((trow0 + l) * 2048 + g * 256 + h * 64 + 4 * hf); const float* gp = INF(18) + g * 256 + h * 64 + 4 * hf;
#pragma unroll
            for (int pb = 0; pb < 2; ++pb)
#pragma unroll
                for (int rg = 0; rg < 4; ++rg) { const f32x4 gs = *(const f32x4*)(gp + pb * 32 + 8 * rg);
                    u32x2 w; w.x = pk2(yacc[li][pb][4 * rg] * rs * gs[0], yacc[li][pb][4 * rg + 1] * rs * gs[1]); w.y = pk2(yacc[li][pb][4 * rg + 2] * rs * gs[2], yacc[li][pb][4 * rg + 3] * rs * gs[3]);
                    *(u32x2*)(op + pb * 32 + 8 * rg) = w; } }
    }
    __syncthreads();
}
__device__ __forceinline__ void ph_merge_a(LAS unsigned char* lds) {
    unsigned char* ws = WSB(); const int G = lgrid(), bx = lbid();
    pg8::Gemm g{(const bf16_t*)(ws + WS_ATT), (const bf16_t*)(ws + WS_WOA), TG, 1024, 1024}; pg8::StaticOrder S; S.init(TG, 1024, G, bx);
    EpiGate<0> E{(bf16_t*)(ws + WS_MA), (const bf16_t*)(ws + WS_SGA), nullptr};
    pg8::gemm_phase<EpiGate<0>, pg8::StaticOrder, true, true>(lds, g, S, E);
    asm volatile("s_waitcnt vmcnt(0)" ::: "memory");
}
__device__ __forceinline__ void ph_merge_b(LAS unsigned char* lds) {
    unsigned char* ws = WSB(); const int G = lgrid(), bx = lbid();
    pg8::Gemm g{(const bf16_t*)(ws + WS_SSM), (const bf16_t*)(ws + WS_WOB), TG, 1024, 2048}; pg8::StaticOrder S; S.init(TG, 1024, G, bx);
    EpiGate<1> E{(bf16_t*)(ws + WS_MERGED), (const bf16_t*)(ws + WS_SGB), (const bf16_t*)(ws + WS_MA)};
    pg8::gemm_phase<EpiGate<1>, pg8::StaticOrder, true, true>(lds, g, S, E);
}
__device__ __forceinline__ void ph_mix(LAS unsigned char* lds, int tbase) {
    unsigned char* ws = WSB(); const int G = lgrid(), bx = lbid();
    pg8::Gemm g{(const bf16_t*)(ws + WS_MERGED), (const bf16_t*)(ws + WS_WOUT), TG, 1024, 1024}; pg8::StaticOrder S; S.init(TG, 1024, G, bx);
    EpiSsq E{(bf16_t*)(ws + WS_MIX), 1024, (float*)(ws + WS_SSQ) + SQ_MIX, tbase};
    pg8::gemm_phase<EpiSsq, pg8::StaticOrder, true, true>(lds, g, S, E);
}
__device__ __forceinline__ void ph_x1rows(int tbase) {
    const int tid = ltid(), lane = tid & 63, wid = __builtin_amdgcn_readfirstlane(tid >> 6), G = lgrid(), bx = lbid();
    const int gw = bx * 8 + wid, NGW = G * 8;
    unsigned char* ws = WSB(); const float* SSQ_MIX = (const float*)(ws + WS_SSQ) + SQ_MIX; const float* MOD = (const float*)(ws + WS_MOD);
    const bf16_t* MIX = (const bf16_t*)(ws + WS_MIX); bf16_t* H = (bf16_t*)(ws + WS_H);
    const float* x = INF(0); const float* g_post_mix = INF(6); const float* g_pre_mlp = INF(21); float* out = OUTP();
    for (int m = gw; m < TG; m += NGW) { const int t = tbase + m, b = t >> 12;
        float sv = lane < 16 ? SSQ_MIX[lane * TT + t] : 0.f; sv += __shfl_xor(sv, 1); sv += __shfl_xor(sv, 2); sv += __shfl_xor(sv, 4); sv += __shfl_xor(sv, 8); sv = __shfl(sv, 0);
        const float rs1 = rsqrtf(sv * (1.f / 1024.f) + EPS); const float* mod = MOD + b * 6144;
        f32x4 v[4]; float s = 0.f;
#pragma unroll
        for (int j = 0; j < 4; ++j) { const int c0 = 4 * lane + 256 * j; const u32x2 w = *(const u32x2*)(MIX + (size_t)m * 1024 + c0);
            const f32x4 f = {bflo(w.x), bfhi(w.x), bflo(w.y), bfhi(w.y)}; const f32x4 g = *(const f32x4*)(g_post_mix + c0), ga = *(const f32x4*)(mod + 2048 + c0);
            v[j] = *(const f32x4*)(x + (size_t)t * 1024 + c0) + ga * (f * rs1 * g); *(f32x4*)(out + (size_t)t * 1024 + c0) = v[j]; s += dot4(v[j]); }
        const float rs2 = rsqrtf(wave_sum(s) * (1.f / 1024.f) + EPS);
#pragma unroll
        for (int j = 0; j < 4; ++j) { const int c0 = 4 * lane + 256 * j; const f32x4 g = *(const f32x4*)(g_pre_mlp + c0), sc = *(const f32x4*)(mod + 4096 + c0), sh = *(const f32x4*)(mod + 3072 + c0);
            const f32x4 hv = v[j] * rs2 * g * (sc + 1.f) + sh; u32x2 w; w.x = pk2(hv[0], hv[1]); w.y = pk2(hv[2], hv[3]); *(u32x2*)(H + (size_t)m * 1024 + c0) = w; } }
}
__device__ __forceinline__ void ph_ff1(LAS unsigned char* lds) {
    unsigned char* ws = WSB(); const int G = lgrid(), bx = lbid();
    pg8::Gemm g{(const bf16_t*)(ws + WS_H), (const bf16_t*)(ws + WS_WFF1), TG, 4096, 1024}; pg8::StaticOrder S; S.init(TG, 4096, G, bx);
    EpiRelu2 E{(bf16_t*)(ws + WS_FF1), 4096};
    pg8::gemm_phase<EpiRelu2, pg8::StaticOrder, true, true>(lds, g, S, E);
}
__device__ __forceinline__ void ph_ff2(LAS unsigned char* lds, int tbase) {
    unsigned char* ws = WSB(); const int G = lgrid(), bx = lbid();
    pg8::Gemm g{(const bf16_t*)(ws + WS_FF1), (const bf16_t*)(ws + WS_WFF2), TG, 1024, 4096}; pg8::StaticOrder S; S.init(TG, 1024, G, bx);
    EpiSsq E{(bf16_t*)(ws + WS_FF), 1024, (float*)(ws + WS_SSQ) + SQ_FF, tbase};
    pg8::gemm_phase<EpiSsq, pg8::StaticOrder, true, true>(lds, g, S, E);
}

__global__ void __launch_bounds__(512, 2) mega(Args a) {
    extern __shared__ __attribute__((aligned(16))) unsigned char lds_raw[];
    LAS unsigned char* lds = (LAS unsigned char*)lds_raw;
    cg::grid_group grid = cg::this_grid();
    volatile LAS unsigned* bst = (volatile LAS unsigned*)(lds + LDS_BYTES - 64);
    if (threadIdx.x < 2) bst[threadIdx.x] = 0u;
    __syncthreads();
    XcdBarrier xbar = xcd_barrier_post((unsigned*)a.ws, bst);
#ifndef NO_MOD
    ph_mod(lds);
#endif
#ifndef NO_WCP
    ph_wcopy(lds);
#endif
    ph_rope_zero();
    if (DUP_P0) { ph_mod(lds); ph_wcopy(lds); ph_rope_zero(); }
    grid.sync();
#pragma unroll 1
    for (int rd = 0; rd < NROUND; ++rd) {
        const int tbase = rd * TG;
        if (rd > 0) ph_final_rows(tbase - TG);
        ph_hrows(tbase);
        if (DUP_ROWS) ph_hrows(tbase);
        GSYNC();
#ifndef NO_GB
        ph_proj(lds, tbase);
#endif
        GSYNC();
#ifndef NO_GC
        ph_upq(lds, tbase); ph_upk(lds, tbase); ph_upv(lds, tbase);
#endif
#ifndef NO_CONV
        ph_conv(lds);
        if (DUP_CONV) ph_conv(lds);
#endif
        GSYNC();
#ifndef NO_PD
        ph_states(lds);
        if (DUP_SS) ph_states(lds);
#endif
        GSYNC();
        ph_scan();
        if (DUP_SS) ph_scan();
        GSYNC();
#ifndef NO_ATT
        ph_attn(lds);
        if (DUP_ATT) ph_attn(lds);
#endif
#ifndef NO_SSDC
        ph_ssdc(lds);
        if (DUP_SSDC) ph_ssdc(lds);
#endif
        GSYNC();
#ifndef NO_GG
        ph_merge_a(lds); ph_merge_b(lds);
#endif
        GSYNC();
#ifndef NO_GH
        ph_mix(lds, tbase);
#endif
        GSYNC();
        ph_x1rows(tbase);
        if (DUP_ROWS) ph_x1rows(tbase);
        GSYNC();
#ifndef NO_GJ
        ph_ff1(lds);
#endif
        GSYNC();
#ifndef NO_GK
        ph_ff2(lds, tbase);
#endif
        GSYNC();
    }
    ph_final_rows(TT - TG);
}


extern "C" void kernel_launch(void* const* d_in, const int* in_sizes, int n_in, void* d_out, int out_size, void* d_ws, size_t ws_size, hipStream_t stream) {
    static int grid = 0;
    if (grid == 0) {
        if (n_in != 25 || out_size != TT * DM || ws_size < WS_END) { fprintf(stderr, "kernel_launch: unexpected problem (n_in %d out %d ws %zu)\n", n_in, out_size, ws_size); grid = -1; return; }
        int dev = 0, cus = 0, per_cu = 0;
        hipGetDevice(&dev); hipDeviceGetAttribute(&cus, hipDeviceAttributeMultiprocessorCount, dev);
        hipFuncSetAttribute((const void*)mega, hipFuncAttributeMaxDynamicSharedMemorySize, LDS_BYTES);
        hipOccupancyMaxActiveBlocksPerMultiprocessor(&per_cu, (const void*)mega, 512, LDS_BYTES);
        (void)hipGetLastError();
        if (per_cu < 1) per_cu = 1;
        grid = cus;
    }
    if (grid < 0) return;
    if (hipMemsetAsync(d_ws, 0, 65536, stream) != hipSuccess) { fprintf(stderr, "memset failed\n"); return; }
    Args a{};
    for (int i = 0; i < 25; ++i) a.in[i] = d_in[i];
    a.out = (float*)d_out; a.ws = (unsigned char*)d_ws;
    void* args[] = {&a};
    hipError_t e = hipLaunchCooperativeKernel((const void*)mega, dim3(grid), dim3(512), args, LDS_BYTES, stream);
    if (e != hipSuccess) fprintf(stderr, "cooperative launch failed: %s (grid %d)\n", hipGetErrorString(e), grid);
}
```

```cpp
#include <hip/hip_runtime.h>
#include <hip/hip_cooperative_groups.h>
#include <cstdio>
#include <cstdint>
namespace cg = cooperative_groups;
#ifndef DUP_ATT
#define DUP_ATT 0
#endif
#ifndef DUP_P0
#define DUP_P0 0
#endif
#ifndef DUP_SS
#define DUP_SS 0
#endif
#ifndef DUP_ROWS
#define DUP_ROWS 0
#endif
#ifndef DUP_SYNC
#define DUP_SYNC 0
#endif
#ifndef DUP_CONV
#define DUP_CONV 0
#endif
#ifndef DUP_SSDC
#define DUP_SSDC 0
#endif
#define GSYNC() do { xcd_barrier(xbar); if (DUP_SYNC) xcd_barrier(xbar); } while (0)

#define LAS __attribute__((address_space(3)))
typedef unsigned short bf16_t;
typedef short bf16x8 __attribute__((ext_vector_type(8)));
typedef float f32x4 __attribute__((ext_vector_type(4)));
typedef float f32x2 __attribute__((ext_vector_type(2)));
typedef float f32x16 __attribute__((ext_vector_type(16)));
typedef unsigned u32x4 __attribute__((ext_vector_type(4)));
typedef unsigned u32x2 __attribute__((ext_vector_type(2)));

__device__ __forceinline__ int ltid() { int t = threadIdx.x; asm volatile("" : "+v"(t)); return t; }
__device__ __forceinline__ int lbid() { int b = blockIdx.x; asm volatile("" : "+s"(b)); return b; }
__device__ __forceinline__ int lgrid() { int g = gridDim.x; asm volatile("" : "+s"(g)); return g; }

namespace pg8 {
#define PG8_LAS __attribute__((address_space(3)))
constexpr int BM = 256, BK = 64, HALF = 128, HTB = HALF * BK * 2, STAGE_BYTES = 8 * HTB, NXCD = 8, WGM = 8;
__host__ __device__ __forceinline__ int lds_byte(int r, int c) { const int st = (r >> 4) * 2 + (c >> 5), rr = r & 15, cc = c & 31, ob = rr * 64 + cc * 2; return st * 1024 + (ob ^ (((ob >> 9) & 1) << 5)); }
__host__ __device__ __forceinline__ void stage_rc(int b, int& R, int& C) { const int st = b / 1024, sb = b % 1024, swz = sb ^ (((sb >> 9) & 1) << 5); R = (st >> 1) * 16 + swz / 64; C = (st & 1) * 32 + (swz % 64) / 2; }
__host__ __device__ __forceinline__ int perm32(int rho) { const int n = rho >> 4, i = rho & 15; return 8 * (i >> 2) + 4 * n + (i & 3); }
struct Unit { int pm, pn; };
struct Gemm { const bf16_t* A; const bf16_t* Bt; int M, N, K; };
struct StaticOrder {
    int nM, nN, nwg, G, c;
    __host__ __device__ void init(int M, int N, int G_, int c_) { nM = M / BM; nN = N / BM; nwg = nM * nN; G = G_; c = c_; }
    __host__ __device__ bool next(int i, Unit& u) const {
        const long L = (long)i * G + c; if (L >= nwg) return false;
        int wgid = (int)L; { const int q = nwg / NXCD, r = nwg % NXCD, xcd = wgid % NXCD, off = wgid / NXCD; wgid = (xcd < r ? xcd * (q + 1) : r * (q + 1) + (xcd - r) * q) + off; }
        const int nig = WGM * nN, gid = wgid / nig, fm = gid * WGM, gsz = (nM - fm) < WGM ? (nM - fm) : WGM;
        u.pm = fm + ((wgid % nig) % gsz); u.pn = (wgid % nig) / gsz; return true;
    }
    __device__ __forceinline__ void a_ready(const Unit&) const {}
    __device__ __forceinline__ void done(const Unit&) const {}
};
__device__ __forceinline__ unsigned cvt_pk_bf16(float lo, float hi) { unsigned r; asm volatile("v_cvt_pk_bf16_f32 %0, %1, %2" : "=v"(r) : "v"(lo), "v"(hi)); return r; }

template <class Epi, class Sched, bool ALIGN_EPI = false, bool SP2 = false>
__device__ __forceinline__ void gemm_phase(PG8_LAS unsigned char* lds, const Gemm g, const Sched& S, const Epi& E) {
    const int tid = ltid(), wid = __builtin_amdgcn_readfirstlane(tid >> 6), lane = tid & 63, wr = wid >> 2, wc = wid & 3, fr = lane & 15, fq = lane >> 4;
    const int K = g.K, nt = K / BK;
    unsigned voffA[2], voffB[2];
#pragma unroll
    for (int i = 0; i < 2; ++i) { int R, C; stage_rc(tid * 16 + i * 8192, R, C); const int Rb = Epi::PERM ? ((R & ~31) + perm32(R & 31)) : R;
        voffA[i] = (unsigned)(R * K + C) * 2u; voffB[i] = (unsigned)(Rb * K + C) * 2u; }
    const size_t kstep = (size_t)(BK * 2);
    const size_t hstep = (size_t)HALF * K * 2;
    const size_t tstep = 2 * hstep;
    const unsigned ldsw = (unsigned)wid * 1024u;
    const int aoff = lds_byte(wr * 64 + fr, fq * 8), boff = lds_byte(wc * 32 + fr, fq * 8);
#define PG8_SA(b, h) (((b) * 2 + (h)) * HTB)
#define PG8_SB(b, h) ((4 + (b) * 2 + (h)) * HTB)
#define PG8_STAGE(bufoff, gbase, voff) do { _Pragma("unroll") for (int _i = 0; _i < 2; ++_i) \
        __builtin_amdgcn_global_load_lds((const unsigned*)((const char*)(gbase) + (voff)[_i]), (PG8_LAS unsigned*)(lds + (bufoff) + ldsw + _i * 8192), 16, 0, 0); } while (0)
#define PG8_LDA(dst, b, h) do { _Pragma("unroll") for (int m = 0; m < 4; ++m) _Pragma("unroll") for (int k = 0; k < 2; ++k) dst[m][k] = *(const PG8_LAS bf16x8*)(lds + PG8_SA(b, h) + aoff + m * 2048 + k * 1024); } while (0)
#define PG8_LDB(dst, b, h) do { _Pragma("unroll") for (int n = 0; n < 2; ++n) _Pragma("unroll") for (int k = 0; k < 2; ++k) dst[n][k] = *(const PG8_LAS bf16x8*)(lds + PG8_SB(b, h) + boff + n * 2048 + k * 1024); } while (0)
#define PG8_MMA(ai, bj, At, Bt) do { __builtin_amdgcn_s_setprio(1); _Pragma("unroll") for (int m = 0; m < 4; ++m) _Pragma("unroll") for (int n = 0; n < 2; ++n) _Pragma("unroll") for (int k = 0; k < 2; ++k) \
        acc[ai][bj][m][n] = __builtin_amdgcn_mfma_f32_16x16x32_bf16(Bt[n][k], At[m][k], acc[ai][bj][m][n], 0, 0, 0); __builtin_amdgcn_s_setprio(0); } while (0)
#define PG8_WAIT_V(n) asm volatile("s_waitcnt vmcnt(" #n ")" ::: "memory")
#define PG8_WAIT_L(n) asm volatile("s_waitcnt lgkmcnt(" #n ")" ::: "memory")
#define PG8_BAR __builtin_amdgcn_s_barrier()
#define PG8_SCHED __builtin_amdgcn_sched_barrier(0)
    Unit cur, nxt; int ui = 0;
    if (!S.next(0, cur)) return;
    f32x4 acc[2][2][4][2];
#pragma unroll
    for (int a = 0; a < 2; ++a)
#pragma unroll
        for (int b = 0; b < 2; ++b)
#pragma unroll
            for (int m = 0; m < 4; ++m)
#pragma unroll
                for (int n = 0; n < 2; ++n) acc[a][b][m][n] = (f32x4){0.f, 0.f, 0.f, 0.f};
    bf16x8 At[4][2], B0[2][2], B1[2][2];
    const char* cA = (const char*)g.A + (size_t)cur.pm * tstep; const char* cB = (const char*)g.Bt + (size_t)cur.pn * tstep;
    S.a_ready(cur);
    if constexpr (SP2) {
        PG8_STAGE(PG8_SB(0, 0), cB, voffB); PG8_STAGE(PG8_SB(0, 1), cB + hstep, voffB); PG8_STAGE(PG8_SA(0, 0), cA, voffA); PG8_STAGE(PG8_SA(0, 1), cA + hstep, voffA);
        if (wr == 1) PG8_BAR;
        PG8_WAIT_V(2); PG8_BAR;
        PG8_STAGE(PG8_SB(1, 0), cB + kstep, voffB); PG8_STAGE(PG8_SA(1, 0), cA + kstep, voffA); PG8_STAGE(PG8_SB(1, 1), cB + hstep + kstep, voffB);
        PG8_WAIT_V(6); PG8_BAR;
    } else {
        PG8_STAGE(PG8_SB(0, 0), cB, voffB); PG8_STAGE(PG8_SA(0, 0), cA, voffA); PG8_STAGE(PG8_SB(0, 1), cB + hstep, voffB); PG8_STAGE(PG8_SA(0, 1), cA + hstep, voffA);
        if (wr == 1) PG8_BAR;
        PG8_WAIT_V(4); PG8_BAR;
        PG8_STAGE(PG8_SB(1, 0), cB + kstep, voffB); PG8_STAGE(PG8_SA(1, 0), cA + kstep, voffA); PG8_STAGE(PG8_SB(1, 1), cB + hstep + kstep, voffB);
        PG8_WAIT_V(6); PG8_BAR;
    }
    for (;;) {
        const bool has_next = S.next(ui + 1, nxt);
        const char* nA = has_next ? (const char*)g.A + (size_t)nxt.pm * tstep : cA; const char* nB = has_next ? (const char*)g.Bt + (size_t)nxt.pn * tstep : cB;
#pragma unroll 1
        for (int t = 0; t < nt; t += 2) {
            const bool last = (t == nt - 2);
            const char* a1 = cA + (size_t)(t + 1) * kstep;
            const char* a2 = last ? nA : cA + (size_t)(t + 2) * kstep; const char* b2 = last ? nB : cB + (size_t)(t + 2) * kstep;
            const char* a3 = a2 + kstep; const char* b3 = b2 + kstep;
            if (last && has_next) S.a_ready(nxt);
            if constexpr (SP2) {
            PG8_LDB(B0, 0, 0); PG8_LDB(B1, 0, 1); PG8_SCHED; PG8_LDA(At, 0, 0); PG8_STAGE(PG8_SA(1, 1), a1 + hstep, voffA);
            PG8_WAIT_V(8); PG8_WAIT_L(0); PG8_BAR; PG8_MMA(0, 0, At, B0); PG8_MMA(0, 1, At, B1); PG8_BAR; PG8_SCHED;
            PG8_LDA(At, 0, 1); PG8_STAGE(PG8_SB(0, 0), b2, voffB); PG8_STAGE(PG8_SB(0, 1), b2 + hstep, voffB); PG8_STAGE(PG8_SA(0, 0), a2, voffA);
            PG8_WAIT_V(8); PG8_WAIT_L(0); PG8_BAR; PG8_MMA(1, 0, At, B0); PG8_MMA(1, 1, At, B1); PG8_BAR; PG8_SCHED;
            PG8_LDB(B0, 1, 0); PG8_LDB(B1, 1, 1); PG8_SCHED; PG8_LDA(At, 1, 0); PG8_STAGE(PG8_SA(0, 1), a2 + hstep, voffA);
            PG8_WAIT_V(8); PG8_WAIT_L(0); PG8_BAR; PG8_MMA(0, 0, At, B0); PG8_MMA(0, 1, At, B1); PG8_BAR; PG8_SCHED;
            PG8_LDA(At, 1, 1); PG8_STAGE(PG8_SB(1, 0), b3, voffB); PG8_STAGE(PG8_SB(1, 1), b3 + hstep, voffB); PG8_STAGE(PG8_SA(1, 0), a3, voffA);
            PG8_WAIT_V(8); PG8_WAIT_L(0); PG8_BAR; PG8_MMA(1, 0, At, B0); PG8_MMA(1, 1, At, B1); PG8_BAR; PG8_SCHED;
            } else {
            PG8_LDB(B0, 0, 0); PG8_SCHED; PG8_LDA(At, 0, 0); PG8_STAGE(PG8_SA(1, 1), a1 + hstep, voffA);
            PG8_WAIT_L(8); PG8_BAR; PG8_WAIT_L(0); PG8_MMA(0, 0, At, B0); PG8_BAR; PG8_SCHED;
            PG8_LDB(B1, 0, 1); PG8_STAGE(PG8_SB(0, 0), b2, voffB);
            PG8_BAR; PG8_WAIT_L(0); PG8_MMA(0, 1, At, B1); PG8_BAR;
            PG8_LDA(At, 0, 1); PG8_STAGE(PG8_SA(0, 0), a2, voffA);
            PG8_BAR; PG8_WAIT_L(0); PG8_MMA(1, 0, At, B0); PG8_BAR; PG8_SCHED;
            PG8_STAGE(PG8_SB(0, 1), b2 + hstep, voffB);
            PG8_WAIT_V(6); PG8_BAR; PG8_MMA(1, 1, At, B1); PG8_BAR;
            PG8_LDB(B0, 1, 0); PG8_SCHED; PG8_LDA(At, 1, 0); PG8_STAGE(PG8_SA(0, 1), a2 + hstep, voffA);
            PG8_WAIT_L(8); PG8_BAR; PG8_WAIT_L(0); PG8_MMA(0, 0, At, B0); PG8_BAR; PG8_SCHED;
            PG8_LDB(B1, 1, 1); PG8_STAGE(PG8_SB(1, 0), b3, voffB);
            PG8_BAR; PG8_WAIT_L(0); PG8_MMA(0, 1, At, B1); PG8_BAR;
            PG8_LDA(At, 1, 1); PG8_STAGE(PG8_SA(1, 0), a3, voffA);
            PG8_BAR; PG8_WAIT_L(0); PG8_MMA(1, 0, At, B0); PG8_BAR; PG8_SCHED;
            PG8_STAGE(PG8_SB(1, 1), b3 + hstep, voffB);
            PG8_WAIT_V(6); PG8_BAR; PG8_MMA(1, 1, At, B1); PG8_BAR;
            }
        }
        if constexpr (ALIGN_EPI) { if (wr == 0) PG8_BAR; }
        if constexpr (!Epi::AFTER_DRAIN) { PG8_SCHED; int fr_l = fr, fq_l = fq; asm volatile("" : "+v"(fr_l), "+v"(fq_l) :: "memory"); E(acc, cur, wr, wc, fr_l, fq_l); asm volatile("" ::: "memory"); PG8_SCHED; S.done(cur); }
        if (!has_next) break;
#pragma unroll
        for (int a = 0; a < 2; ++a)
#pragma unroll
            for (int b = 0; b < 2; ++b)
#pragma unroll
                for (int m = 0; m < 4; ++m)
#pragma unroll
                    for (int n = 0; n < 2; ++n) acc[a][b][m][n] = (f32x4){0.f, 0.f, 0.f, 0.f};
        cur = nxt; cA = nA; cB = nB; ++ui;
        if constexpr (ALIGN_EPI) { if (wr == 1) PG8_BAR; }
    }
    PG8_WAIT_V(0);
    if constexpr (!ALIGN_EPI) { if (wr == 0) PG8_BAR; }
    PG8_BAR;
#undef PG8_SA
#undef PG8_SB
#undef PG8_STAGE
#undef PG8_LDA
#undef PG8_LDB
#undef PG8_MMA
#undef PG8_WAIT_V
#undef PG8_WAIT_L
#undef PG8_BAR
#undef PG8_SCHED
}
}

constexpr int BATCH = 16, SEQ = 4096, DM = 1024, TT = BATCH * SEQ;
constexpr int NB = 4, TG = NB * SEQ, NROUND = BATCH / NB;
constexpr int NPROJ = 8960;
constexpr float EPS = 1e-6f;
constexpr int LDS_BYTES = 147456;
constexpr size_t MiB = 1u << 20;
constexpr size_t WS_MOD = 1 * MiB, WS_WIN = 2 * MiB, WS_WUQ = 20 * MiB, WS_WUKN = 21 * MiB, WS_WUV = 22 * MiB, WS_WOA = 23 * MiB, WS_WOB = 25 * MiB,
                 WS_WOUT = 29 * MiB, WS_WFF1 = 31 * MiB, WS_WFF2 = 39 * MiB, WS_ROPE = 48 * MiB, WS_DEC = 65 * MiB;
constexpr size_t WS_H = 66 * MiB, WS_QL = 98 * MiB, WS_KVL = 106 * MiB, WS_KR = 114 * MiB, WS_DT = 116 * MiB, WS_Z = 118 * MiB, WS_XBC = 182 * MiB,
                 WS_SGA = 310 * MiB, WS_SGB = 342 * MiB, WS_QN = 374 * MiB, WS_QR = 406 * MiB, WS_KN = 422 * MiB, WS_VT = 454 * MiB, WS_CC = 486 * MiB,
                 WS_BC = 518 * MiB, WS_BT = 550 * MiB, WS_XT = 582 * MiB, WS_ATT = 646 * MiB, WS_ST = 678 * MiB, WS_HP = 806 * MiB, WS_SSM = 870 * MiB,
                 WS_SSQ = 934 * MiB, WS_END = 944 * MiB;
constexpr int SQ_Q = 0, SQ_KV = 4 * TT, SQ_MIX = 8 * TT, SQ_FF = 24 * TT;
constexpr size_t WS_FF1 = WS_XBC, WS_MA = WS_QN, WS_MERGED = WS_KN, WS_MIX = WS_VT, WS_FF = WS_ATT;

__device__ const double ROPE_INV[32] = {1.0, 0.7498942093324559, 0.5623413251903491, 0.4216965034285822, 0.31622776601683794, 0.23713737056616552, 0.1778279410038923, 0.1333521432163324, 0.1, 0.07498942093324558, 0.05623413251903491, 0.042169650342858224, 0.03162277660168379, 0.023713737056616554, 0.01778279410038923, 0.01333521432163324, 0.01, 0.007498942093324558, 0.005623413251903491, 0.004216965034285823, 0.0031622776601683794, 0.0023713737056616554, 0.0017782794100389228, 0.001333521432163324, 0.001, 0.0007498942093324559, 0.0005623413251903491, 0.00042169650342858224, 0.00031622776601683794, 0.00023713737056616554, 0.00017782794100389227, 0.0001333521432163324};

typedef __bf16 bf16x2_t __attribute__((ext_vector_type(2)));
__device__ __forceinline__ unsigned pk2(float lo, float hi) { const f32x2 v = {lo, hi}; const bf16x2_t b = __builtin_convertvector(v, bf16x2_t); return __builtin_bit_cast(unsigned, b); }
__device__ __forceinline__ float bflo(unsigned w) { return __builtin_bit_cast(float, w << 16); }
__device__ __forceinline__ float bfhi(unsigned w) { return __builtin_bit_cast(float, w & 0xffff0000u); }
__device__ __forceinline__ float wave_sum(float v) {
#pragma unroll
    for (int o = 1; o < 64; o <<= 1) v += __shfl_xor(v, o);
    return v;
}
__device__ __forceinline__ void st8(bf16_t* p, f32x4 a, f32x4 b) { u32x4 w; w.x = pk2(a[0], a[1]); w.y = pk2(a[2], a[3]); w.z = pk2(b[0], b[1]); w.w = pk2(b[2], b[3]); *(u32x4*)p = w; }
__device__ __forceinline__ void ld8(const bf16_t* p, f32x4& a, f32x4& b) { const u32x4 w = *(const u32x4*)p; a[0] = bflo(w.x); a[1] = bfhi(w.x); a[2] = bflo(w.y); a[3] = bfhi(w.y); b[0] = bflo(w.z); b[1] = bfhi(w.z); b[2] = bflo(w.w); b[3] = bfhi(w.w); }
__device__ __forceinline__ float sigm(float x) { return __builtin_amdgcn_rcpf(1.f + __builtin_amdgcn_exp2f(-1.4426950408889634f * x)); }
__device__ __forceinline__ float silu(float x) { return x * __builtin_amdgcn_rcpf(1.f + __builtin_amdgcn_exp2f(-1.4426950408889634f * x)); }
__device__ __forceinline__ float softplus(float x) {
    const float e = __expf(-fabsf(x));
    const float l = e < 0.03125f ? e * (1.f - e * (0.5f - e * (0.33333334f - 0.25f * e))) : __logf(1.f + e);
    return fmaxf(x, 0.f) + l;
}
__device__ __forceinline__ float bf2f_lds(const LAS unsigned char* p) { return __builtin_bit_cast(float, (unsigned)(*(const LAS unsigned short*)p) << 16); }
__device__ __forceinline__ float dot4(f32x4 a) { return (a[0] * a[0] + a[1] * a[1]) + (a[2] * a[2] + a[3] * a[3]); }
#define LDS_WAIT() asm volatile("s_waitcnt lgkmcnt(0)" ::: "memory")

__device__ __forceinline__ int srcmap(int map, int r) {
    if (map == 0) return r;
    if (map == 1) {
        if (r < 512) return r;
        if (r < 6656) return r + 64;
        if (r < 8704) return r + 96;
        if (r < 8768) { const int j = r - 8704, g8 = j >> 3, e = j & 7; return 512 + (e < 4 ? 4 * g8 + e : 32 + 4 * g8 + (e - 4)); }
        if (r < 8800) return 6720 + (r - 8768);
        return -1;
    }
    if (map == 2) {
        if (r < 1024) return (r >> 7) * 192 + (r & 127);
        const int rr = r - 1024, h = rr >> 6, j = rr & 63, g8 = j >> 3, e = j & 7;
        return h * 192 + 128 + (e < 4 ? 4 * g8 + e : 32 + 4 * g8 + (e - 4));
    }
    if (map == 3) return (r >> 7) * 256 + (r & 127);
    return (r >> 7) * 256 + 128 + (r & 127);
}
__device__ __forceinline__ void transpose_item(const float* W, int K, int N, bf16_t* WT, int map, const float* ks, int nblk, LAS float* scr, int item, int lane) {
    const int kb = item / nblk, nb = item % nblk, k0 = 64 * kb, n0 = 32 * nb;
    const int src = srcmap(map, n0 + (lane & 31));
#pragma unroll 8
    for (int i = 0; i < 32; ++i) { const int kk = 2 * i + (lane >> 5); float v = src >= 0 ? W[(size_t)(k0 + kk) * N + src] : 0.f; if (ks) v *= ks[k0 + kk]; scr[kk * 33 + (lane & 31)] = v; }
    LDS_WAIT(); asm volatile("" ::: "memory");
    const int c = lane & 7;
#pragma unroll
    for (int j = 0; j < 4; ++j) { const int n = (lane >> 3) + 8 * j; const LAS float* s = scr + (8 * c) * 33 + n;
        u32x4 o; o.x = pk2(s[0 * 33], s[1 * 33]); o.y = pk2(s[2 * 33], s[3 * 33]); o.z = pk2(s[4 * 33], s[5 * 33]); o.w = pk2(s[6 * 33], s[7 * 33]);
        *(u32x4*)(WT + (size_t)(n0 + n) * K + k0 + 8 * c) = o; }
    LDS_WAIT(); asm volatile("" ::: "memory");
}

#define ACC_T const f32x4 (&acc)[2][2][4][2]
struct EpiProj {
    static constexpr bool PERM = true, AFTER_DRAIN = false;
    bf16_t *QL, *KVL, *KR, *Z, *XBC, *SGA, *SGB; float* DT; float *ssq_q, *ssq_kv; const float* rope; const float* dt_bias; int tbase;
    __device__ __forceinline__ void operator()(ACC_T, const pg8::Unit& u, int wr, int wc, int fr, int fq) const {
        const int pn = u.pn, row0 = u.pm * 256 + wr * 64 + fr, cw = wc * 32 + 8 * fq;
        if (pn < 2) {
            bf16_t* O = pn == 0 ? QL : KVL; float* sq = (pn == 0 ? ssq_q : ssq_kv) + wc * TT + tbase;
#pragma unroll
            for (int ai = 0; ai < 2; ++ai)
#pragma unroll
                for (int m = 0; m < 4; ++m) { const int row = row0 + ai * 128 + m * 16; float s = 0.f;
#pragma unroll
                    for (int bj = 0; bj < 2; ++bj) { const f32x4 v0 = acc[ai][bj][m][0], v1 = acc[ai][bj][m][1]; st8(O + (unsigned)row * 256u + cw + bj * 128, v0, v1); s += dot4(v0) + dot4(v1); }
                    s += __shfl_xor(s, 16); s += __shfl_xor(s, 32);
                    if (fq == 0) sq[row] = s; }
        } else if (pn < 26) {
            bf16_t* O; int ld, c0; if (pn < 10) { O = Z; ld = 2048; c0 = (pn - 2) * 256; } else { O = XBC; ld = 4096; c0 = (pn - 10) * 256; }
#pragma unroll
            for (int ai = 0; ai < 2; ++ai)
#pragma unroll
                for (int m = 0; m < 4; ++m) { const int row = row0 + ai * 128 + m * 16;
#pragma unroll
                    for (int bj = 0; bj < 2; ++bj) st8(O + (unsigned)row * (unsigned)ld + c0 + cw + bj * 128, acc[ai][bj][m][0], acc[ai][bj][m][1]); }
        } else if (pn < 34) {
            bf16_t* O = pn < 30 ? SGA : SGB; const int c0 = ((pn - 26) & 3) * 256;
#pragma unroll
            for (int ai = 0; ai < 2; ++ai)
#pragma unroll
                for (int m = 0; m < 4; ++m) { const int row = row0 + ai * 128 + m * 16;
#pragma unroll
                    for (int bj = 0; bj < 2; ++bj) { f32x4 v0 = acc[ai][bj][m][0], v1 = acc[ai][bj][m][1];
#pragma unroll
                        for (int e = 0; e < 4; ++e) { v0[e] = sigm(v0[e]); v1[e] = sigm(v1[e]); }
                        st8(O + (unsigned)row * 1024u + c0 + cw + bj * 128, v0, v1); }
                    asm volatile("" ::: "memory"); }
        } else {
            if (wc < 2) {
                const int g8 = wc * 4 + fq;
#pragma unroll
                for (int ai = 0; ai < 2; ++ai)
#pragma unroll
                    for (int m = 0; m < 4; ++m) { const int row = row0 + ai * 128 + m * 16; const f32x4 v0 = acc[ai][0][m][0], v1 = acc[ai][0][m][1];
                        const f32x4* rp = (const f32x4*)(rope + (unsigned)((tbase + row) * 64 + 8 * g8)); const f32x4 c01 = rp[0], c23 = rp[1];
                        f32x4 o1, o2;
                        o1[0] = v0[0] * c01[0] - v1[0] * c01[1]; o2[0] = v0[0] * c01[1] + v1[0] * c01[0];
                        o1[1] = v0[1] * c01[2] - v1[1] * c01[3]; o2[1] = v0[1] * c01[3] + v1[1] * c01[2];
                        o1[2] = v0[2] * c23[0] - v1[2] * c23[1]; o2[2] = v0[2] * c23[1] + v1[2] * c23[0];
                        o1[3] = v0[3] * c23[2] - v1[3] * c23[3]; o2[3] = v0[3] * c23[3] + v1[3] * c23[2];
                        st8(KR + (unsigned)row * 64u + 8 * g8, o1, o2); asm volatile("" ::: "memory"); }
            } else if (wc == 2) {
                const int i0 = 8 * fq; const f32x4 b0 = *(const f32x4*)(dt_bias + i0), b1 = *(const f32x4*)(dt_bias + i0 + 4);
#pragma unroll
                for (int ai = 0; ai < 2; ++ai)
#pragma unroll
                    for (int m = 0; m < 4; ++m) { const int row = row0 + ai * 128 + m * 16; f32x4 v0 = acc[ai][0][m][0] + b0, v1 = acc[ai][0][m][1] + b1;
#pragma unroll
                        for (int e = 0; e < 4; ++e) { v0[e] = softplus(v0[e]); v1[e] = softplus(v1[e]); }
                        *(f32x4*)(DT + (unsigned)row * 32u + i0) = v0; *(f32x4*)(DT + (unsigned)row * 32u + i0 + 4) = v1; asm volatile("" ::: "memory"); }
            }
        }
    }
};
struct EpiQ {
    static constexpr bool PERM = true, AFTER_DRAIN = false;
    bf16_t *QN, *QR; const float* ssq; const float* rope; int tbase; float c2;
    __device__ __forceinline__ void operator()(ACC_T, const pg8::Unit& u, int wr, int wc, int fr, int fq) const {
        const int pn = u.pn, row0 = u.pm * 256 + wr * 64 + fr, cw = wc * 32 + 8 * fq;
#pragma unroll
        for (int ai = 0; ai < 2; ++ai)
#pragma unroll
            for (int m = 0; m < 4; ++m) { const int row = row0 + ai * 128 + m * 16; const float* sp = ssq + tbase + row; const float rs = rsqrtf(((sp[0] + sp[TT]) + (sp[2 * TT] + sp[3 * TT])) * (1.f / 256.f) + EPS) * c2;
#pragma unroll
                for (int bj = 0; bj < 2; ++bj) { const f32x4 v0 = acc[ai][bj][m][0] * rs, v1 = acc[ai][bj][m][1] * rs;
                    if (pn < 4) st8(QN + (unsigned)row * 1024u + pn * 256 + cw + bj * 128, v0, v1);
                    else { const int colr = (pn - 4) * 256 + cw + bj * 128, g8 = (colr & 63) >> 3;
                        const f32x4* rp = (const f32x4*)(rope + (unsigned)((tbase + row) * 64 + 8 * g8)); const f32x4 c01 = rp[0], c23 = rp[1];
                        f32x4 o1, o2;
                        o1[0] = v0[0] * c01[0] - v1[0] * c01[1]; o2[0] = v0[0] * c01[1] + v1[0] * c01[0];
                        o1[1] = v0[1] * c01[2] - v1[1] * c01[3]; o2[1] = v0[1] * c01[3] + v1[1] * c01[2];
                        o1[2] = v0[2] * c23[0] - v1[2] * c23[1]; o2[2] = v0[2] * c23[1] + v1[2] * c23[0];
                        o1[3] = v0[3] * c23[2] - v1[3] * c23[3]; o2[3] = v0[3] * c23[3] + v1[3] * c23[2];
                        st8(QR + (unsigned)row * 512u + colr, o1, o2); } }
                asm volatile("" ::: "memory"); }
    }
};
struct EpiRowScale {
    static constexpr bool PERM = true, AFTER_DRAIN = false;
    bf16_t* O; int ldc; const float* ssq; int tbase;
    __device__ __forceinline__ void operator()(ACC_T, const pg8::Unit& u, int wr, int wc, int fr, int fq) const {
        const int row0 = u.pm * 256 + wr * 64 + fr, col0 = u.pn * 256 + wc * 32 + 8 * fq;
#pragma unroll
        for (int ai = 0; ai < 2; ++ai)
#pragma unroll
            for (int m = 0; m < 4; ++m) { const int row = row0 + ai * 128 + m * 16; const float* sp = ssq + tbase + row; const float rs = rsqrtf(((sp[0] + sp[TT]) + (sp[2 * TT] + sp[3 * TT])) * (1.f / 256.f) + EPS);
#pragma unroll
                for (int bj = 0; bj < 2; ++bj) st8(O + (unsigned)row * (unsigned)ldc + col0 + bj * 128, acc[ai][bj][m][0] * rs, acc[ai][bj][m][1] * rs);
                asm volatile("" ::: "memory"); }
    }
};
struct EpiColScale {
    static constexpr bool PERM = true, AFTER_DRAIN = false;
    bf16_t* O; int ldc; const float* ssq; int tbase;
    __device__ __forceinline__ void operator()(ACC_T, const pg8::Unit& u, int wr, int wc, int fr, int fq) const {
        const int row0 = u.pm * 256 + wr * 64 + fr, col0 = u.pn * 256 + wc * 32 + 8 * fq;
#pragma unroll
        for (int bj = 0; bj < 2; ++bj) {
            const float* sp = ssq + tbase + col0 + bj * 128;
            f32x4 r0 = (*(const f32x4*)sp + *(const f32x4*)(sp + TT)) + (*(const f32x4*)(sp + 2 * TT) + *(const f32x4*)(sp + 3 * TT));
            f32x4 r1 = (*(const f32x4*)(sp + 4) + *(const f32x4*)(sp + TT + 4)) + (*(const f32x4*)(sp + 2 * TT + 4) + *(const f32x4*)(sp + 3 * TT + 4));
#pragma unroll
            for (int e = 0; e < 4; ++e) { r0[e] = rsqrtf(r0[e] * (1.f / 256.f) + EPS); r1[e] = rsqrtf(r1[e] * (1.f / 256.f) + EPS); }
#pragma unroll
            for (int ai = 0; ai < 2; ++ai)
#pragma unroll
                for (int m = 0; m < 4; ++m) { const int row = row0 + ai * 128 + m * 16; st8(O + (unsigned)row * (unsigned)ldc + col0 + bj * 128, acc[ai][bj][m][0] * r0, acc[ai][bj][m][1] * r1); }
            asm volatile("" ::: "memory");
        }
    }
};
template <int MODE> struct EpiGate {
    static constexpr bool PERM = true, AFTER_DRAIN = false;
    bf16_t* O; const bf16_t* G; const bf16_t* P;
    __device__ __forceinline__ void operator()(ACC_T, const pg8::Unit& u, int wr, int wc, int fr, int fq) const {
        const int row0 = u.pm * 256 + wr * 64 + fr, col0 = u.pn * 256 + wc * 32 + 8 * fq;
#pragma unroll
        for (int ai = 0; ai < 2; ++ai)
#pragma unroll
            for (int m = 0; m < 4; ++m) { const int row = row0 + ai * 128 + m * 16;
#pragma unroll
                for (int bj = 0; bj < 2; ++bj) { const unsigned off = (unsigned)row * 1024u + col0 + bj * 128; f32x4 g0, g1; ld8(G + off, g0, g1);
                    f32x4 v0 = acc[ai][bj][m][0] * g0, v1 = acc[ai][bj][m][1] * g1;
                    if (MODE == 1) { f32x4 p0, p1; ld8(P + off, p0, p1); v0 += p0; v1 += p1; }
                    st8(O + off, v0, v1); }
                asm volatile("" ::: "memory"); }
    }
};
struct EpiSsq {
    static constexpr bool PERM = true, AFTER_DRAIN = false;
    bf16_t* O; int ldc; float* ssq; int tbase;
    __device__ __forceinline__ void operator()(ACC_T, const pg8::Unit& u, int wr, int wc, int fr, int fq) const {
        const int row0 = u.pm * 256 + wr * 64 + fr, col0 = u.pn * 256 + wc * 32 + 8 * fq;
#pragma unroll
        for (int ai = 0; ai < 2; ++ai)
#pragma unroll
            for (int m = 0; m < 4; ++m) { const int row = row0 + ai * 128 + m * 16; float s = 0.f;
#pragma unroll
                for (int bj = 0; bj < 2; ++bj) { const f32x4 v0 = acc[ai][bj][m][0], v1 = acc[ai][bj][m][1]; st8(O + (unsigned)row * (unsigned)ldc + col0 + bj * 128, v0, v1); s += dot4(v0) + dot4(v1); }
                s += __shfl_xor(s, 16); s += __shfl_xor(s, 32);
                if (fq == 0) ssq[(u.pn * 4 + wc) * TT + tbase + row] = s; }
    }
};
struct EpiRelu2 {
    static constexpr bool PERM = true, AFTER_DRAIN = false;
    bf16_t* O; int ldc;
    __device__ __forceinline__ void operator()(ACC_T, const pg8::Unit& u, int wr, int wc, int fr, int fq) const {
        const int row0 = u.pm * 256 + wr * 64 + fr, col0 = u.pn * 256 + wc * 32 + 8 * fq;
#pragma unroll
        for (int ai = 0; ai < 2; ++ai)
#pragma unroll
            for (int m = 0; m < 4; ++m) { const int row = row0 + ai * 128 + m * 16;
#pragma unroll
                for (int bj = 0; bj < 2; ++bj) { f32x4 v0 = acc[ai][bj][m][0], v1 = acc[ai][bj][m][1];
#pragma unroll
                    for (int e = 0; e < 4; ++e) { const float a = fmaxf(v0[e], 0.f), b = fmaxf(v1[e], 0.f); v0[e] = a * a; v1[e] = b * b; }
                    st8(O + (unsigned)row * (unsigned)ldc + col0 + bj * 128, v0, v1); } }
    }
};

constexpr int ATT_KB = 24576, ATT_BUF = 40960;
__device__ __forceinline__ void attn_unit(LAS unsigned char* lds, const bf16_t* QN, const bf16_t* QR, const bf16_t* KN, const bf16_t* KR, const bf16_t* VT, bf16_t* ATT, int b, int h, int qb) {
    const int tid = ltid(), wid = __builtin_amdgcn_readfirstlane(tid >> 6), lane = tid & 63, r32 = lane & 31, hf = lane >> 5;
    const int tb = b * SEQ, q0w = qb * 256 + wid * 32;
    bf16x8 qf[12];
    { const unsigned t = (unsigned)(tb + q0w + r32);
#pragma unroll
      for (int ks = 0; ks < 8; ++ks) qf[ks] = *(const bf16x8*)(QN + t * 1024u + h * 128 + ks * 16 + hf * 8);
#pragma unroll
      for (int ks = 0; ks < 4; ++ks) qf[8 + ks] = *(const bf16x8*)(QR + t * 512u + h * 64 + ks * 16 + hf * 8); }
    f32x16 o[4];
#pragma unroll
    for (int i = 0; i < 4; ++i)
#pragma unroll
        for (int r = 0; r < 16; ++r) o[i][r] = 0.f;
    float m_i = -INFINITY, l_i = 0.f;
    const int nkt = 4 * (qb + 1);
    unsigned ksrc[3]; unsigned vsrc[2];
#pragma unroll
    for (int i = 0; i < 3; ++i) { const int pid = (wid + 8 * i) * 64 + lane, row = pid / 24, cp = pid % 24, c = (cp & ~7) | ((cp ^ row) & 7);
        ksrc[i] = c < 16 ? (unsigned)((tb + row) * 1024 + h * 128 + c * 8) : (0x80000000u | (unsigned)((tb + row) * 64 + (c - 16) * 8)); }
#pragma unroll
    for (int i = 0; i < 2; ++i) { const int pid = (wid + 8 * i) * 64 + lane, dv = pid >> 3, cp = pid & 7, c = cp ^ (dv & 7);
        vsrc[i] = (unsigned)((h * 128 + dv) * TG + tb + c * 8); }
#define ATT_DMA(kt, buf) do { \
    _Pragma("unroll") for (int i = 0; i < 3; ++i) { const bf16_t* src = (ksrc[i] & 0x80000000u) ? KR + ((ksrc[i] & 0x7fffffffu) + (unsigned)(kt) * 4096u) : KN + (ksrc[i] + (unsigned)(kt) * 65536u); \
        __builtin_amdgcn_global_load_lds((const unsigned*)src, (LAS unsigned*)(lds + (buf) * ATT_BUF + (wid + 8 * i) * 1024), 16, 0, 0); } \
    _Pragma("unroll") for (int i = 0; i < 2; ++i) \
        __builtin_amdgcn_global_load_lds((const unsigned*)(VT + (vsrc[i] + (unsigned)(kt) * 64u)), (LAS unsigned*)(lds + (buf) * ATT_BUF + ATT_KB + (wid + 8 * i) * 1024), 16, 0, 0); } while (0)
    __syncthreads();
    ATT_DMA(0, 0);
    const int tx = hf ^ (r32 & 7);
    for (int kt = 0; kt < nkt; ++kt) {
        asm volatile("s_waitcnt vmcnt(0)" ::: "memory");
        __syncthreads();
        if (kt + 1 < nkt) ATT_DMA(kt + 1, (kt + 1) & 1);
        const LAS unsigned char* kbuf = lds + (kt & 1) * ATT_BUF; const LAS unsigned char* vbuf = kbuf + ATT_KB;
        const int key0 = kt * 64;
        if (key0 <= q0w + 31) {
            f32x16 s[2];
#pragma unroll
            for (int kb = 0; kb < 2; ++kb) {
#pragma unroll
                for (int r = 0; r < 16; ++r) s[kb][r] = 0.f;
                const LAS unsigned char* krow = kbuf + (kb * 32 + r32) * 384;
#pragma unroll
                for (int ks = 0; ks < 12; ++ks) { const bf16x8 a = *(const LAS bf16x8*)(krow + (((2 * ks) & ~7) + (((2 * ks) & 7) ^ tx)) * 16);
                    s[kb] = __builtin_amdgcn_mfma_f32_32x32x16_bf16(a, qf[ks], s[kb], 0, 0, 0);
                    if ((ks & 3) == 3) __builtin_amdgcn_sched_barrier(0); }
            }
            if (key0 + 63 > q0w) {
                const int qi = q0w + r32;
#pragma unroll
                for (int kb = 0; kb < 2; ++kb)
#pragma unroll
                    for (int r = 0; r < 16; ++r) { const int key = key0 + kb * 32 + (r & 3) + 8 * (r >> 2) + 4 * hf; if (key > qi) s[kb][r] = -INFINITY; }
            }
            float mx = s[0][0];
#pragma unroll
            for (int kb = 0; kb < 2; ++kb)
#pragma unroll
                for (int r = 0; r < 16; ++r) mx = fmaxf(mx, s[kb][r]);
            mx = fmaxf(mx, __shfl_xor(mx, 32));
            const float m_new = fmaxf(m_i, mx);
            if (__any(m_new - m_i > 8.f)) {
                const float alpha = __builtin_amdgcn_exp2f(m_i - m_new);
                l_i *= alpha; m_i = m_new;
#pragma unroll
                for (int i = 0; i < 4; ++i)
#pragma unroll
                    for (int r = 0; r < 16; ++r) o[i][r] *= alpha;
            }
            float ps = 0.f;
#pragma unroll
            for (int kb = 0; kb < 2; ++kb)
#pragma unroll
                for (int r = 0; r < 16; ++r) { const float p = __builtin_amdgcn_exp2f(s[kb][r] - m_i); s[kb][r] = p; ps += p; }
            l_i += ps;
            bf16x8 pb[2][2];
#pragma unroll
            for (int kb = 0; kb < 2; ++kb)
#pragma unroll
                for (int s2 = 0; s2 < 2; ++s2) { u32x4 w; w.x = pk2(s[kb][8 * s2 + 0], s[kb][8 * s2 + 1]); w.y = pk2(s[kb][8 * s2 + 2], s[kb][8 * s2 + 3]);
                    w.z = pk2(s[kb][8 * s2 + 4], s[kb][8 * s2 + 5]); w.w = pk2(s[kb][8 * s2 + 6], s[kb][8 * s2 + 7]); pb[kb][s2] = __builtin_bit_cast(bf16x8, w); }
            const int vx = r32 & 7;
#pragma unroll
            for (int dvb = 0; dvb < 4; ++dvb) {
                const LAS unsigned char* vrow = vbuf + (dvb * 32 + r32) * 128 + hf * 8;
#pragma unroll
                for (int kb = 0; kb < 2; ++kb)
#pragma unroll
                    for (int s2 = 0; s2 < 2; ++s2) { const int c = kb * 4 + s2 * 2;
                        const u32x2 lo = *(const LAS u32x2*)(vrow + ((c ^ vx) * 16)), hi = *(const LAS u32x2*)(vrow + (((c + 1) ^ vx) * 16)); u32x4 w; w.x = lo.x; w.y = lo.y; w.z = hi.x; w.w = hi.y;
                        o[dvb] = __builtin_amdgcn_mfma_f32_32x32x16_bf16(__builtin_bit_cast(bf16x8, w), pb[kb][s2], o[dvb], 0, 0, 0); }
                __builtin_amdgcn_sched_barrier(0);
            }
        }
    }
#undef ATT_DMA
    l_i += __shfl_xor(l_i, 32);
    const float inv = 1.f / l_i;
    bf16_t* orow = ATT + (unsigned)(tb + q0w + r32) * 1024u + h * 128;
#pragma unroll
    for (int dvb = 0; dvb < 4; ++dvb)
#pragma unroll
        for (int rg = 0; rg < 4; ++rg) { u32x2 w; w.x = pk2(o[dvb][4 * rg] * inv, o[dvb][4 * rg + 1] * inv); w.y = pk2(o[dvb][4 * rg + 2] * inv, o[dvb][4 * rg + 3] * inv);
            *(u32x2*)(orow + dvb * 32 + 8 * rg + 4 * hf) = w; }
}

constexpr int SP = 272;
__device__ __forceinline__ void ld_tile(LAS unsigned char* dst, const bf16_t* src, int rows) {
    for (int p = ltid(); p < rows * 16; p += 512) { const int r = p >> 4, c = p & 15; *(LAS u32x4*)(dst + r * SP + c * 16) = *(const u32x4*)(src + r * 128 + c * 8); }
}
__device__ __forceinline__ void chunk_prep(LAS float* dts, LAS float* acs, const float* DT, int trow0, int g, const float* a_log) {
    const int tid = ltid(), wid = tid >> 6, lane = tid & 63;
    if (wid < 4) {
        const float A = -__expf(a_log[g * 4 + wid]);
        const float d0 = DT[(size_t)(trow0 + 2 * lane) * 32 + g * 4 + wid], d1 = DT[(size_t)(trow0 + 2 * lane + 1) * 32 + g * 4 + wid];
        const float x0 = d0 * A, x1 = x0 + d1 * A;
        float incl = x1;
#pragma unroll
        for (int o = 1; o < 64; o <<= 1) { const float v = __shfl_up(incl, o); if (lane >= o) incl += v; }
        const float excl = incl - x1;
        acs[wid * 128 + 2 * lane] = excl + x0; acs[wid * 128 + 2 * lane + 1] = excl + x1;
        dts[wid * 128 + 2 * lane] = d0; dts[wid * 128 + 2 * lane + 1] = d1;
    }
    __syncthreads();
}
__device__ __forceinline__ bf16x8 ldsfrag(const LAS unsigned char* base, int row, int k0) { return *(const LAS bf16x8*)(base + row * SP + k0 * 2); }

#define XB_TMO      128
#define XB_XCNT(j)  (256  + 64 * (j))
#define XB_XSUB(j)  (1280 + 64 * (j))
#define XB_XGEN(j)  (2304 + 64 * (j))
#define XB_TOP      3328
#define XB_TOPGEN   3392
#define XCD_BAR_WORDS 3456
#define XB_SPIN_CAP (1u << 18)

__device__ __forceinline__ unsigned xb_ld(unsigned* p)              { return __hip_atomic_load(p, __ATOMIC_RELAXED, __HIP_MEMORY_SCOPE_AGENT); }
__device__ __forceinline__ unsigned xb_add(unsigned* p, unsigned v) { return __hip_atomic_fetch_add(p, v, __ATOMIC_RELAXED, __HIP_MEMORY_SCOPE_AGENT); }
__device__ __forceinline__ unsigned xb_xcc_id() { return (unsigned)__builtin_amdgcn_s_getreg((3 << 11) | 20) & 0xFu; }
#define XB_SPIN(cond, bar) do { unsigned _sp = 0; while (cond) { __builtin_amdgcn_s_sleep(1); \
    if ((++_sp & 255u) == 0u) { if (xb_ld(&(bar)[XB_TMO])) break; if (_sp > XB_SPIN_CAP) { atomicAdd(&(bar)[XB_TMO], 1u); break; } } } } while (0)

struct XcdBarrier {
    unsigned* bar; unsigned x;
    volatile LAS unsigned* st;
};

__device__ __forceinline__ XcdBarrier xcd_barrier_post(unsigned* bar, volatile LAS unsigned* st) {
    XcdBarrier b; b.bar = bar; b.x = xb_xcc_id(); b.st = st;
    if (threadIdx.x == 0) (void)xb_add(&bar[XB_XCNT(b.x)], 1u);
    return b;
}
__device__ __forceinline__ void xcd_barrier_complete(unsigned* bar, unsigned x, unsigned& nloc, unsigned& nx) {
    const unsigned G = gridDim.x * gridDim.y * gridDim.z;
    unsigned sum, cnt, mine, sp = 0u;
    for (;;) {
        sum = 0u; cnt = 0u; mine = 0u;
#pragma unroll
        for (unsigned j = 0; j < 16; ++j) { const unsigned c = xb_ld(&bar[XB_XCNT(j)]); sum += c; cnt += (c > 0u) ? 1u : 0u; mine = (j == x) ? c : mine; }
        if (sum == G) break;
        __builtin_amdgcn_s_sleep(1);
        if ((++sp & 255u) == 0u) { if (xb_ld(&bar[XB_TMO])) break; if (sp > XB_SPIN_CAP) { atomicAdd(&bar[XB_TMO], 1u); break; } }
    }
    nloc = mine > 0u ? mine : 1u; nx = cnt > 0u ? cnt : 1u;
}

__device__ __forceinline__ void xcd_barrier(const XcdBarrier& b) {
    asm volatile("s_waitcnt vmcnt(0)" ::: "memory");
    __syncthreads();
    if (threadIdx.x == 0) {
        unsigned* bar = b.bar;
        __builtin_amdgcn_s_waitcnt(0);
        unsigned nloc = b.st[0], nx = b.st[1];
        if (nloc == 0u) { xcd_barrier_complete(bar, b.x, nloc, nx); b.st[0] = nloc; b.st[1] = nx; }
        const unsigned old = xb_add(&bar[XB_XSUB(b.x)], 1u);
        const unsigned gen = old / nloc;
        if (old + 1u == (gen + 1u) * nloc) {
            __builtin_amdgcn_fence(__ATOMIC_RELEASE, "agent");
            asm volatile("s_waitcnt vmcnt(0)" ::: "memory");
            const unsigned og = xb_add(&bar[XB_TOP], 1u);
            const unsigned tg = og / nx;
            if (og + 1u == (tg + 1u) * nx) xb_add(&bar[XB_TOPGEN], 1u);
            else XB_SPIN(xb_ld(&bar[XB_TOPGEN]) == tg, bar);
            __builtin_amdgcn_fence(__ATOMIC_ACQUIRE, "agent");
            xb_add(&bar[XB_XGEN(b.x)], 1u);
            asm volatile("s_waitcnt vmcnt(0)" ::: "memory");
        } else {
            XB_SPIN(xb_ld(&bar[XB_XGEN(b.x)]) == gen, bar);
            __builtin_amdgcn_fence(__ATOMIC_ACQUIRE, "agent");
            asm volatile("s_waitcnt vmcnt(0)" ::: "memory");
        }
    }
    __syncthreads();
}

struct Args { const void* in[25]; float* out; unsigned char* ws; };
__device__ __forceinline__ const void* in_ptr(int i) {
    int off = i * 8; asm volatile("" : "+s"(off));
    const __attribute__((address_space(4))) char* kp = (const __attribute__((address_space(4))) char*)__builtin_amdgcn_kernarg_segment_ptr();
    return *(const void* const __attribute__((address_space(4)))*)(kp + off);
}
#define INF(i) ((const float*)in_ptr(i))
#define WSB() ((unsigned char*)in_ptr(26))
#define OUTP() ((float*)in_ptr(25))

__device__ __forceinline__ void ph_mod(LAS unsigned char* lds) {
    const int tid = ltid(), lane = tid & 63, wid = __builtin_amdgcn_readfirstlane(tid >> 6), G = lgrid(), bx = lbid();
    float* MOD = (float*)(WSB() + WS_MOD);
    const float* cvec = INF(1); const float* w_ada = INF(3); const float* b_ada = INF(4);
    for (int item = bx; item < 96; item += G) {
        LAS float* sc = (LAS float*)lds;
        LAS float* red = (LAS float*)(lds + 65536);
        for (int i = tid; i < 16384; i += 512) { const int b = i >> 10, k = i & 1023; sc[k * 16 + b] = silu(cvec[i]); }
        __syncthreads();
        const int kg = tid >> 4, cl = tid & 15, j0 = item * 64 + cl * 4;
        f32x4 ac[16];
#pragma unroll
        for (int b = 0; b < 16; ++b) ac[b] = (f32x4){0.f, 0.f, 0.f, 0.f};
#pragma unroll 2
        for (int i = 0; i < 32; ++i) { const int k = kg + 32 * i; const f32x4 w = *(const f32x4*)(w_ada + (size_t)k * 6144 + j0);
            const LAS f32x4* sp = (const LAS f32x4*)(sc + k * 16);
#pragma unroll
            for (int q = 0; q < 4; ++q) { const f32x4 s4 = sp[q];
#pragma unroll
                for (int e = 0; e < 4; ++e) ac[q * 4 + e] += w * s4[e]; } }
#pragma unroll
        for (int b = 0; b < 16; ++b)
#pragma unroll
            for (int e = 0; e < 4; ++e) { float v = ac[b][e]; v += __shfl_xor(v, 16); v += __shfl_xor(v, 32); ac[b][e] = v; }
        if (lane < 16) {
#pragma unroll
            for (int b = 0; b < 16; ++b) *(LAS f32x4*)(red + (wid * 16 + b) * 64 + cl * 4) = ac[b];
        }
        __syncthreads();
        for (int i = tid; i < 1024; i += 512) { const int b = i >> 6, cc = i & 63; float s = b_ada[item * 64 + cc];
#pragma unroll
            for (int w = 0; w < 8; ++w) s += red[(w * 16 + b) * 64 + cc];
            MOD[b * 6144 + item * 64 + cc] = s; }
        __syncthreads();
    }
}
__device__ __forceinline__ void ph_wcopy(LAS unsigned char* lds) {
    const int tid = ltid(), lane = tid & 63, wid = __builtin_amdgcn_readfirstlane(tid >> 6), G = lgrid(), bx = lbid();
    const int gw = bx * 8 + wid, NGW = G * 8;
    unsigned char* ws = WSB();
    LAS float* scr = (LAS float*)(lds + wid * 8448);
    constexpr int I0 = 16 * 280, I1 = 4 * 48, I2 = 4 * 32, I3 = 4 * 32, I4 = 16 * 32, I5 = 32 * 32, I6 = 16 * 32, I7 = 16 * 128, I8 = 64 * 32;
    constexpr int NIT = I0 + I1 + I2 + I3 + I4 + I5 + I6 + I7 + I8;
    for (int it = gw; it < NIT; it += NGW) {
        int r = it;
        if (r < I0) { transpose_item(INF(7), 1024, 8800, (bf16_t*)(ws + WS_WIN), 1, nullptr, 280, scr, r, lane); continue; } r -= I0;
        if (r < I1) { transpose_item(INF(10), 256, 1536, (bf16_t*)(ws + WS_WUQ), 2, INF(8), 48, scr, r, lane); continue; } r -= I1;
        if (r < I2) { transpose_item(INF(11), 256, 2048, (bf16_t*)(ws + WS_WUKN), 3, INF(9), 32, scr, r, lane); continue; } r -= I2;
        if (r < I3) { transpose_item(INF(11), 256, 2048, (bf16_t*)(ws + WS_WUV), 4, INF(9), 32, scr, r, lane); continue; } r -= I3;
        if (r < I4) { transpose_item(INF(12), 1024, 1024, (bf16_t*)(ws + WS_WOA), 0, nullptr, 32, scr, r, lane); continue; } r -= I4;
        if (r < I5) { transpose_item(INF(19), 2048, 1024, (bf16_t*)(ws + WS_WOB), 0, nullptr, 32, scr, r, lane); continue; } r -= I5;
        if (r < I6) { transpose_item(INF(20), 1024, 1024, (bf16_t*)(ws + WS_WOUT), 0, nullptr, 32, scr, r, lane); continue; } r -= I6;
        if (r < I7) { transpose_item(INF(23), 1024, 4096, (bf16_t*)(ws + WS_WFF1), 0, nullptr, 128, scr, r, lane); continue; } r -= I7;
        transpose_item(INF(24), 4096, 1024, (bf16_t*)(ws + WS_WFF2), 0, nullptr, 32, scr, r, lane);
    }
}
__device__ __forceinline__ void ph_rope_zero() {
    const int tid = ltid(), G = lgrid(), bx = lbid();
    unsigned char* ws = WSB(); float* ROPE = (float*)(ws + WS_ROPE); const int* positions = (const int*)in_ptr(2);
    for (int idx = bx * 512 + tid; idx < TT * 32; idx += G * 512) {
        const int t = idx >> 5, i = idx & 31;
        const double ang = (double)positions[t] * ROPE_INV[i];
        const double n = __builtin_rint(ang * 0.15915494309189535);
        const double r = ang - n * 6.283185307179586476925, x2 = r * r;
        double ts = r, s = r, tc = 1.0, c = 1.0;
#pragma unroll
        for (int k = 1; k <= 13; ++k) { ts *= -x2 * (1.0 / (double)((2 * k) * (2 * k + 1))); s += ts; tc *= -x2 * (1.0 / (double)((2 * k - 1) * (2 * k))); c += tc; }
        *(f32x2*)(ROPE + (size_t)idx * 2) = (f32x2){(float)c, (float)s};
    }
}
__device__ __forceinline__ void ph_final_rows(int pb) {
    const int tid = ltid(), lane = tid & 63, wid = __builtin_amdgcn_readfirstlane(tid >> 6), G = lgrid(), bx = lbid();
    const int gw = bx * 8 + wid, NGW = G * 8;
    unsigned char* ws = WSB(); const float* SSQ_FF = (const float*)(ws + WS_SSQ) + SQ_FF; const float* MOD = (const float*)(ws + WS_MOD); const bf16_t* FF = (const bf16_t*)(ws + WS_FF);
    const float* g_post_mlp = INF(22); float* out = OUTP();
    for (int m = gw; m < TG; m += NGW) { const int t = pb + m, b = t >> 12;
        float sv = lane < 16 ? SSQ_FF[lane * TT + t] : 0.f; sv += __shfl_xor(sv, 1); sv += __shfl_xor(sv, 2); sv += __shfl_xor(sv, 4); sv += __shfl_xor(sv, 8); sv = __shfl(sv, 0);
        const float rs = rsqrtf(sv * (1.f / 1024.f) + EPS); const float* gate2 = MOD + b * 6144 + 5120;
#pragma unroll
        for (int j = 0; j < 4; ++j) { const int c0 = 4 * lane + 256 * j; const u32x2 w = *(const u32x2*)(FF + (size_t)m * 1024 + c0);
            f32x4 f = {bflo(w.x), bfhi(w.x), bflo(w.y), bfhi(w.y)}; const f32x4 g = *(const f32x4*)(g_post_mlp + c0), ga = *(const f32x4*)(gate2 + c0);
            f32x4* op = (f32x4*)(out + (size_t)t * 1024 + c0); *op = *op + ga * (f * rs * g); } }
}
__device__ __forceinline__ void ph_hrows(int tbase) {
    const int tid = ltid(), lane = tid & 63, wid = __builtin_amdgcn_readfirstlane(tid >> 6), G = lgrid(), bx = lbid();
    const int gw = bx * 8 + wid, NGW = G * 8;
    unsigned char* ws = WSB(); const float* MOD = (const float*)(ws + WS_MOD); bf16_t* H = (bf16_t*)(ws + WS_H);
    const float* x = INF(0); const float* g_pre_mix = INF(5);
    for (int m = gw; m < TG; m += NGW) { const int t = tbase + m, b = t >> 12;
        const f32x4* xr = (const f32x4*)(x + (size_t)t * 1024) + lane; f32x4 v[4]; float s = 0.f;
#pragma unroll
        for (int j = 0; j < 4; ++j) { v[j] = xr[64 * j]; s += dot4(v[j]); }
        const float rs = rsqrtf(wave_sum(s) * (1.f / 1024.f) + EPS); const float* shift = MOD + b * 6144; const float* scale = shift + 1024;
#pragma unroll
        for (int j = 0; j < 4; ++j) { const int c0 = 4 * lane + 256 * j; const f32x4 g = *(const f32x4*)(g_pre_mix + c0), sc = *(const f32x4*)(scale + c0), sh = *(const f32x4*)(shift + c0);
            const f32x4 hv = v[j] * rs * g * (sc + 1.f) + sh; u32x2 w; w.x = pk2(hv[0], hv[1]); w.y = pk2(hv[2], hv[3]); *(u32x2*)(H + (size_t)m * 1024 + c0) = w; } }
}
__device__ __forceinline__ void ph_proj(LAS unsigned char* lds, int tbase) {
    unsigned char* ws = WSB(); const int G = lgrid(), bx = lbid();
    pg8::Gemm g{(const bf16_t*)(ws + WS_H), (const bf16_t*)(ws + WS_WIN), TG, NPROJ, 1024}; pg8::StaticOrder S; S.init(TG, NPROJ, G, bx);
    float* SSQ = (float*)(ws + WS_SSQ);
    EpiProj E{(bf16_t*)(ws + WS_QL), (bf16_t*)(ws + WS_KVL), (bf16_t*)(ws + WS_KR), (bf16_t*)(ws + WS_Z), (bf16_t*)(ws + WS_XBC), (bf16_t*)(ws + WS_SGA), (bf16_t*)(ws + WS_SGB),
              (float*)(ws + WS_DT), SSQ + SQ_Q, SSQ + SQ_KV, (const float*)(ws + WS_ROPE), INF(15), tbase};
    pg8::gemm_phase<EpiProj, pg8::StaticOrder, true, true>(lds, g, S, E);
}
__device__ __forceinline__ void ph_upq(LAS unsigned char* lds, int tbase) {
    unsigned char* ws = WSB(); const int G = lgrid(), bx = lbid();
    pg8::Gemm g{(const bf16_t*)(ws + WS_QL), (const bf16_t*)(ws + WS_WUQ), TG, 1536, 256}; pg8::StaticOrder S; S.init(TG, 1536, G, bx);
    EpiQ E{(bf16_t*)(ws + WS_QN), (bf16_t*)(ws + WS_QR), (const float*)(ws + WS_SSQ) + SQ_Q, (const float*)(ws + WS_ROPE), tbase, 0.07216878364870322f * 1.4426950408889634f};
    pg8::gemm_phase<EpiQ, pg8::StaticOrder, true, true>(lds, g, S, E);
}
__device__ __forceinline__ void ph_upk(LAS unsigned char* lds, int tbase) {
    unsigned char* ws = WSB(); const int G = lgrid(), bx = lbid();
    pg8::Gemm g{(const bf16_t*)(ws + WS_KVL), (const bf16_t*)(ws + WS_WUKN), TG, 1024, 256}; pg8::StaticOrder S; S.init(TG, 1024, G, bx);
    EpiRowScale E{(bf16_t*)(ws + WS_KN), 1024, (const float*)(ws + WS_SSQ) + SQ_KV, tbase};
    pg8::gemm_phase<EpiRowScale, pg8::StaticOrder, true, true>(lds, g, S, E);
}
__device__ __forceinline__ void ph_upv(LAS unsigned char* lds, int tbase) {
    unsigned char* ws = WSB(); const int G = lgrid(), bx = lbid();
    pg8::Gemm g{(const bf16_t*)(ws + WS_WUV), (const bf16_t*)(ws + WS_KVL), 1024, TG, 256}; pg8::StaticOrder S; S.init(1024, TG, G, bx);
    EpiColScale E{(bf16_t*)(ws + WS_VT), TG, (const float*)(ws + WS_SSQ) + SQ_KV, tbase};
    pg8::gemm_phase<EpiColScale, pg8::StaticOrder, true, true>(lds, g, S, E);
}
__device__ __forceinline__ void ph_conv(LAS unsigned char* lds) {
    const int tid = ltid(), lane = tid & 63, wid = __builtin_amdgcn_readfirstlane(tid >> 6), G = lgrid(), bx = lbid();
    const int gw = bx * 8 + wid, NGW = G * 8;
    unsigned char* ws = WSB(); const bf16_t* XBC = (const bf16_t*)(ws + WS_XBC);
    const float* conv_w = INF(13); const float* conv_b = INF(14);
    LAS unsigned char* tile = lds + wid * 16768;
    for (int item = gw; item < NB * 32 * 64; item += NGW) {
        const int slab = item & 63, c = (item >> 6) & 31, b = item >> 11;
        const int ch0 = slab * 64;
        {
            u32x4 v[16];
            const bf16_t* src = XBC + (unsigned)((b * SEQ + c * 128) * 4096 + ch0);
#pragma unroll
            for (int i = 0; i < 16; ++i) { const int p = i * 64 + lane; v[i] = *(const u32x4*)(src + (unsigned)((p >> 3) * 4096 + (p & 7) * 8)); }
            u32x4 hv = {0u, 0u, 0u, 0u};
            if (lane < 24 && c > 0) hv = *(const u32x4*)(XBC + (unsigned)((b * SEQ + c * 128 - 3 + (lane >> 3)) * 4096 + ch0 + (lane & 7) * 8));
#pragma unroll
            for (int i = 0; i < 16; ++i) { const int p = i * 64 + lane; *(LAS u32x4*)(tile + (3 + (p >> 3)) * 128 + (p & 7) * 16) = v[i]; }
            if (lane < 24) *(LAS u32x4*)(tile + (lane >> 3) * 128 + (lane & 7) * 16) = hv;
        }
        LDS_WAIT(); __builtin_amdgcn_wave_barrier();
        if (slab < 48) {
            bf16_t* dst;
            if (slab < 32) { const int bl = (b * 32 + c) * 8 + (slab >> 2); dst = (bf16_t*)(ws + WS_XT) + ((size_t)(bl * 4 + (slab & 3)) * 64) * 128; }
            else { const int bl = (b * 32 + c) * 8 + ((slab - 32) >> 1); dst = (bf16_t*)(ws + WS_BT) + ((size_t)bl * 128 + ((slab - 32) & 1) * 64) * 128; }
            const int ch = lane;
            const float w0 = conv_w[ch0 + ch], w1 = conv_w[4096 + ch0 + ch], w2 = conv_w[8192 + ch0 + ch], w3 = conv_w[12288 + ch0 + ch], bb = conv_b[ch0 + ch];
            const LAS unsigned char* tp = tile + ch * 2;
            float u0 = bf2f_lds(tp), u1 = bf2f_lds(tp + 128), u2 = bf2f_lds(tp + 256);
#pragma unroll 2
            for (int q = 0; q < 16; ++q) {
                float uu[11]; uu[0] = u0; uu[1] = u1; uu[2] = u2;
#pragma unroll
                for (int i = 0; i < 8; ++i) uu[3 + i] = bf2f_lds(tp + (q * 8 + 3 + i) * 128);
                float ov[8];
#pragma unroll
                for (int j = 0; j < 8; ++j) ov[j] = silu(bb + w0 * uu[j] + w1 * uu[j + 1] + w2 * uu[j + 2] + w3 * uu[j + 3]);
                u32x4 w; w.x = pk2(ov[0], ov[1]); w.y = pk2(ov[2], ov[3]); w.z = pk2(ov[4], ov[5]); w.w = pk2(ov[6], ov[7]);
                *(u32x4*)(dst + (unsigned)(ch * 128 + q * 8)) = w;
                u0 = uu[8]; u1 = uu[9]; u2 = uu[10];
            }
        }
        if (slab >= 32) {
            const int s2 = slab - (slab < 48 ? 32 : 48); const int bl = (b * 32 + c) * 8 + (s2 >> 1);
            bf16_t* dst = (bf16_t*)(ws + (slab < 48 ? WS_BC : WS_CC)) + (size_t)bl * 128 * 128 + (s2 & 1) * 64;
            const int cgp = lane & 7, lr = lane >> 3, chb = ch0 + cgp * 8;
            f32x4 wa[4], wb[4];
#pragma unroll
            for (int k = 0; k < 4; ++k) { wa[k] = *(const f32x4*)(conv_w + k * 4096 + chb); wb[k] = *(const f32x4*)(conv_w + k * 4096 + chb + 4); }
            const f32x4 b0 = *(const f32x4*)(conv_b + chb), b1 = *(const f32x4*)(conv_b + chb + 4);
#pragma unroll 2
            for (int q = 0; q < 16; ++q) { const int l = q * 8 + lr;
                f32x4 a0 = b0, a1 = b1;
#pragma unroll
                for (int k = 0; k < 4; ++k) { const u32x4 uw = *(const LAS u32x4*)(tile + (l + k) * 128 + cgp * 16);
                    const f32x4 x0 = {bflo(uw.x), bfhi(uw.x), bflo(uw.y), bfhi(uw.y)}, x1 = {bflo(uw.z), bfhi(uw.z), bflo(uw.w), bfhi(uw.w)};
                    a0 += wa[k] * x0; a1 += wb[k] * x1; }
#pragma unroll
                for (int e = 0; e < 4; ++e) { a0[e] = silu(a0[e]); a1[e] = silu(a1[e]); }
                st8(dst + (unsigned)(l * 128 + cgp * 8), a0, a1); }
        }
        LDS_WAIT(); __builtin_amdgcn_wave_barrier();
    }
    __syncthreads();
}
__device__ __forceinline__ void ph_states(LAS unsigned char* lds) {
    const int tid = ltid(), lane = tid & 63, wid = __builtin_amdgcn_readfirstlane(tid >> 6), G = lgrid(), bx = lbid();
    unsigned char* ws = WSB(); const float* DT = (const float*)(ws + WS_DT); float* DEC = (float*)(ws + WS_DEC); const float* a_log = INF(16);
    for (int item = bx; item < NB * 32 * 8; item += G) {
        const int bl = item, g = item & 7, c = (item >> 3) & 31, b = item >> 8;
        LAS unsigned char* XTs = lds; LAS unsigned char* BTs = lds + 256 * SP;
        LAS float* dts = (LAS float*)(lds + 384 * SP); LAS float* acs = dts + 512; LAS float* wsc = acs + 512;
        ld_tile(XTs, (const bf16_t*)(ws + WS_XT) + (size_t)bl * 4 * 8192, 256); ld_tile(BTs, (const bf16_t*)(ws + WS_BT) + (size_t)bl * 16384, 128);
        chunk_prep(dts, acs, DT, b * SEQ + c * 128, g, a_log);
        { const int hh = tid >> 7; wsc[tid] = dts[tid] * __expf(acs[hh * 128 + 127] - acs[tid]); }
        if (tid < 4) DEC[(b * 32 + c) * 32 + g * 4 + tid] = __expf(acs[tid * 128 + 127]);
        __syncthreads();
        const int r32 = lane & 31, hf = lane >> 5, pb = wid >> 2, nb = wid & 3;
#pragma unroll 1
        for (int hh = 0; hh < 4; ++hh) {
            f32x16 acc;
#pragma unroll
            for (int r = 0; r < 16; ++r) acc[r] = 0.f;
#pragma unroll 2
            for (int ks = 0; ks < 8; ++ks) {
                const u32x4 xa = *(const LAS u32x4*)(XTs + (hh * 64 + pb * 32 + r32) * SP + (ks * 16 + hf * 8) * 2);
                const LAS f32x4* wp = (const LAS f32x4*)(wsc + hh * 128 + ks * 16 + hf * 8); const f32x4 w0 = wp[0], w1 = wp[1];
                u32x4 xs; xs.x = pk2(bflo(xa.x) * w0[0], bfhi(xa.x) * w0[1]); xs.y = pk2(bflo(xa.y) * w0[2], bfhi(xa.y) * w0[3]);
                xs.z = pk2(bflo(xa.z) * w1[0], bfhi(xa.z) * w1[1]); xs.w = pk2(bflo(xa.w) * w1[2], bfhi(xa.w) * w1[3]);
                const bf16x8 bb = ldsfrag(BTs, nb * 32 + r32, ks * 16 + hf * 8);
                acc = __builtin_amdgcn_mfma_f32_32x32x16_bf16(__builtin_bit_cast(bf16x8, xs), bb, acc, 0, 0, 0);
            }
            bf16_t* sp = (bf16_t*)(ws + WS_ST) + ((size_t)bl * 4 + hh) * 8192 + nb * 32 + r32;
#pragma unroll
            for (int r = 0; r < 16; ++r) sp[(pb * 32 + (r & 3) + 8 * (r >> 2) + 4 * hf) * 128] = (bf16_t)(pk2(acc[r], 0.f) & 0xffffu);
        }
        __syncthreads();
    }
}
__device__ __forceinline__ void ph_scan() {
    const int tid = ltid(), G = lgrid(), bx = lbid();
    unsigned char* ws = WSB(); const bf16_t* ST = (const bf16_t*)(ws + WS_ST); bf16_t* HP = (bf16_t*)(ws + WS_HP); const float* DEC = (const float*)(ws + WS_DEC);
    for (int e = bx * 512 + tid; e < NB * 32 * 1024; e += G * 512) {
        const int bgh = e >> 10, pn8 = e & 1023, b = bgh >> 5, gh = bgh & 31;
        f32x4 s0 = {0.f, 0.f, 0.f, 0.f}, s1 = {0.f, 0.f, 0.f, 0.f};
#pragma unroll 4
        for (int c = 0; c < 32; ++c) { const unsigned off = (unsigned)(((b * 32 + c) * 32 + gh) * 8192 + pn8 * 8);
            f32x4 a0, a1; ld8(ST + off, a0, a1); st8(HP + off, s0, s1);
            const float d = DEC[(b * 32 + c) * 32 + gh]; s0 = s0 * d + a0; s1 = s1 * d + a1; }
    }
}
__device__ __forceinline__ void ph_attn(LAS unsigned char* lds) {
    const int G = lgrid(), bx = lbid();
    unsigned char* ws = WSB();
    const bf16_t* QN = (const bf16_t*)(ws + WS_QN); const bf16_t* QR = (const bf16_t*)(ws + WS_QR); const bf16_t* KN = (const bf16_t*)(ws + WS_KN);
    const bf16_t* KR = (const bf16_t*)(ws + WS_KR); const bf16_t* VT = (const bf16_t*)(ws + WS_VT); bf16_t* ATT = (bf16_t*)(ws + WS_ATT);
    for (int pi0 = bx; pi0 < NB * 64; pi0 += G) {
        const int pi = (G % 8 == 0 && NB * 64 % 8 == 0 && pi0 - bx + G <= NB * 64) ? ((pi0 - bx) + (bx & 7) * (G >> 3) + (bx >> 3)) : pi0;
        const int b = pi >> 6, h = (pi >> 3) & 7, j = pi & 7;
#pragma unroll 1
        for (int k = 0; k < 2; ++k) attn_unit(lds, QN, QR, KN, KR, VT, ATT, b, h, k ? j : 15 - j); }
    __syncthreads();
}
__device__ __forceinline__ void ph_ssdc(LAS unsigned char* lds) {
    const int tid = ltid(), lane = tid & 63, wid = __builtin_amdgcn_readfirstlane(tid >> 6), G = lgrid(), bx = lbid();
    unsigned char* ws = WSB(); const float* DT = (const float*)(ws + WS_DT); const float* a_log = INF(16);
    LAS unsigned char* Cs = lds; LAS unsigned char* Bs = lds + 32768; LAS unsigned char* XTs = lds + 65536;
    LAS float* dts = (LAS float*)(lds + 131072); LAS float* acs = dts + 512; LAS float* rowp = acs + 512;
    const int r32 = lane & 31, hf = lane >> 5, h = wid >> 1, wl = wid & 1;
    for (int item = bx; item < NB * 32 * 8; item += G) {
        const int bl = item, g = item & 7, c = (item >> 3) & 31, b = item >> 8;
        const int trow0 = b * SEQ + c * 128;
        bf16x8 hpf[2][8];
#pragma unroll
        for (int pb = 0; pb < 2; ++pb) { const bf16_t* hp = (const bf16_t*)(ws + WS_HP) + ((size_t)bl * 4 + h) * 8192 + (unsigned)((pb * 32 + r32) * 128 + hf * 8);
#pragma unroll
            for (int ks = 0; ks < 8; ++ks) hpf[pb][ks] = *(const bf16x8*)(hp + ks * 16); }
        {
            int tid = ltid(); const int lane = tid & 63;
            const bf16_t* cc = (const bf16_t*)(ws + WS_CC) + (size_t)bl * 16384; const bf16_t* bc = (const bf16_t*)(ws + WS_BC) + (size_t)bl * 16384; const bf16_t* xt = (const bf16_t*)(ws + WS_XT) + (size_t)bl * 32768;
            {
                u32x4 v[8];
#pragma unroll
                for (int i = 0; i < 4; ++i) { v[i] = *(const u32x4*)(cc + (unsigned)((tid + 512 * i) * 8)); v[4 + i] = *(const u32x4*)(bc + (unsigned)((tid + 512 * i) * 8)); }
#pragma unroll
                for (int i = 0; i < 4; ++i) { const int p = tid + 512 * i, r = p >> 4, cp = (p & 15) ^ (r & 15);
                    *(LAS u32x4*)(Cs + r * 256 + cp * 16) = v[i]; *(LAS u32x4*)(Bs + r * 256 + cp * 16) = v[4 + i]; }
            }
            asm volatile("" ::: "memory");
            {
                u32x4 v[8];
#pragma unroll
                for (int i = 0; i < 8; ++i) v[i] = *(const u32x4*)(xt + (unsigned)((tid + 512 * i) * 8));
#pragma unroll
                for (int i = 0; i < 8; ++i) { const int p = tid + 512 * i, r = p >> 4, cp = (p & 15) ^ (r & 15); *(LAS u32x4*)(XTs + r * 256 + cp * 16) = v[i]; }
            }
            if (wid < 4) {
                const float A = -__expf(a_log[g * 4 + wid]);
                const float d0 = DT[(unsigned)((trow0 + 2 * lane) * 32 + g * 4 + wid)], d1 = DT[(unsigned)((trow0 + 2 * lane + 1) * 32 + g * 4 + wid)];
                const float x0 = d0 * A, x1 = x0 + d1 * A;
                float incl = x1;
#pragma unroll
                for (int o = 1; o < 64; o <<= 1) { const float t = __shfl_up(incl, o); if (lane >= o) incl += t; }
                const float excl = incl - x1;
                acs[wid * 128 + 2 * lane] = excl + x0; acs[wid * 128 + 2 * lane + 1] = excl + x1;
                dts[wid * 128 + 2 * lane] = d0; dts[wid * 128 + 2 * lane + 1] = d1;
            }
        }
        __syncthreads();
        f32x16 yacc[2][2];
#pragma unroll
        for (int li = 0; li < 2; ++li)
#pragma unroll
            for (int pb = 0; pb < 2; ++pb)
#pragma unroll
                for (int r = 0; r < 16; ++r) yacc[li][pb][r] = 0.f;
        const int sw = r32 & 15;
#pragma unroll
        for (int pb = 0; pb < 2; ++pb) {
#pragma unroll
            for (int li = 0; li < 2; ++li) { const int lb = li == 0 ? (wl ? 1 : 0) : (wl ? 2 : 3);
                const LAS unsigned char* crow = Cs + (lb * 32 + r32) * 256;
#pragma unroll
                for (int ks = 0; ks < 8; ++ks) yacc[li][pb] = __builtin_amdgcn_mfma_f32_32x32x16_bf16(hpf[pb][ks], *(const LAS bf16x8*)(crow + (((2 * ks + hf) ^ sw) * 16)), yacc[li][pb], 0, 0, 0);
            }
        }
        const float dsk = INF(17)[g * 4 + h];
#pragma unroll
        for (int li = 0; li < 2; ++li) {
            const int lb = li == 0 ? (wl ? 1 : 0) : (wl ? 2 : 3);
            const int l = lb * 32 + r32;
            const float al = acs[h * 128 + l];
            { const float ea = __expf(al);
#pragma unroll
              for (int pb = 0; pb < 2; ++pb)
#pragma unroll
                  for (int r = 0; r < 16; ++r) yacc[li][pb][r] *= ea; }
            const LAS unsigned char* crow = Cs + (lb * 32 + r32) * 256;
#pragma unroll 1
            for (int sb = 0; sb <= lb; ++sb) {
                f32x16 cbt;
#pragma unroll
                for (int r = 0; r < 16; ++r) cbt[r] = 0.f;
                const LAS unsigned char* brow = Bs + (sb * 32 + r32) * 256;
#pragma unroll
                for (int ks = 0; ks < 8; ++ks) cbt = __builtin_amdgcn_mfma_f32_32x32x16_bf16(*(const LAS bf16x8*)(brow + (((2 * ks + hf) ^ sw) * 16)), *(const LAS bf16x8*)(crow + (((2 * ks + hf) ^ sw) * 16)), cbt, 0, 0, 0);
                bf16x8 mt[2];
                { unsigned pk[8];
#pragma unroll
                  for (int rg = 0; rg < 4; ++rg) { const int s0 = sb * 32 + 8 * rg + 4 * hf;
                      const f32x4 as4 = *(const LAS f32x4*)(acs + h * 128 + s0), ds4 = *(const LAS f32x4*)(dts + h * 128 + s0);
                      float mv[4];
#pragma unroll
                      for (int e = 0; e < 4; ++e) { const int s = s0 + e; float val = cbt[4 * rg + e] * __expf(fminf(al - as4[e], 0.f)) * ds4[e];
                          if (s == l) val += dsk;
                          if (s > l) val = 0.f;
                          mv[e] = val; }
                      pk[2 * rg] = pk2(mv[0], mv[1]); pk[2 * rg + 1] = pk2(mv[2], mv[3]); }
                  u32x4 w0 = {pk[0], pk[1], pk[2], pk[3]}, w1 = {pk[4], pk[5], pk[6], pk[7]};
                  mt[0] = __builtin_bit_cast(bf16x8, w0); mt[1] = __builtin_bit_cast(bf16x8, w1); }
#pragma unroll
                for (int pb = 0; pb < 2; ++pb) { const LAS unsigned char* xrow = XTs + (h * 64 + pb * 32 + r32) * 256 + hf * 8;
#pragma unroll
                    for (int s2 = 0; s2 < 2; ++s2) { const int cpi = sb * 4 + s2 * 2;
                        const u32x2 lo = *(const LAS u32x2*)(xrow + ((cpi ^ sw) * 16)), hi = *(const LAS u32x2*)(xrow + (((cpi + 1) ^ sw) * 16));
                        u32x4 w = {lo.x, lo.y, hi.x, hi.y};
                        yacc[li][pb] = __builtin_amdgcn_mfma_f32_32x32x16_bf16(__builtin_bit_cast(bf16x8, w), mt[s2], yacc[li][pb], 0, 0, 0); } }
            }
        }
#pragma unroll
        for (int li = 0; li < 2; ++li) { const int lb = li == 0 ? (wl ? 1 : 0) : (wl ? 2 : 3); const int l = lb * 32 + r32;
            const bf16_t* zp = (const bf16_t*)(ws + WS_Z) + (unsigned)((trow0 + l) * 2048 + g * 256 + h * 64 + 4 * hf);
            float ssq = 0.f;
#pragma unroll
            for (int pb = 0; pb < 2; ++pb)
#pragma unroll
                for (int rg = 0; rg < 4; ++rg) { const u32x2 zw = *(const u32x2*)(zp + pb * 32 + 8 * rg); const float zz[4] = {bflo(zw.x), bfhi(zw.x), bflo(zw.y), bfhi(zw.y)};
#pragma unroll
                    for (int e = 0; e < 4; ++e) { const float v = yacc[li][pb][4 * rg + e] * silu(zz[e]); yacc[li][pb][4 * rg + e] = v; ssq += v * v; } }
            ssq += __shfl_xor(ssq, 32);
            if (hf == 0) rowp[h * 128 + l] = ssq; }
        __syncthreads();
#pragma unroll
        for (int li = 0; li < 2; ++li) { const int lb = li == 0 ? (wl ? 1 : 0) : (wl ? 2 : 3); const int l = lb * 32 + r32;
            const float rs = rsqrtf((rowp[l] + rowp[128 + l] + rowp[256 + l] + rowp[384 + l]) * (1.f / 256.f) + EPS);
            bf16_t* op = (bf16_t*)(ws + WS_SSM) + (unsigned)((trow0 + l) * 2048 + g * 256 + h * 64 + 4 * hf); const float* gp = INF(18) + g * 256 + h * 64 + 4 * hf;
#pragma unroll
            for (int pb = 0; pb < 2; ++pb)
#pragma unroll
                for (int rg = 0; rg < 4; ++rg) { const f32x4 gs = *(const f32x4*)(gp + pb * 32 + 8 * rg);
                    u32x2 w; w.x = pk2(yacc[li][pb][4 * rg] * rs * gs[0], yacc[li][pb][4 * rg + 1] * rs * gs[1]); w.y = pk2(yacc[li][pb][4 * rg + 2] * rs * gs[2], yacc[li][pb][4 * rg + 3] * rs * gs[3]);
                    *(u32x2*)(op + pb * 32 + 8 * rg) = w; } }
    }
    __syncthreads();
}
__device__ __forceinline__ void ph_merge_a(LAS unsigned char* lds) {
    unsigned char* ws = WSB(); const int G = lgrid(), bx = lbid();
    pg8::Gemm g{(const bf16_t*)(ws + WS_ATT), (const bf16_t*)(ws + WS_WOA), TG, 1024, 1024}; pg8::StaticOrder S; S.init(TG, 1024, G, bx);
    EpiGate<0> E{(bf16_t*)(ws + WS_MA), (const bf16_t*)(ws + WS_SGA), nullptr};
    pg8::gemm_phase<EpiGate<0>, pg8::StaticOrder, true, true>(lds, g, S, E);
    asm volatile("s_waitcnt vmcnt(0)" ::: "memory");
}
__device__ __forceinline__ void ph_merge_b(LAS unsigned char* lds) {
    unsigned char* ws = WSB(); const int G = lgrid(), bx = lbid();
    pg8::Gemm g{(const bf16_t*)(ws + WS_SSM), (const bf16_t*)(ws + WS_WOB), TG, 1024, 2048}; pg8::StaticOrder S; S.init(TG, 1024, G, bx);
    EpiGate<1> E{(bf16_t*)(ws + WS_MERGED), (const bf16_t*)(ws + WS_SGB), (const bf16_t*)(ws + WS_MA)};
    pg8::gemm_phase<EpiGate<1>, pg8::StaticOrder, true, true>(lds, g, S, E);
}
__device__ __forceinline__ void ph_mix(LAS unsigned char* lds, int tbase) {
    unsigned char* ws = WSB(); const int G = lgrid(), bx = lbid();
    pg8::Gemm g{(const bf16_t*)(ws + WS_MERGED), (const bf16_t*)(ws + WS_WOUT), TG, 1024, 1024}; pg8::StaticOrder S; S.init(TG, 1024, G, bx);
    EpiSsq E{(bf16_t*)(ws + WS_MIX), 1024, (float*)(ws + WS_SSQ) + SQ_MIX, tbase};
    pg8::gemm_phase<EpiSsq, pg8::StaticOrder, true, true>(lds, g, S, E);
}
__device__ __forceinline__ void ph_x1rows(int tbase) {
    const int tid = ltid(), lane = tid & 63, wid = __builtin_amdgcn_readfirstlane(tid >> 6), G = lgrid(), bx = lbid();
    const int gw = bx * 8 + wid, NGW = G * 8;
    unsigned char* ws = WSB(); const float* SSQ_MIX = (const float*)(ws + WS_SSQ) + SQ_MIX; const float* MOD = (const float*)(ws + WS_MOD);
    const bf16_t* MIX = (const bf16_t*)(ws + WS_MIX); bf16_t* H = (bf16_t*)(ws + WS_H);
    const float* x = INF(0); const float* g_post_mix = INF(6); const float* g_pre_mlp = INF(21); float* out = OUTP();
    for (int m = gw; m < TG; m += NGW) { const int t = tbase + m, b = t >> 12;
        float sv = lane < 16 ? SSQ_MIX[lane * TT + t] : 0.f; sv += __shfl_xor(sv, 1); sv += __shfl_xor(sv, 2); sv += __shfl_xor(sv, 4); sv += __shfl_xor(sv, 8); sv = __shfl(sv, 0);
        const float rs1 = rsqrtf(sv * (1.f / 1024.f) + EPS); const float* mod = MOD + b * 6144;
        f32x4 v[4]; float s = 0.f;
#pragma unroll
        for (int j = 0; j < 4; ++j) { const int c0 = 4 * lane + 256 * j; const u32x2 w = *(const u32x2*)(MIX + (size_t)m * 1024 + c0);
            const f32x4 f = {bflo(w.x), bfhi(w.x), bflo(w.y), bfhi(w.y)}; const f32x4 g = *(const f32x4*)(g_post_mix + c0), ga = *(const f32x4*)(mod + 2048 + c0);
            v[j] = *(const f32x4*)(x + (size_t)t * 1024 + c0) + ga * (f * rs1 * g); *(f32x4*)(out + (size_t)t * 1024 + c0) = v[j]; s += dot4(v[j]); }
        const float rs2 = rsqrtf(wave_sum(s) * (1.f / 1024.f) + EPS);
#pragma unroll
        for (int j = 0; j < 4; ++j) { const int c0 = 4 * lane + 256 * j; const f32x4 g = *(const f32x4*)(g_pre_mlp + c0), sc = *(const f32x4*)(mod + 4096 + c0), sh = *(const f32x4*)(mod + 3072 + c0);
            const f32x4 hv = v[j] * rs2 * g * (sc + 1.f) + sh; u32x2 w; w.x = pk2(hv[0], hv[1]); w.y = pk2(hv[2], hv[3]); *(u32x2*)(H + (size_t)m * 1024 + c0) = w; } }
}
__device__ __forceinline__ void ph_ff1(LAS unsigned char* lds) {
    unsigned char* ws = WSB(); const int G = lgrid(), bx = lbid();
    pg8::Gemm g{(const bf16_t*)(ws + WS_H), (const bf16_t*)(ws + WS_WFF1), TG, 4096, 1024}; pg8::StaticOrder S; S.init(TG, 4096, G, bx);
    EpiRelu2 E{(bf16_t*)(ws + WS_FF1), 4096};
    pg8::gemm_phase<EpiRelu2, pg8::StaticOrder, true, true>(lds, g, S, E);
}
__device__ __forceinline__ void ph_ff2(LAS unsigned char* lds, int tbase) {
    unsigned char* ws = WSB(); const int G = lgrid(), bx = lbid();
    pg8::Gemm g{(const bf16_t*)(ws + WS_FF1), (const bf16_t*)(ws + WS_WFF2), TG, 1024, 4096}; pg8::StaticOrder S; S.init(TG, 1024, G, bx);
    EpiSsq E{(bf16_t*)(ws + WS_FF), 1024, (float*)(ws + WS_SSQ) + SQ_FF, tbase};
    pg8::gemm_phase<EpiSsq, pg8::StaticOrder, true, true>(lds, g, S, E);
}

__global__ void __launch_bounds__(512, 2) mega(Args a) {
    extern __shared__ __attribute__((aligned(16))) unsigned char lds_raw[];
    LAS unsigned char* lds = (LAS unsigned char*)lds_raw;
    cg::grid_group grid = cg::this_grid();
    volatile LAS unsigned* bst = (volatile LAS unsigned*)(lds + LDS_BYTES - 64);
    if (threadIdx.x < 2) bst[threadIdx.x] = 0u;
    __syncthreads();
    XcdBarrier xbar = xcd_barrier_post((unsigned*)a.ws, bst);
#ifndef NO_MOD
    ph_mod(lds);
#endif
#ifndef NO_WCP
    ph_wcopy(lds);
#endif
    ph_rope_zero();
    if (DUP_P0) { ph_mod(lds); ph_wcopy(lds); ph_rope_zero(); }
    grid.sync();
#pragma unroll 1
    for (int rd = 0; rd < NROUND; ++rd) {
        const int tbase = rd * TG;
        if (rd > 0) ph_final_rows(tbase - TG);
        ph_hrows(tbase);
        if (DUP_ROWS) ph_hrows(tbase);
        GSYNC();
#ifndef NO_GB
        ph_proj(lds, tbase);
#endif
        GSYNC();
#ifndef NO_GC
        ph_upq(lds, tbase); ph_upk(lds, tbase); ph_upv(lds, tbase);
#endif
#ifndef NO_CONV
        ph_conv(lds);
        if (DUP_CONV) ph_conv(lds);
#endif
        GSYNC();
#ifndef NO_PD
        ph_states(lds);
        if (DUP_SS) ph_states(lds);
#endif
        GSYNC();
        ph_scan();
        if (DUP_SS) ph_scan();
        GSYNC();
#ifndef NO_ATT
        ph_attn(lds);
        if (DUP_ATT) ph_attn(lds);
#endif
#ifndef NO_SSDC
        ph_ssdc(lds);
        if (DUP_SSDC) ph_ssdc(lds);
#endif
        GSYNC();
#ifndef NO_GG
        ph_merge_a(lds); ph_merge_b(lds);
#endif
        GSYNC();
#ifndef NO_GH
        ph_mix(lds, tbase);
#endif
        GSYNC();
        ph_x1rows(tbase);
        if (DUP_ROWS) ph_x1rows(tbase);
        GSYNC();
#ifndef NO_GJ
        ph_ff1(lds);
#endif
        GSYNC();
#ifndef NO_GK
        ph_ff2(lds, tbase);
#endif
        GSYNC();
    }
    ph_final_rows(TT - TG);
}


extern "C" void kernel_launch(void* const* d_in, const int* in_sizes, int n_in, void* d_out, int out_size, void* d_ws, size_t ws_size, hipStream_t stream) {
    static int grid = 0;
    if (grid == 0) {
        if (n_in != 25 || out_size != TT * DM || ws_size < WS_END) { fprintf(stderr, "kernel_launch: unexpected problem (n_in %d out %d ws %zu)\n", n_in, out_size, ws_size); grid = -1; return; }
        int dev = 0, cus = 0, per_cu = 0;
        hipGetDevice(&dev); hipDeviceGetAttribute(&cus, hipDeviceAttributeMultiprocessorCount, dev);
        hipFuncSetAttribute((const void*)mega, hipFuncAttributeMaxDynamicSharedMemorySize, LDS_BYTES);
        hipOccupancyMaxActiveBlocksPerMultiprocessor(&per_cu, (const void*)mega, 512, LDS_BYTES);
        (void)hipGetLastError();
        if (per_cu < 1) per_cu = 1;
        grid = cus;
    }
    if (grid < 0) return;
    if (hipMemsetAsync(d_ws, 0, 65536, stream) != hipSuccess) { fprintf(stderr, "memset failed\n"); return; }
    Args a{};
    for (int i = 0; i < 25; ++i) a.in[i] = d_in[i];
    a.out = (float*)d_out; a.ws = (unsigned char*)d_ws;
    void* args[] = {&a};
    hipError_t e = hipLaunchCooperativeKernel((const void*)mega, dim3(grid), dim3(512), args, LDS_BYTES, stream);
    if (e != hipSuccess) fprintf(stderr, "cooperative launch failed: %s (grid %d)\n", hipGetErrorString(e), grid);
}
```
